# Optimizing an MI355X kernel written in HIP

```python
import math
import jax
import jax.numpy as jnp
from jax import lax
import numpy as np

D_MODEL = 1024
BATCH = 8
SEQ = 4096
DEPTH = 4

HEAD_DIM = 64
D_FF = 2816
NORM_EPS = 1e-6
NUM_BUCKETS = 32
MAX_DISTANCE = 1024
BAND_BLOCK = 128
NSA_HEADS = 8
NSA_KV = 2
NSA_GROUP = NSA_HEADS // NSA_KV
CMP_LEN = 32
CMP_STRIDE = 16
CMP_HIDDEN = 128
SEL_LEN = 64
SEL_TOPK = 16
SEL_QCHUNK = 64
NSA_WINDOW = 512
SWA_HEADS = 8
SWA_KV = 2
SWA_GROUP = SWA_HEADS // SWA_KV
SWA_WINDOW = 128
MLA_HEADS = 8
MLA_Q_RANK = 384
MLA_KV_RANK = 256
MLA_NOPE = 64
MLA_ROPE = 32
MLA_V = 64
MLA_QBLOCK = 128
ROPE_BASE = 10000.0
N_BRANCH = 3
BRANCH_WIDTH = NSA_HEADS * HEAD_DIM
N_BIAS_HEADS = NSA_HEADS + SWA_HEADS
NEG_INF = -1e30
SEL_FORCE = 1e9
IN_SIZES = (
    NSA_HEADS * HEAD_DIM,
    NSA_KV * HEAD_DIM, NSA_KV * HEAD_DIM,
    NSA_KV * HEAD_DIM, NSA_KV * HEAD_DIM,
    NSA_KV * HEAD_DIM, NSA_KV * HEAD_DIM,
    3 * NSA_HEADS,
    SWA_HEADS * HEAD_DIM,
    SWA_KV * HEAD_DIM, SWA_KV * HEAD_DIM,
    MLA_Q_RANK,
    MLA_KV_RANK,
    MLA_ROPE,
    N_BRANCH * D_MODEL,
)
IN_WIDTH = sum(IN_SIZES)

kernel_name = "hybrid_gated_nsa_swa_mla_macaron"


def rmsnorm(x, g):
    xf = x.astype(jnp.float32)
    inv = lax.rsqrt(jnp.mean(xf * xf, axis=-1, keepdims=True) + NORM_EPS)
    return (xf * inv).astype(x.dtype) * g


def split_cols(z):
    outs = []
    off = 0
    for n in IN_SIZES:
        outs.append(z[..., off:off + n])
        off += n
    return outs


def t5_bucket(dist):
    max_exact = NUM_BUCKETS // 2
    d = jnp.maximum(dist, 0)
    df = jnp.maximum(d, 1).astype(jnp.float32)
    large = max_exact + (jnp.log(df / max_exact) / math.log(MAX_DISTANCE / max_exact)
                         * (NUM_BUCKETS - max_exact)).astype(jnp.int32)
    large = jnp.minimum(large, NUM_BUCKETS - 1)
    return jnp.where(d < max_exact, d, large)


def rel_bias(dist, table):
    return table[t5_bucket(dist)].astype(jnp.float32)


def rope(x, pos):
    half = x.shape[-1] // 2
    inv_freq = ROPE_BASE ** (-jnp.arange(half, dtype=jnp.float32) / half)
    ang = pos.astype(jnp.float32)[:, None] * inv_freq[None, :]
    cos = jnp.cos(ang)[None, :, None, :].astype(x.dtype)
    sin = jnp.sin(ang)[None, :, None, :].astype(x.dtype)
    x1, x2 = x[..., :half], x[..., half:]
    return jnp.concatenate([x1 * cos - x2 * sin, x1 * sin + x2 * cos], axis=-1)


def macaron_ffn(x, g_pre, w_gu, w_down, g_post):
    h = rmsnorm(x, g_pre)
    gu = h @ w_gu
    y = (jax.nn.silu(gu[..., :D_FF]) * gu[..., D_FF:]) @ w_down
    return x + 0.5 * rmsnorm(y, g_post)


def banded_attention(q, k, v, window, table, sinks=None):
    B, S, Hkv, G, d = q.shape
    blk = BAND_BLOCK
    nb = S // blk
    n_prev = window // blk
    span = (n_prev + 1) * blk
    pad = ((0, 0), (n_prev * blk, 0), (0, 0), (0, 0))
    kp = jnp.pad(k, pad)
    vp = jnp.pad(v, pad)
    qi = jnp.arange(blk)[:, None]
    kj = jnp.arange(span)[None, :]
    dist = qi + n_prev * blk - kj
    bias = rel_bias(dist, table).transpose(2, 0, 1).reshape(Hkv, G, blk, span)
    in_band = (dist >= 0) & (dist < window)
    scale = d ** -0.5

    def one_block(n):
        qb = lax.dynamic_slice_in_dim(q, n * blk, blk, axis=1)
        kb = lax.dynamic_slice_in_dim(kp, n * blk, span, axis=1)
        vb = lax.dynamic_slice_in_dim(vp, n * blk, span, axis=1)
        s = jnp.einsum('bqhgd,bkhd->bhgqk', qb, kb).astype(jnp.float32) * scale + bias
        valid = in_band & ((n - n_prev) * blk + kj >= 0)
        s = jnp.where(valid, s, NEG_INF)
        if sinks is None:
            p = jax.nn.softmax(s, axis=-1)
        else:
            sk = sinks.astype(jnp.float32).reshape(Hkv, G, 1, 1)
            m = jnp.maximum(jnp.max(s, axis=-1, keepdims=True), sk)
            e = jnp.exp(s - m)
            p = e / (jnp.sum(e, axis=-1, keepdims=True) + jnp.exp(sk - m))
        return jnp.einsum('bhgqk,bkhd->bqhgd', p.astype(v.dtype), vb)

    o = lax.map(one_block, jnp.arange(nb))
    return o.transpose(1, 0, 2, 3, 4, 5).reshape(B, S, Hkv, G, d)


def nsa_compress(kv, pe, w1, w2):
    B, S, Hkv, d = kv.shape
    nc = (S - CMP_LEN) // CMP_STRIDE + 1
    idx = jnp.arange(nc)[:, None] * CMP_STRIDE + jnp.arange(CMP_LEN)[None, :]
    blocks = kv[:, idx] + pe[:, None, :]
    flat = blocks.transpose(0, 1, 3, 2, 4).reshape(B, nc, Hkv, CMP_LEN * d)
    return jax.nn.gelu(flat @ w1) @ w2


def nsa_attention(q, k_c, v_c, k_s, v_s, k_w, v_w, gate, pos, table,
                  pe_k, w1_k, w2_k, pe_v, w1_v, w2_v):
    B, S, Hkv, G, d = q.shape
    scale = d ** -0.5
    kc = nsa_compress(k_c, pe_k, w1_k, w2_k)
    vc = nsa_compress(v_c, pe_v, w1_v, w2_v)
    nc = kc.shape[1]
    cmp_end = jnp.arange(nc) * CMP_STRIDE + CMP_LEN - 1
    dist_c = pos[:, None] - cmp_end[None, :]
    valid_c = dist_c >= 0
    bias_c = rel_bias(dist_c, table).transpose(2, 0, 1).reshape(Hkv, G, S, nc)
    s = jnp.einsum('bthgd,bchd->bhgtc', q, kc).astype(jnp.float32) * scale + bias_c
    s = jnp.where(valid_c, s, NEG_INF)
    e = jnp.where(valid_c, jnp.exp(s - jnp.max(s, axis=-1, keepdims=True)), 0.0)
    den = jnp.sum(e, axis=-1, keepdims=True)
    p_c = e / jnp.where(den > 0, den, 1.0)
    o_cmp = jnp.einsum('bhgtc,bchd->bthgd', p_c.astype(vc.dtype), vc)

    n_sel = S // SEL_LEN
    top_k = min(SEL_TOPK, n_sel)
    ci = jnp.arange(nc)[:, None] * CMP_STRIDE
    sj = jnp.arange(n_sel)[None, :] * SEL_LEN
    overlap = jnp.maximum(jnp.minimum(ci + CMP_LEN, sj + SEL_LEN) - jnp.maximum(ci, sj), 0)
    overlap = overlap.astype(jnp.float32) / CMP_LEN
    imp = jnp.einsum('bhgtc,cj->bhtj', p_c, overlap)
    cur = pos // SEL_LEN
    jj = jnp.arange(n_sel)[None, :]
    forced = (jj == 0) | (jj == cur[:, None]) | (jj == cur[:, None] - 1)
    causal_blk = jj <= cur[:, None]
    score = jnp.where(forced, SEL_FORCE, jnp.where(causal_blk, imp, -SEL_FORCE))
    _, sel_idx = lax.top_k(score, top_k)

    ks_blk = k_s.reshape(B, n_sel, SEL_LEN, Hkv, d).transpose(0, 3, 1, 2, 4)
    vs_blk = v_s.reshape(B, n_sel, SEL_LEN, Hkv, d).transpose(0, 3, 1, 2, 4)
    tb_h = table.reshape(NUM_BUCKETS, Hkv, G).transpose(1, 0, 2)
    bi = jnp.arange(B)[:, None, None, None]
    hi = jnp.arange(Hkv)[None, :, None, None]
    C = SEL_QCHUNK

    def one_chunk(c):
        qc = lax.dynamic_slice_in_dim(q, c * C, C, axis=1)
        ic = lax.dynamic_slice_in_dim(sel_idx, c * C, C, axis=2)
        pc = lax.dynamic_slice_in_dim(pos, c * C, C, axis=0)
        kg = ks_blk[bi, hi, ic]
        vg = vs_blk[bi, hi, ic]
        s = jnp.einsum('bchgd,bhcnpd->bhgcnp', qc, kg).astype(jnp.float32) * scale
        dist = pc[:, None, None] - (ic[..., None] * SEL_LEN + jnp.arange(SEL_LEN))
        bias = tb_h[hi[..., None], t5_bucket(dist)].astype(jnp.float32)
        s = s + jnp.moveaxis(bias, -1, 2)
        s = jnp.where((dist >= 0)[:, :, None], s, NEG_INF)
        p = jax.nn.softmax(s.reshape(B, Hkv, G, C, -1), axis=-1).reshape(s.shape)
        return jnp.einsum('bhgcnp,bhcnpd->bchgd', p.astype(vg.dtype), vg)

    o_sel = lax.map(one_chunk, jnp.arange(S // C))
    o_sel = o_sel.transpose(1, 0, 2, 3, 4, 5).reshape(B, S, Hkv, G, d)

    o_win = banded_attention(q, k_w, v_w, NSA_WINDOW, table)

    g = jax.nn.sigmoid(gate.astype(jnp.float32)).reshape(B, S, Hkv, G, 3).astype(q.dtype)
    o = g[..., 0:1] * o_cmp + g[..., 1:2] * o_sel + g[..., 2:3] * o_win
    return o.reshape(B, S, Hkv * G * d)


def mla_attention(q_c, kv_c, k_r, pos, q_norm, w_qb, kv_norm, w_kvb):
    B, S, _ = q_c.shape
    H = MLA_HEADS
    q = (rmsnorm(q_c, q_norm) @ w_qb).reshape(B, S, H, MLA_NOPE + MLA_ROPE)
    q_nope = q[..., :MLA_NOPE]
    q_rope = rope(q[..., MLA_NOPE:], pos)
    kv = (rmsnorm(kv_c, kv_norm) @ w_kvb).reshape(B, S, H, MLA_NOPE + MLA_V)
    k_nope, v = kv[..., :MLA_NOPE], kv[..., MLA_NOPE:]
    k_rope = rope(k_r[:, :, None, :], pos)[:, :, 0]
    scale = (MLA_NOPE + MLA_ROPE) ** -0.5
    QB = MLA_QBLOCK

    def one_block(n):
        qn = lax.dynamic_slice_in_dim(q_nope, n * QB, QB, axis=1)
        qr = lax.dynamic_slice_in_dim(q_rope, n * QB, QB, axis=1)
        pq = lax.dynamic_slice_in_dim(pos, n * QB, QB, axis=0)
        s = (jnp.einsum('bqhd,bkhd->bhqk', qn, k_nope)
             + jnp.einsum('bqhd,bkd->bhqk', qr, k_rope)).astype(jnp.float32) * scale
        s = jnp.where(pq[:, None] >= pos[None, :], s, NEG_INF)
        p = jax.nn.softmax(s, axis=-1)
        return jnp.einsum('bhqk,bkhd->bqhd', p.astype(v.dtype), v)

    o = lax.map(one_block, jnp.arange(S // QB))
    return o.transpose(1, 0, 2, 3, 4).reshape(B, S, H * MLA_V)


def token_mixing(h, pos, table, w_in, nsa_pe_k, nsa_w1_k, nsa_w2_k, nsa_pe_v, nsa_w1_v, nsa_w2_v,
                 swa_sinks, mla_q_norm, mla_w_qb, mla_kv_norm, mla_w_kvb, w_branch, w_out):
    B, S, _ = h.shape
    (nq, nkc, nvc, nks, nvs, nkw, nvw, ngate, sq, sk, sv,
     mq, mkv, mkr, mgate) = split_cols(h @ w_in)
    kvs_a = (B, S, NSA_KV, HEAD_DIM)
    o_a = nsa_attention(nq.reshape(B, S, NSA_KV, NSA_GROUP, HEAD_DIM),
                        nkc.reshape(kvs_a), nvc.reshape(kvs_a), nks.reshape(kvs_a),
                        nvs.reshape(kvs_a), nkw.reshape(kvs_a), nvw.reshape(kvs_a),
                        ngate, pos, table[:, :NSA_HEADS],
                        nsa_pe_k, nsa_w1_k, nsa_w2_k, nsa_pe_v, nsa_w1_v, nsa_w2_v)
    kvs_b = (B, S, SWA_KV, HEAD_DIM)
    o_b = banded_attention(sq.reshape(B, S, SWA_KV, SWA_GROUP, HEAD_DIM),
                           sk.reshape(kvs_b), sv.reshape(kvs_b), SWA_WINDOW,
                           table[:, NSA_HEADS:], swa_sinks).reshape(B, S, BRANCH_WIDTH)
    o_c = mla_attention(mq, mkv, mkr, pos, mla_q_norm, mla_w_qb, mla_kv_norm, mla_w_kvb)
    branches = jnp.stack([o_a, o_b, o_c], axis=2)
    y = jnp.einsum('bsnc,ncd->bsnd', branches, w_branch)
    gates = jax.nn.sigmoid(mgate.astype(jnp.float32)).reshape(B, S, N_BRANCH, D_MODEL).astype(y.dtype)
    return jnp.sum(gates * y, axis=2) @ w_out


def setup_inputs(seed: int = 0) -> dict:
    key = jax.random.key(seed)
    ks = jax.random.split(key, 26)
    f32 = jnp.float32
    L = DEPTH

    def dense(k, shape, fan_in):
        return jax.random.normal(k, shape, f32) * fan_in ** -0.5

    def gain(k, shape):
        return 1.0 + 0.05 * jax.random.normal(k, shape, f32)

    return {
        "x": jax.random.normal(ks[0], (BATCH, SEQ, D_MODEL), f32),
        "rel_bias_table": 0.2 * jax.random.normal(ks[1], (NUM_BUCKETS, N_BIAS_HEADS), f32),
        "ffn1_norm_pre": gain(ks[2], (L, D_MODEL)),
        "ffn1_w_gu": dense(ks[3], (L, D_MODEL, 2 * D_FF), D_MODEL),
        "ffn1_w_down": dense(ks[4], (L, D_FF, D_MODEL), D_FF),
        "ffn1_norm_post": gain(ks[5], (L, D_MODEL)),
        "mix_norm_pre": gain(ks[6], (L, D_MODEL)),
        "w_in": dense(ks[7], (L, D_MODEL, IN_WIDTH), D_MODEL),
        "nsa_pe_k": 0.1 * jax.random.normal(ks[8], (L, CMP_LEN, HEAD_DIM), f32),
        "nsa_w1_k": dense(ks[9], (L, CMP_LEN * HEAD_DIM, CMP_HIDDEN), CMP_LEN * HEAD_DIM),
        "nsa_w2_k": dense(ks[10], (L, CMP_HIDDEN, HEAD_DIM), CMP_HIDDEN),
        "nsa_pe_v": 0.1 * jax.random.normal(ks[11], (L, CMP_LEN, HEAD_DIM), f32),
        "nsa_w1_v": dense(ks[12], (L, CMP_LEN * HEAD_DIM, CMP_HIDDEN), CMP_LEN * HEAD_DIM),
        "nsa_w2_v": dense(ks[13], (L, CMP_HIDDEN, HEAD_DIM), CMP_HIDDEN),
        "swa_sinks": jax.random.normal(ks[14], (L, SWA_HEADS), f32),
        "mla_q_norm": gain(ks[15], (L, MLA_Q_RANK)),
        "mla_w_qb": dense(ks[16], (L, MLA_Q_RANK, MLA_HEADS * (MLA_NOPE + MLA_ROPE)), MLA_Q_RANK),
        "mla_kv_norm": gain(ks[17], (L, MLA_KV_RANK)),
        "mla_w_kvb": dense(ks[18], (L, MLA_KV_RANK, MLA_HEADS * (MLA_NOPE + MLA_V)), MLA_KV_RANK),
        "w_branch": dense(ks[19], (L, N_BRANCH, BRANCH_WIDTH, D_MODEL), BRANCH_WIDTH),
        "w_out": dense(ks[20], (L, D_MODEL, D_MODEL), D_MODEL),
        "mix_norm_post": gain(ks[21], (L, D_MODEL)),
        "ffn2_norm_pre": gain(ks[22], (L, D_MODEL)),
        "ffn2_w_gu": dense(ks[23], (L, D_MODEL, 2 * D_FF), D_MODEL),
        "ffn2_w_down": dense(ks[24], (L, D_FF, D_MODEL), D_FF),
        "ffn2_norm_post": gain(ks[25], (L, D_MODEL)),
    }


def reference(x, rel_bias_table, ffn1_norm_pre, ffn1_w_gu, ffn1_w_down, ffn1_norm_post,
              mix_norm_pre, w_in, nsa_pe_k, nsa_w1_k, nsa_w2_k, nsa_pe_v, nsa_w1_v, nsa_w2_v,
              swa_sinks, mla_q_norm, mla_w_qb, mla_kv_norm, mla_w_kvb, w_branch, w_out,
              mix_norm_post, ffn2_norm_pre, ffn2_w_gu, ffn2_w_down, ffn2_norm_post):
    pos = jnp.arange(x.shape[1], dtype=jnp.int32)
    for l in range(DEPTH):
        x = macaron_ffn(x, ffn1_norm_pre[l], ffn1_w_gu[l], ffn1_w_down[l], ffn1_norm_post[l])
        h = rmsnorm(x, mix_norm_pre[l])
        m = token_mixing(h, pos, rel_bias_table, w_in[l],
                         nsa_pe_k[l], nsa_w1_k[l], nsa_w2_k[l], nsa_pe_v[l], nsa_w1_v[l], nsa_w2_v[l],
                         swa_sinks[l], mla_q_norm[l], mla_w_qb[l], mla_kv_norm[l], mla_w_kvb[l],
                         w_branch[l], w_out[l])
        x = x + rmsnorm(m, mix_norm_post[l])
        x = macaron_ffn(x, ffn2_norm_pre[l], ffn2_w_gu[l], ffn2_w_down[l], ffn2_norm_post[l])
    return x
```

```cpp
#include <hip/hip_runtime.h>
#include <cstdio>
#include <cstdint>
namespace pg8 {
#define PG8_LAS __attribute__((address_space(3)))
typedef unsigned short bf16_t;
typedef short bf16x8 __attribute__((ext_vector_type(8)));
typedef float f32x4 __attribute__((ext_vector_type(4)));
typedef unsigned u32x4 __attribute__((ext_vector_type(4)));
constexpr int BM = 256, BK = 64, HALF = 128, HTB = HALF * BK * 2  , STAGE_BYTES = 8 * HTB, NXCD = 8, WGM = 8;

__host__ __device__ __forceinline__ int lds_byte(int r, int c) { const int st = (r >> 4) * 2 + (c >> 5), rr = r & 15, cc = c & 31, ob = rr * 64 + cc * 2; return st * 1024 + (ob ^ (((ob >> 9) & 1) << 5)); }
__host__ __device__ __forceinline__ void stage_rc(int b, int& R, int& C) { const int st = b / 1024, sb = b % 1024, swz = sb ^ (((sb >> 9) & 1) << 5); R = (st >> 1) * 16 + swz / 64; C = (st & 1) * 32 + (swz % 64) / 2; }
__host__ __device__ __forceinline__ int perm32(int rho) { const int n = rho >> 4, i = rho & 15; return 8 * (i >> 2) + 4 * n + (i & 3); }

struct Unit { int pm, pn; };
struct Gemm { const bf16_t* A; const bf16_t* Bt; int M, N, K, lda; };

struct StaticOrder {
    int nM, nN, nwg, G, c;
    __host__ __device__ void init(int M, int N, int G_, int c_) { nM = M / BM; nN = N / BM; nwg = nM * nN; G = G_; c = c_; }
    __host__ __device__ bool next(int i, Unit& u) const {
        const long L = (long)i * G + c; if (L >= nwg) return false;
        int wgid = (int)L; { const int q = nwg / NXCD, r = nwg % NXCD, xcd = wgid % NXCD, off = wgid / NXCD; wgid = (xcd < r ? xcd * (q + 1) : r * (q + 1) + (xcd - r) * q) + off; }
        const int nig = WGM * nN, gid = wgid / nig, fm = gid * WGM, gsz = (nM - fm) < WGM ? (nM - fm) : WGM;
        u.pm = fm + ((wgid % nig) % gsz); u.pn = (wgid % nig) / gsz; return true;
    }
    __device__ __forceinline__ void a_ready(const Unit&) const {}
    __device__ __forceinline__ void done(const Unit&) const {}
};

typedef float f32x2c_t __attribute__((ext_vector_type(2))); typedef __bf16 bf16x2c_t __attribute__((ext_vector_type(2)));
__device__ __forceinline__ unsigned cvt_pk_bf16(float lo, float hi) { f32x2c_t v = {lo, hi}; bf16x2c_t b = __builtin_convertvector(v, bf16x2c_t); return __builtin_bit_cast(unsigned, b); }
typedef float f32x2 __attribute__((ext_vector_type(2)));
__device__ __forceinline__ f32x2 gelu_pk(f32x2 v) {
    const f32x2 av = __builtin_elementwise_abs(v), d = av * 0.2316418882f + 1.0f;
    f32x2 t; t.x = __builtin_amdgcn_rcpf(d.x); t.y = __builtin_amdgcn_rcpf(d.y);
    f32x2 q = t * 0.5307027145f + (-0.7265760135f); q = q * t + 0.7107068705f; q = q * t + (-0.142248368f); q = q * t + 0.127414796f; q = q * t;
    const f32x2 s = (v * v) * (-0.72134752044f);
    f32x2 e; e.x = __builtin_amdgcn_exp2f(s.x); e.y = __builtin_amdgcn_exp2f(s.y);
    const f32x2 m = v * (q * e), r = v - m;
    f32x2 o; o.x = v.x < 0.f ? m.x : r.x; o.y = v.y < 0.f ? m.y : r.y; return o;
}

template <int ACT  > struct EpiBf16 {
    static constexpr bool PERM = true, AFTER_DRAIN = false; static_assert(ACT == 0 || ACT == 1, "EpiBf16: ACT is 0 (none) or 1 (gelu_pk)");
    bf16_t* O; int ldc; const float* bias; int split_cols; size_t split_stride; float scale0;
    __device__ __forceinline__ void operator()(const f32x4 (&acc)[2][2][4][2], const Unit& u, int wr, int wc, int fr, int fq) const {
        const int row0 = u.pm * BM + wr * 64 + fr; int colt = u.pn * BM; bf16_t* base = O;
        float sc = 1.f; if (split_cols) { const int t = colt / split_cols; base += (size_t)t * split_stride; colt -= t * split_cols; if (t == 0) sc = scale0; }
        const int col0 = colt + wc * 32 + 8 * fq, bcol0 = u.pn * BM + wc * 32 + 8 * fq;
        f32x4 bv[2][2];
#pragma unroll
        for (int bj = 0; bj < 2; ++bj)
#pragma unroll
            for (int n = 0; n < 2; ++n) bv[bj][n] = bias ? *(const f32x4*)(bias + bcol0 + bj * HALF + 4 * n) : (f32x4){0.f, 0.f, 0.f, 0.f};
#pragma unroll
        for (int ai = 0; ai < 2; ++ai)
#pragma unroll
            for (int m = 0; m < 4; ++m) { bf16_t* rowp = base + (size_t)(row0 + ai * HALF + m * 16) * ldc + col0;
#pragma unroll
                for (int bj = 0; bj < 2; ++bj) { f32x4 v0 = acc[ai][bj][m][0] + bv[bj][0], v1 = acc[ai][bj][m][1] + bv[bj][1];
                    if (ACT == 1) { f32x2 a = gelu_pk((f32x2){v0[0], v0[1]}), b = gelu_pk((f32x2){v0[2], v0[3]}), c = gelu_pk((f32x2){v1[0], v1[1]}), d = gelu_pk((f32x2){v1[2], v1[3]});
                        v0 = (f32x4){a.x, a.y, b.x, b.y}; v1 = (f32x4){c.x, c.y, d.x, d.y}; }
                    v0 = v0 * sc; v1 = v1 * sc; u32x4 w; w.x = cvt_pk_bf16(v0[0], v0[1]); w.y = cvt_pk_bf16(v0[2], v0[3]); w.z = cvt_pk_bf16(v1[0], v1[1]); w.w = cvt_pk_bf16(v1[2], v1[3]);
                    *(u32x4*)(rowp + bj * HALF) = w; } }
    }
};

struct PanelStats {
    unsigned* xbuf;
    unsigned* cnt;
    unsigned* tmo;
    int ntn; float eps;
    unsigned code;
    __device__ __forceinline__ bool run(const f32x4 (&v)[2][2][4][2], const Unit& u, int wr, int wc, int fr, int fq, PG8_LAS unsigned char* lds, int wid, int lane) const {
        typedef float f32x2v __attribute__((ext_vector_type(2)));
        PG8_LAS f32x2v* P = (PG8_LAS f32x2v*)lds;
        PG8_LAS f32x2v* S = (PG8_LAS f32x2v*)(lds + 8192);
        PG8_LAS unsigned* flag = (PG8_LAS unsigned*)(lds + 8192 + 2048);
#pragma unroll
        for (int ai = 0; ai < 2; ++ai)
#pragma unroll
            for (int m = 0; m < 4; ++m) {
                float s = 0.f;
#pragma unroll
                for (int bj = 0; bj < 2; ++bj)
#pragma unroll
                    for (int n = 0; n < 2; ++n) { const f32x4 x = v[ai][bj][m][n]; s += (x[0] + x[1]) + (x[2] + x[3]); }
                s += __shfl_xor(s, 16); s += __shfl_xor(s, 32);
                const float mw = s * (1.0f / 64.0f); float q = 0.f;
#pragma unroll
                for (int bj = 0; bj < 2; ++bj)
#pragma unroll
                    for (int n = 0; n < 2; ++n) { const f32x4 d = v[ai][bj][m][n] - mw; q += (d[0] * d[0] + d[1] * d[1]) + (d[2] * d[2] + d[3] * d[3]); }
                q += __shfl_xor(q, 16); q += __shfl_xor(q, 32);
                if (fq == 0) P[(ai * HALF + wr * 64 + m * 16 + fr) * 4 + wc] = (f32x2v){mw, q};
            }
        asm volatile("s_waitcnt lgkmcnt(0)" ::: "memory"); __builtin_amdgcn_s_barrier(); asm volatile("" ::: "memory");
#if defined(BROKEN_EXCHANGE_NO_WAIT)
#warning BROKEN CONTROL BUILD: the row-statistics exchange does not wait; results are wrong by design
        if (blockIdx.x >= 64) { const long long t0_ = clock64(); while (clock64() - t0_ < 60000) __builtin_amdgcn_s_sleep(8); }
#endif
        const int row = wid * 32 + (lane & 31);
        if (lane < 32) {
            const f32x2v a = P[row * 4 + 0], b = P[row * 4 + 1], c = P[row * 4 + 2], d = P[row * 4 + 3];
            const float mt = (a.x + b.x + c.x + d.x) * 0.25f;
            const float da = a.x - mt, db = b.x - mt, dc = c.x - mt, dd = d.x - mt;
            const float m2 = (a.y + b.y) + (c.y + d.y) + 64.0f * ((da * da + db * db) + (dc * dc + dd * dd));
            unsigned long long* slot = (unsigned long long*)xbuf + ((size_t)(u.pm * BM + row) * 4 + u.pn);
            __hip_atomic_store(slot, ((unsigned long long)__float_as_uint(m2) << 32) | __float_as_uint(mt), __ATOMIC_RELAXED, __HIP_MEMORY_SCOPE_AGENT);
        }
        asm volatile("s_waitcnt vmcnt(0)" ::: "memory");
        if (lane == 0) __hip_atomic_fetch_add(cnt + 64 * u.pm, 1u, __ATOMIC_RELAXED, __HIP_MEMORY_SCOPE_AGENT);
        if (wid == 0) {
            bool dead = false; const unsigned long long t0 = __builtin_amdgcn_s_memrealtime(); const unsigned want = 8u * (unsigned)ntn;
            for (;;) {
#if defined(BROKEN_EXCHANGE_NO_WAIT)
                break;
#endif
                if ((unsigned)__builtin_amdgcn_readfirstlane(__hip_atomic_load(cnt + 64 * u.pm, __ATOMIC_RELAXED, __HIP_MEMORY_SCOPE_AGENT)) >= want) break;
                if (__builtin_amdgcn_s_memrealtime() - t0 > 2000000ull) {
                    if (lane == 0) { unsigned expect = 0u; __hip_atomic_compare_exchange_strong(tmo + 1, &expect, code | (unsigned)(u.pm & 0xff), __ATOMIC_RELAXED, __ATOMIC_RELAXED, __HIP_MEMORY_SCOPE_AGENT);
                                     __hip_atomic_store(tmo, 1u, __ATOMIC_RELAXED, __HIP_MEMORY_SCOPE_AGENT); }
                    dead = true; break; }
                __builtin_amdgcn_s_sleep(2);
            }
            __builtin_amdgcn_fence(__ATOMIC_ACQUIRE, "agent");
            if (lane == 0) flag[0] = dead ? 1u : 0u;
        }
        asm volatile("s_waitcnt vmcnt(0) lgkmcnt(0)" ::: "memory"); __builtin_amdgcn_s_barrier(); asm volatile("" ::: "memory");
        const bool bad = flag[0] != 0u;
        if (lane < 32) {
            const unsigned long long* slot = (const unsigned long long*)xbuf + (size_t)(u.pm * BM + row) * 4; float mt[4], m2[4]; float ms = 0.f;
#pragma unroll
            for (int t = 0; t < 4; ++t) { if (t < ntn) { const unsigned long long w = __hip_atomic_load(slot + t, __ATOMIC_RELAXED, __HIP_MEMORY_SCOPE_AGENT); mt[t] = __uint_as_float((unsigned)w); m2[t] = __uint_as_float((unsigned)(w >> 32)); } else { mt[t] = 0.f; m2[t] = 0.f; } ms += mt[t]; }
            const float mean = ms / (float)ntn; float q = 0.f;
#pragma unroll
            for (int t = 0; t < 4; ++t) if (t < ntn) { const float dm = mt[t] - mean; q += m2[t] + 256.0f * dm * dm; }
            S[row] = (f32x2v){mean, 1.0f / sqrtf(q / (256.0f * (float)ntn) + eps)};
        }
        asm volatile("s_waitcnt lgkmcnt(0)" ::: "memory"); __builtin_amdgcn_s_barrier(); asm volatile("" ::: "memory");
        return bad;
    }
};
struct EpiLnRes {
    static constexpr bool PERM = false, AFTER_DRAIN = true;
    const float* base; float* out; int ldc; const float* bias; PanelStats st; unsigned poison;
    __device__ __forceinline__ void fused(f32x4 (&acc)[2][2][4][2], const Unit& u, int wr, int wc, int fr, int fq, PG8_LAS unsigned char* lds, int wid, int lane) const {
        typedef float f32x2v __attribute__((ext_vector_type(2)));
        const PG8_LAS f32x2v* S = (const PG8_LAS f32x2v*)(lds + 8192);
        const int col0 = u.pn * BM + wc * 32 + 4 * fq;
#pragma unroll
        for (int bj = 0; bj < 2; ++bj)
#pragma unroll
            for (int n = 0; n < 2; ++n) { const f32x4 bv = bias ? *(const f32x4*)(bias + col0 + bj * HALF + n * 16) : (f32x4){0.f, 0.f, 0.f, 0.f};
#pragma unroll
                for (int ai = 0; ai < 2; ++ai)
#pragma unroll
                    for (int m = 0; m < 4; ++m) acc[ai][bj][m][n] += bv; }
        f32x4 pre[4][2][2];
#pragma unroll
        for (int m = 0; m < 4; ++m) { const size_t off = (size_t)(u.pm * BM + wr * 64 + m * 16 + fr) * ldc + col0;
#pragma unroll
            for (int bj = 0; bj < 2; ++bj)
#pragma unroll
                for (int n = 0; n < 2; ++n) pre[m][bj][n] = *(const f32x4*)(base + off + bj * HALF + n * 16); }
        const bool bad = st.run(acc, u, wr, wc, fr, fq, lds, wid, lane) || poison != 0u;
        const float qnan = __builtin_nanf("");
#pragma unroll
        for (int ai = 0; ai < 2; ++ai)
#pragma unroll
            for (int m = 0; m < 4; ++m) { const int r = ai * HALF + wr * 64 + m * 16 + fr; const f32x2v sr = S[r]; const size_t off = (size_t)(u.pm * BM + r) * ldc + col0;
#pragma unroll
                for (int bj = 0; bj < 2; ++bj)
#pragma unroll
                    for (int n = 0; n < 2; ++n) { const f32x4 bs = ai == 0 ? pre[m][bj][n] : *(const f32x4*)(base + off + bj * HALF + n * 16); f32x4 o = bs + (acc[ai][bj][m][n] - sr.x) * sr.y;
                        if (bad) o = (f32x4){qnan, qnan, qnan, qnan}; *(f32x4*)(out + off + bj * HALF + n * 16) = o; }
                if (m & 1) asm volatile("" ::: "memory"); }
    }
};
struct EpiLnResLn {
    static constexpr bool PERM = false, AFTER_DRAIN = true;
    const float* base; float* out; bf16_t* xn; int ldc; const float* bias; PanelStats st1, st2; unsigned poison;
    __device__ __forceinline__ void fused(f32x4 (&acc)[2][2][4][2], const Unit& u, int wr, int wc, int fr, int fq, PG8_LAS unsigned char* lds, int wid, int lane) const {
        typedef float f32x2v __attribute__((ext_vector_type(2))); typedef unsigned u32x2v __attribute__((ext_vector_type(2)));
        const PG8_LAS f32x2v* S = (const PG8_LAS f32x2v*)(lds + 8192);
        const int col0 = u.pn * BM + wc * 32 + 4 * fq;
#pragma unroll
        for (int bj = 0; bj < 2; ++bj)
#pragma unroll
            for (int n = 0; n < 2; ++n) { const f32x4 bv = bias ? *(const f32x4*)(bias + col0 + bj * HALF + n * 16) : (f32x4){0.f, 0.f, 0.f, 0.f};
#pragma unroll
                for (int ai = 0; ai < 2; ++ai)
#pragma unroll
                    for (int m = 0; m < 4; ++m) acc[ai][bj][m][n] += bv; }
        bool bad = st1.run(acc, u, wr, wc, fr, fq, lds, wid, lane) || poison != 0u;
        const float qnan = __builtin_nanf("");
#pragma unroll
        for (int ai = 0; ai < 2; ++ai)
#pragma unroll
            for (int m = 0; m < 4; ++m) { const int r = ai * HALF + wr * 64 + m * 16 + fr; const f32x2v sr = S[r]; const size_t off = (size_t)(u.pm * BM + r) * ldc + col0;
#pragma unroll
                for (int bj = 0; bj < 2; ++bj)
#pragma unroll
                    for (int n = 0; n < 2; ++n) { const f32x4 bs = *(const f32x4*)(base + off + bj * HALF + n * 16); acc[ai][bj][m][n] = bs + (acc[ai][bj][m][n] - sr.x) * sr.y; }
                asm volatile("" : "+v"(acc[ai][0][m][0]), "+v"(acc[ai][0][m][1]), "+v"(acc[ai][1][m][0]), "+v"(acc[ai][1][m][1]));
                if (m & 1) asm volatile("" ::: "memory"); }
        const bool bad1 = bad;
        bad = st2.run(acc, u, wr, wc, fr, fq, lds, wid, lane) || bad;
#pragma unroll
        for (int ai = 0; ai < 2; ++ai)
#pragma unroll
            for (int m = 0; m < 4; ++m) { const int r = ai * HALF + wr * 64 + m * 16 + fr; const f32x2v sr = S[r]; const size_t off = (size_t)(u.pm * BM + r) * ldc + col0;
#pragma unroll
                for (int bj = 0; bj < 2; ++bj)
#pragma unroll
                    for (int n = 0; n < 2; ++n) { const f32x4 x1 = acc[ai][bj][m][n]; *(f32x4*)(out + off + bj * HALF + n * 16) = bad1 ? (f32x4){qnan, qnan, qnan, qnan} : x1;
                        const f32x4 o = (x1 - sr.x) * sr.y; u32x2v w; w.x = cvt_pk_bf16(o[0], o[1]); w.y = cvt_pk_bf16(o[2], o[3]);
                        if (bad) { w.x = 0x7fc07fc0u; w.y = 0x7fc07fc0u; } *(u32x2v*)(xn + off + bj * HALF + n * 16) = w; }
                asm volatile("" ::: "memory"); }
    }
};

template <class Epi, class Sched, bool ALIGN_EPI = false, bool SP2 = false>
__device__ __forceinline__ void gemm_phase(PG8_LAS unsigned char* lds, const Gemm g, const Sched& S, const Epi& E) {
    const int tid = threadIdx.x, wid = __builtin_amdgcn_readfirstlane(tid >> 6), lane = tid & 63, wr = wid >> 2, wc = wid & 3, fr = lane & 15, fq = lane >> 4;
    const int K = g.K, nt = K / BK;
    unsigned voffA[2], voffB[2];
#pragma unroll
    for (int i = 0; i < 2; ++i) { int R, C; stage_rc(tid * 16 + i * 8192, R, C); const int Rb = Epi::PERM ? ((R & ~31) + perm32(R & 31)) : R;
        voffA[i] = (unsigned)(R * g.lda + C) * 2u; voffB[i] = (unsigned)(Rb * K + C) * 2u; }
    const size_t kstep = (size_t)(BK * 2);
    const size_t hstep = (size_t)HALF * K * 2;
    const size_t tstep = 2 * hstep; const size_t hstepA = (size_t)HALF * g.lda * 2, tstepA = 2 * hstepA;
    const unsigned ldsw = (unsigned)wid * 1024u;
    const int aoff = lds_byte(wr * 64 + fr, fq * 8), boff = lds_byte(wc * 32 + fr, fq * 8);
#define PG8_SA(b, h) (((b) * 2 + (h)) * HTB)
#define PG8_SB(b, h) ((4 + (b) * 2 + (h)) * HTB)
#define PG8_STAGE(bufoff, gbase, voff) do { _Pragma("unroll") for (int _i = 0; _i < 2; ++_i) \
        __builtin_amdgcn_global_load_lds((const unsigned*)((const char*)(gbase) + (voff)[_i]), (PG8_LAS unsigned*)(lds + (bufoff) + ldsw + _i * 8192), 16, 0, 0); } while (0)
#define PG8_LDA(dst, b, h) do { _Pragma("unroll") for (int m = 0; m < 4; ++m) _Pragma("unroll") for (int k = 0; k < 2; ++k) dst[m][k] = *(const PG8_LAS bf16x8*)(lds + PG8_SA(b, h) + aoff + m * 2048 + k * 1024); } while (0)
#define PG8_LDB(dst, b, h) do { _Pragma("unroll") for (int n = 0; n < 2; ++n) _Pragma("unroll") for (int k = 0; k < 2; ++k) dst[n][k] = *(const PG8_LAS bf16x8*)(lds + PG8_SB(b, h) + boff + n * 2048 + k * 1024); } while (0)
#define PG8_MMA(ai, bj, At, Bt) do { __builtin_amdgcn_s_setprio(1); _Pragma("unroll") for (int m = 0; m < 4; ++m) _Pragma("unroll") for (int n = 0; n < 2; ++n) _Pragma("unroll") for (int k = 0; k < 2; ++k) \
        acc[ai][bj][m][n] = __builtin_amdgcn_mfma_f32_16x16x32_bf16(Bt[n][k], At[m][k], acc[ai][bj][m][n], 0, 0, 0); __builtin_amdgcn_s_setprio(0); } while (0)
#define PG8_WAIT_V(n) asm volatile("s_waitcnt vmcnt(" #n ")" ::: "memory")
#define PG8_WAIT_L(n) asm volatile("s_waitcnt lgkmcnt(" #n ")" ::: "memory")
#define PG8_BAR __builtin_amdgcn_s_barrier()
#define PG8_SCHED __builtin_amdgcn_sched_barrier(0)
    Unit cur, nxt; int ui = 0;
    if (!S.next(0, cur)) return;
    f32x4 acc[2][2][4][2];
#pragma unroll
    for (int a = 0; a < 2; ++a)
#pragma unroll
        for (int b = 0; b < 2; ++b)
#pragma unroll
            for (int m = 0; m < 4; ++m)
#pragma unroll
                for (int n = 0; n < 2; ++n) acc[a][b][m][n] = (f32x4){0.f, 0.f, 0.f, 0.f};
    bf16x8 At[4][2], B0[2][2], B1[2][2];
    const char* cA = (const char*)g.A + (size_t)cur.pm * tstepA; const char* cB = (const char*)g.Bt + (size_t)cur.pn * tstep;
    S.a_ready(cur);
    if constexpr (SP2) {
        PG8_STAGE(PG8_SB(0, 0), cB, voffB); PG8_STAGE(PG8_SB(0, 1), cB + hstep, voffB); PG8_STAGE(PG8_SA(0, 0), cA, voffA); PG8_STAGE(PG8_SA(0, 1), cA + hstepA, voffA);
        if (wr == 1) PG8_BAR;
        PG8_WAIT_V(2); PG8_BAR;
        PG8_STAGE(PG8_SB(1, 0), cB + kstep, voffB); PG8_STAGE(PG8_SA(1, 0), cA + kstep, voffA); PG8_STAGE(PG8_SB(1, 1), cB + hstep + kstep, voffB);
        PG8_WAIT_V(6); PG8_BAR;
    } else {
        PG8_STAGE(PG8_SB(0, 0), cB, voffB); PG8_STAGE(PG8_SA(0, 0), cA, voffA); PG8_STAGE(PG8_SB(0, 1), cB + hstep, voffB); PG8_STAGE(PG8_SA(0, 1), cA + hstepA, voffA);
        if (wr == 1) PG8_BAR;
        PG8_WAIT_V(4); PG8_BAR;
        PG8_STAGE(PG8_SB(1, 0), cB + kstep, voffB); PG8_STAGE(PG8_SA(1, 0), cA + kstep, voffA); PG8_STAGE(PG8_SB(1, 1), cB + hstep + kstep, voffB);
        PG8_WAIT_V(6); PG8_BAR;
    }
    for (;;) {
        const bool has_next = S.next(ui + 1, nxt);
        const char* nA = has_next ? (const char*)g.A + (size_t)nxt.pm * tstepA : cA; const char* nB = has_next ? (const char*)g.Bt + (size_t)nxt.pn * tstep : cB;
        for (int t = 0; t < nt; t += 2) {
            const bool last = (t == nt - 2);
            const char* a1 = cA + (size_t)(t + 1) * kstep;
            const char* a2 = last ? nA : cA + (size_t)(t + 2) * kstep; const char* b2 = last ? nB : cB + (size_t)(t + 2) * kstep;
            const char* a3 = a2 + kstep; const char* b3 = b2 + kstep;
            if (last && has_next) S.a_ready(nxt);
            if constexpr (SP2) {
            PG8_LDB(B0, 0, 0); PG8_LDB(B1, 0, 1); PG8_SCHED; PG8_LDA(At, 0, 0); PG8_STAGE(PG8_SA(1, 1), a1 + hstepA, voffA);
            PG8_WAIT_V(8); PG8_WAIT_L(0); PG8_BAR; PG8_MMA(0, 0, At, B0); PG8_MMA(0, 1, At, B1); PG8_BAR; PG8_SCHED;
            PG8_LDA(At, 0, 1); PG8_STAGE(PG8_SB(0, 0), b2, voffB); PG8_STAGE(PG8_SB(0, 1), b2 + hstep, voffB); PG8_STAGE(PG8_SA(0, 0), a2, voffA);
            PG8_WAIT_V(8); PG8_WAIT_L(0); PG8_BAR; PG8_MMA(1, 0, At, B0); PG8_MMA(1, 1, At, B1); PG8_BAR; PG8_SCHED;
            PG8_LDB(B0, 1, 0); PG8_LDB(B1, 1, 1); PG8_SCHED; PG8_LDA(At, 1, 0); PG8_STAGE(PG8_SA(0, 1), a2 + hstepA, voffA);
            PG8_WAIT_V(8); PG8_WAIT_L(0); PG8_BAR; PG8_MMA(0, 0, At, B0); PG8_MMA(0, 1, At, B1); PG8_BAR; PG8_SCHED;
            PG8_LDA(At, 1, 1); PG8_STAGE(PG8_SB(1, 0), b3, voffB); PG8_STAGE(PG8_SB(1, 1), b3 + hstep, voffB); PG8_STAGE(PG8_SA(1, 0), a3, voffA);
            PG8_WAIT_V(8); PG8_WAIT_L(0); PG8_BAR; PG8_MMA(1, 0, At, B0); PG8_MMA(1, 1, At, B1); PG8_BAR; PG8_SCHED;
            } else {
            PG8_LDB(B0, 0, 0); PG8_SCHED; PG8_LDA(At, 0, 0); PG8_STAGE(PG8_SA(1, 1), a1 + hstepA, voffA);
            PG8_WAIT_L(8); PG8_BAR; PG8_WAIT_L(0); PG8_MMA(0, 0, At, B0); PG8_BAR; PG8_SCHED;
            PG8_LDB(B1, 0, 1); PG8_STAGE(PG8_SB(0, 0), b2, voffB);
            PG8_BAR; PG8_WAIT_L(0); PG8_MMA(0, 1, At, B1); PG8_BAR;
            PG8_LDA(At, 0, 1); PG8_STAGE(PG8_SA(0, 0), a2, voffA);
            PG8_BAR; PG8_WAIT_L(0); PG8_MMA(1, 0, At, B0); PG8_BAR; PG8_SCHED;
            PG8_STAGE(PG8_SB(0, 1), b2 + hstep, voffB);
            PG8_WAIT_V(6); PG8_BAR; PG8_MMA(1, 1, At, B1); PG8_BAR;
            PG8_LDB(B0, 1, 0); PG8_SCHED; PG8_LDA(At, 1, 0); PG8_STAGE(PG8_SA(0, 1), a2 + hstepA, voffA);
            PG8_WAIT_L(8); PG8_BAR; PG8_WAIT_L(0); PG8_MMA(0, 0, At, B0); PG8_BAR; PG8_SCHED;
            PG8_LDB(B1, 1, 1); PG8_STAGE(PG8_SB(1, 0), b3, voffB);
            PG8_BAR; PG8_WAIT_L(0); PG8_MMA(0, 1, At, B1); PG8_BAR;
            PG8_LDA(At, 1, 1); PG8_STAGE(PG8_SA(1, 0), a3, voffA);
            PG8_BAR; PG8_WAIT_L(0); PG8_MMA(1, 0, At, B0); PG8_BAR; PG8_SCHED;
            PG8_STAGE(PG8_SB(1, 1), b3 + hstep, voffB);
            PG8_WAIT_V(6); PG8_BAR; PG8_MMA(1, 1, At, B1); PG8_BAR;
            }
        }
        if constexpr (ALIGN_EPI) { if (wr == 0) PG8_BAR; }
        if constexpr (!Epi::AFTER_DRAIN) { E(acc, cur, wr, wc, fr, fq); S.done(cur); }
        if (!has_next) break;
#pragma unroll
        for (int a = 0; a < 2; ++a)
#pragma unroll
            for (int b = 0; b < 2; ++b)
#pragma unroll
                for (int m = 0; m < 4; ++m)
#pragma unroll
                    for (int n = 0; n < 2; ++n) acc[a][b][m][n] = (f32x4){0.f, 0.f, 0.f, 0.f};
        cur = nxt; cA = nA; cB = nB; ++ui;
        if constexpr (ALIGN_EPI) { if (wr == 1) PG8_BAR; }
    }
    PG8_WAIT_V(0);
    if constexpr (!ALIGN_EPI) { if (wr == 0) PG8_BAR; }
    PG8_BAR;
    if constexpr (Epi::AFTER_DRAIN) { E.fused(acc, cur, wr, wc, fr, fq, lds, wid, lane); S.done(cur); }
#undef PG8_SA
#undef PG8_SB
#undef PG8_STAGE
#undef PG8_LDA
#undef PG8_LDB
#undef PG8_MMA
#undef PG8_WAIT_V
#undef PG8_WAIT_L
#undef PG8_BAR
#undef PG8_SCHED
}
}

constexpr int BATCH = 8, SEQ = 4096, DM = 1024, DEPTH = 4, DFF = 2816, MTOK = BATCH * SEQ;
constexpr int ZW = 2816;
constexpr int Z_NQ = 0, Z_KC = 512, Z_VC = 640, Z_KS = 768, Z_VS = 896, Z_KW = 1024, Z_VW = 1152, Z_SQ = 1280, Z_SK = 1792, Z_SV = 1920,
              Z_MQ = 2048, Z_MKV = 2432, Z_MKR = 2688, Z_GATE = 2720;
constexpr int NCMP = 255;
constexpr float NORM_EPS = 1e-6f;
typedef unsigned short bf16_t;
typedef unsigned u32x4_t __attribute__((ext_vector_type(4)));

__device__ __forceinline__ float bf2f(bf16_t v) { return __uint_as_float(((unsigned)v) << 16); }
__device__ __forceinline__ float bflo(unsigned w) { return __uint_as_float(w << 16); }
__device__ __forceinline__ float bfhi(unsigned w) { return __uint_as_float(w & 0xffff0000u); }
__device__ __forceinline__ bf16_t f2bf(float f) { unsigned u = __float_as_uint(f); return (bf16_t)((u + 0x7fffu + ((u >> 16) & 1u)) >> 16); }
__device__ __forceinline__ float wave_sum(float v) {
#pragma unroll
    for (int o = 1; o < 64; o <<= 1) v += __shfl_xor(v, o);
    return v;
}
__device__ __forceinline__ int t5_bucket(int d) {
    if (d < 16) return d < 0 ? 0 : d;
    int b = 16;
    b += (d >= 21); b += (d >= 27); b += (d >= 35); b += (d >= 46); b += (d >= 59); b += (d >= 77); b += (d >= 99); b += (d >= 128);
    b += (d >= 166); b += (d >= 216); b += (d >= 280); b += (d >= 363); b += (d >= 470); b += (d >= 609); b += (d >= 790);
    return b;
}

namespace pg8 {
struct EpiStore {
    static constexpr bool PERM = true, AFTER_DRAIN = false;
    bf16_t* O; long ldc;
    __device__ __forceinline__ void operator()(const f32x4 (&acc)[2][2][4][2], const Unit& u, int wr, int wc, int fr, int fq) const {
        const int row0 = u.pm * BM + wr * 64 + fr, col0 = u.pn * BM + wc * 32 + 8 * fq;
#pragma unroll
        for (int ai = 0; ai < 2; ++ai)
#pragma unroll
            for (int m = 0; m < 4; ++m) { bf16_t* rowp = O + (size_t)(row0 + ai * HALF + m * 16) * ldc + col0;
#pragma unroll
                for (int bj = 0; bj < 2; ++bj) { const f32x4 v0 = acc[ai][bj][m][0], v1 = acc[ai][bj][m][1];
                    u32x4 w; w.x = cvt_pk_bf16(v0[0], v0[1]); w.y = cvt_pk_bf16(v0[2], v0[3]); w.z = cvt_pk_bf16(v1[0], v1[1]); w.w = cvt_pk_bf16(v1[2], v1[3]);
                    *(u32x4*)(rowp + bj * HALF) = w; } }
    }
};
__device__ __forceinline__ float sigm(float x) { return __builtin_amdgcn_rcpf(1.0f + __expf(-x)); }
struct EpiSigmoid {
    static constexpr bool PERM = true, AFTER_DRAIN = false;
    bf16_t* O; long ldc;
    __device__ __forceinline__ void operator()(const f32x4 (&acc)[2][2][4][2], const Unit& u, int wr, int wc, int fr, int fq) const {
        const int row0 = u.pm * BM + wr * 64 + fr, col0 = u.pn * BM + wc * 32 + 8 * fq;
#pragma unroll
        for (int ai = 0; ai < 2; ++ai)
#pragma unroll
            for (int m = 0; m < 4; ++m) { bf16_t* rowp = O + (size_t)(row0 + ai * HALF + m * 16) * ldc + col0;
#pragma unroll
                for (int bj = 0; bj < 2; ++bj) { const f32x4 v0 = acc[ai][bj][m][0], v1 = acc[ai][bj][m][1];
                    u32x4 w; w.x = cvt_pk_bf16(sigm(v0[0]), sigm(v0[1])); w.y = cvt_pk_bf16(sigm(v0[2]), sigm(v0[3])); w.z = cvt_pk_bf16(sigm(v1[0]), sigm(v1[1])); w.w = cvt_pk_bf16(sigm(v1[2]), sigm(v1[3]));
                    *(u32x4*)(rowp + bj * HALF) = w; } }
    }
};
struct EpiSwiGLU {
    static constexpr bool PERM = true, AFTER_DRAIN = false;
    bf16_t* O; long ldc;
    __device__ __forceinline__ void operator()(const f32x4 (&acc)[2][2][4][2], const Unit& u, int wr, int wc, int fr, int fq) const {
        const int row0 = u.pm * BM + wr * 64 + fr, col0 = u.pn * HALF + wc * 32 + 8 * fq;
#pragma unroll
        for (int ai = 0; ai < 2; ++ai)
#pragma unroll
            for (int m = 0; m < 4; ++m) { bf16_t* rowp = O + (size_t)(row0 + ai * HALF + m * 16) * ldc + col0;
                const f32x4 g0 = acc[ai][0][m][0], g1 = acc[ai][0][m][1], u0 = acc[ai][1][m][0], u1 = acc[ai][1][m][1];
                float r[8];
#pragma unroll
                for (int e = 0; e < 4; ++e) { r[e] = g0[e] * sigm(g0[e]) * u0[e]; r[4 + e] = g1[e] * sigm(g1[e]) * u1[e]; }
                u32x4 w; w.x = cvt_pk_bf16(r[0], r[1]); w.y = cvt_pk_bf16(r[2], r[3]); w.z = cvt_pk_bf16(r[4], r[5]); w.w = cvt_pk_bf16(r[6], r[7]);
                *(u32x4*)rowp = w; }
    }
};
}

template <class Epi> __global__ void __launch_bounds__(512, 2) k_gemm(pg8::Gemm g, Epi e) {
    extern __shared__ __attribute__((aligned(16))) unsigned char lds_dyn[];
    pg8::StaticOrder S; S.init(g.M, g.N, (int)gridDim.x, (int)blockIdx.x);
    pg8::gemm_phase<Epi, pg8::StaticOrder, true, true>((PG8_LAS unsigned char*)lds_dyn, g, S, e);
}

__global__ void k_tables(const float* __restrict__ table, float* __restrict__ BD, float* __restrict__ RC, float* __restrict__ RS) {
    const int i = blockIdx.x * blockDim.x + threadIdx.x;
    if (i < 16 * 4096) { const int h = i >> 12, d = i & 4095; BD[i] = table[t5_bucket(d) * 16 + h]; }
    if (i < 4096 * 16) { const int pos = i >> 4, j = i & 15; const float inv_freq = powf(10000.0f, -(float)j / 16.0f); const float ang = (float)pos * inv_freq; RC[i] = cosf(ang); RS[i] = sinf(ang); }
}
__device__ __forceinline__ int srccol(int mode, int n, int a, int b) {
    if (mode == 0) return n < b ? a + n : -1;
    if (mode == 1) { const int t = n >> 8, r = n & 255; return r < 128 ? 128 * t + r : DFF + 128 * t + (r - 128); }
    if (n < 1280) return n; if (n < 2720) return n + 24; if (n < 2744) return 1280 + (n - 2720); return -1;
}
__global__ void k_transpose(const float* __restrict__ W, int K, int N, bf16_t* __restrict__ Wt, int mode, int a, int b) {
    __shared__ float tile[32][33];
    const int k0 = blockIdx.x * 32, n0 = blockIdx.y * 32, tx = threadIdx.x & 31, ty = threadIdx.x >> 5;
    const int sc = srccol(mode, n0 + tx, a, b);
#pragma unroll
    for (int i = 0; i < 4; ++i) { const int k = k0 + ty + 8 * i; tile[ty + 8 * i][tx] = sc >= 0 ? W[(size_t)k * N + sc] : 0.f; }
    __syncthreads();
#pragma unroll
    for (int i = 0; i < 4; ++i) { const int n = n0 + ty + 8 * i; Wt[(size_t)n * K + k0 + tx] = f2bf(tile[tx][ty + 8 * i]); }
}
__global__ void k_rmsnorm(const float* __restrict__ x, const float* __restrict__ g, bf16_t* __restrict__ out) {
    const int lane = threadIdx.x & 63, row = blockIdx.x * 4 + (threadIdx.x >> 6);
    const float4* xr = (const float4*)(x + (size_t)row * DM); const float4* gr = (const float4*)g;
    float4 v[4]; float s = 0.f;
#pragma unroll
    for (int j = 0; j < 4; ++j) { v[j] = xr[j * 64 + lane]; s += v[j].x * v[j].x + v[j].y * v[j].y + v[j].z * v[j].z + v[j].w * v[j].w; }
    const float inv = rsqrtf(wave_sum(s) * (1.0f / DM) + NORM_EPS);
#pragma unroll
    for (int j = 0; j < 4; ++j) { const float4 gg = gr[j * 64 + lane]; ushort4 o; o.x = f2bf(v[j].x * inv * gg.x); o.y = f2bf(v[j].y * inv * gg.y); o.z = f2bf(v[j].z * inv * gg.z); o.w = f2bf(v[j].w * inv * gg.w);
        ((ushort4*)(out + (size_t)row * DM))[j * 64 + lane] = o; }
}
__global__ void k_resnorm(const bf16_t* __restrict__ y, const float* __restrict__ gpost, float scale, const float* xin, float* xout, const float* __restrict__ gnext, bf16_t* __restrict__ hn) {
    const int lane = threadIdx.x & 63, row = blockIdx.x * 4 + (threadIdx.x >> 6);
    const ushort4* yr = (const ushort4*)(y + (size_t)row * DM); const float4* xr = (const float4*)(xin + (size_t)row * DM);
    float4 v[4]; float s = 0.f;
#pragma unroll
    for (int j = 0; j < 4; ++j) { const ushort4 t = yr[j * 64 + lane]; v[j] = make_float4(bf2f(t.x), bf2f(t.y), bf2f(t.z), bf2f(t.w)); s += v[j].x * v[j].x + v[j].y * v[j].y + v[j].z * v[j].z + v[j].w * v[j].w; }
    const float inv = rsqrtf(wave_sum(s) * (1.0f / DM) + NORM_EPS) * scale;
    float s2 = 0.f;
#pragma unroll
    for (int j = 0; j < 4; ++j) { const float4 gg = ((const float4*)gpost)[j * 64 + lane]; const float4 xx = xr[j * 64 + lane];
        v[j].x = xx.x + v[j].x * inv * gg.x; v[j].y = xx.y + v[j].y * inv * gg.y; v[j].z = xx.z + v[j].z * inv * gg.z; v[j].w = xx.w + v[j].w * inv * gg.w;
        s2 += v[j].x * v[j].x + v[j].y * v[j].y + v[j].z * v[j].z + v[j].w * v[j].w; }
#pragma unroll
    for (int j = 0; j < 4; ++j) ((float4*)(xout + (size_t)row * DM))[j * 64 + lane] = v[j];
    if (hn) { const float inv2 = rsqrtf(wave_sum(s2) * (1.0f / DM) + NORM_EPS);
#pragma unroll
        for (int j = 0; j < 4; ++j) { const float4 gg = ((const float4*)gnext)[j * 64 + lane]; ushort4 o; o.x = f2bf(v[j].x * inv2 * gg.x); o.y = f2bf(v[j].y * inv2 * gg.y); o.z = f2bf(v[j].z * inv2 * gg.z); o.w = f2bf(v[j].w * inv2 * gg.w);
            ((ushort4*)(hn + (size_t)row * DM))[j * 64 + lane] = o; } }
}
__global__ void k_mla_prep(const bf16_t* __restrict__ Z, const float* __restrict__ gq, const float* __restrict__ gkv, const float* __restrict__ RC, const float* __restrict__ RS,
                           bf16_t* __restrict__ QN, bf16_t* __restrict__ KVN, float* __restrict__ KR) {
    const int lane = threadIdx.x & 63, row = blockIdx.x * 4 + (threadIdx.x >> 6), pos = row & (SEQ - 1);
    const bf16_t* z = Z + (size_t)row * ZW;
    float q[6], s = 0.f;
#pragma unroll
    for (int i = 0; i < 6; ++i) { q[i] = bf2f(z[Z_MQ + i * 64 + lane]); s += q[i] * q[i]; }
    const float invq = rsqrtf(wave_sum(s) * (1.0f / 384.0f) + NORM_EPS);
#pragma unroll
    for (int i = 0; i < 6; ++i) QN[(size_t)row * 384 + i * 64 + lane] = f2bf(q[i] * invq * gq[i * 64 + lane]);
    float kv[4]; s = 0.f;
#pragma unroll
    for (int i = 0; i < 4; ++i) { kv[i] = bf2f(z[Z_MKV + i * 64 + lane]); s += kv[i] * kv[i]; }
    const float invk = rsqrtf(wave_sum(s) * (1.0f / 256.0f) + NORM_EPS);
#pragma unroll
    for (int i = 0; i < 4; ++i) KVN[(size_t)row * 256 + i * 64 + lane] = f2bf(kv[i] * invk * gkv[i * 64 + lane]);
    if (lane < 16) { const float x1 = bf2f(z[Z_MKR + lane]), x2 = bf2f(z[Z_MKR + 16 + lane]); const float c = RC[pos * 16 + lane], sn = RS[pos * 16 + lane];
        KR[(size_t)row * 32 + lane] = x1 * c - x2 * sn; KR[(size_t)row * 32 + 16 + lane] = x1 * sn + x2 * c; }
}
__device__ __forceinline__ float gelu_tanh(float x) { const float u = 0.7978845608028654f * (x + 0.044715f * x * x * x); return 0.5f * x * (1.0f + tanhf(u)); }
__global__ void __launch_bounds__(128) k_nsa_compress(const bf16_t* __restrict__ Z, const float* __restrict__ pe_k, const float* __restrict__ w1_k, const float* __restrict__ w2_k,
                               const float* __restrict__ pe_v, const float* __restrict__ w1_v, const float* __restrict__ w2_v, float* __restrict__ KC, float* __restrict__ VC) {
    __shared__ float flat[2048]; __shared__ float hid[128];
    const int tid = threadIdx.x, c = blockIdx.x, hkv = blockIdx.y & 1, which = blockIdx.y >> 1, b = blockIdx.z;
    const float* pe = which ? pe_v : pe_k; const float* w1 = which ? w1_v : w1_k; const float* w2 = which ? w2_v : w2_k; float* out = which ? VC : KC;
    const int col = (which ? Z_VC : Z_KC) + hkv * 64;
    for (int i = tid; i < 2048; i += 128) { const int l = i >> 6, d = i & 63; flat[i] = bf2f(Z[(size_t)(b * SEQ + 16 * c + l) * ZW + col + d]) + pe[i]; }
    __syncthreads();
    float h = 0.f;
    for (int i = 0; i < 2048; ++i) h += flat[i] * w1[i * 128 + tid];
    hid[tid] = gelu_tanh(h);
    __syncthreads();
    if (tid < 64) { float o = 0.f; for (int j = 0; j < 128; ++j) o += hid[j] * w2[j * 64 + tid]; out[((size_t)(b * NCMP + c) * 2 + hkv) * 64 + tid] = o; }
}
__device__ __forceinline__ void load_q64(float (&q)[64], const bf16_t* p, float scale) {
    const uint4* p4 = (const uint4*)p;
#pragma unroll
    for (int i = 0; i < 8; ++i) { const uint4 w = p4[i];
        q[8 * i + 0] = bflo(w.x) * scale; q[8 * i + 1] = bfhi(w.x) * scale; q[8 * i + 2] = bflo(w.y) * scale; q[8 * i + 3] = bfhi(w.y) * scale;
        q[8 * i + 4] = bflo(w.z) * scale; q[8 * i + 5] = bfhi(w.z) * scale; q[8 * i + 6] = bflo(w.w) * scale; q[8 * i + 7] = bfhi(w.w) * scale; }
}
__device__ __forceinline__ float dot64_bf(const float (&q)[64], const bf16_t* k) {
    const uint4* k4 = (const uint4*)k; float s = 0.f;
#pragma unroll
    for (int i = 0; i < 8; ++i) { const uint4 w = k4[i];
        s += q[8 * i + 0] * bflo(w.x) + q[8 * i + 1] * bfhi(w.x) + q[8 * i + 2] * bflo(w.y) + q[8 * i + 3] * bfhi(w.y)
           + q[8 * i + 4] * bflo(w.z) + q[8 * i + 5] * bfhi(w.z) + q[8 * i + 6] * bflo(w.w) + q[8 * i + 7] * bfhi(w.w); }
    return s;
}
__device__ __forceinline__ float dot64_f(const float (&q)[64], const float* k) {
    const float4* k4 = (const float4*)k; float s = 0.f;
#pragma unroll
    for (int i = 0; i < 16; ++i) { const float4 w = k4[i]; s += q[4 * i] * w.x + q[4 * i + 1] * w.y + q[4 * i + 2] * w.z + q[4 * i + 3] * w.w; }
    return s;
}
__device__ __forceinline__ void upd_bf(float (&o)[64], float& m, float& l, float s, const bf16_t* v) {
    const float mn = fmaxf(m, s), c = __expf(m - mn), p = __expf(s - mn); l = l * c + p; m = mn;
    const uint4* v4 = (const uint4*)v;
#pragma unroll
    for (int i = 0; i < 8; ++i) { const uint4 w = v4[i];
        o[8 * i + 0] = o[8 * i + 0] * c + p * bflo(w.x); o[8 * i + 1] = o[8 * i + 1] * c + p * bfhi(w.x); o[8 * i + 2] = o[8 * i + 2] * c + p * bflo(w.y); o[8 * i + 3] = o[8 * i + 3] * c + p * bfhi(w.y);
        o[8 * i + 4] = o[8 * i + 4] * c + p * bflo(w.z); o[8 * i + 5] = o[8 * i + 5] * c + p * bfhi(w.z); o[8 * i + 6] = o[8 * i + 6] * c + p * bflo(w.w); o[8 * i + 7] = o[8 * i + 7] * c + p * bfhi(w.w); }
}
template <bool ACCUM> __device__ __forceinline__ void store_o64(bf16_t* O, const float (&o)[64], float f) {
    uint4* O4 = (uint4*)O;
#pragma unroll
    for (int i = 0; i < 8; ++i) { float r[8];
#pragma unroll
        for (int e = 0; e < 8; ++e) r[e] = o[8 * i + e] * f;
        if (ACCUM) { const uint4 w = O4[i]; r[0] += bflo(w.x); r[1] += bfhi(w.x); r[2] += bflo(w.y); r[3] += bfhi(w.y); r[4] += bflo(w.z); r[5] += bfhi(w.z); r[6] += bflo(w.w); r[7] += bfhi(w.w); }
        uint4 w; w.x = (unsigned)f2bf(r[0]) | ((unsigned)f2bf(r[1]) << 16); w.y = (unsigned)f2bf(r[2]) | ((unsigned)f2bf(r[3]) << 16);
        w.z = (unsigned)f2bf(r[4]) | ((unsigned)f2bf(r[5]) << 16); w.w = (unsigned)f2bf(r[6]) | ((unsigned)f2bf(r[7]) << 16); O4[i] = w; }
}
__device__ __forceinline__ float sigmoidf_(float x) { return 1.0f / (1.0f + __expf(-x)); }

template <int WINDOW, bool IS_SWA> __global__ void __launch_bounds__(64) k_band_attn(const bf16_t* __restrict__ Z, const float* __restrict__ BD, const float* __restrict__ sinks, bf16_t* __restrict__ O) {
    const int lane = threadIdx.x, t0 = blockIdx.x * 64, h = blockIdx.y, b = blockIdx.z, t = t0 + lane, hkv = h >> 2;
    const size_t rowq = (size_t)(b * SEQ + t);
    const int qcol = (IS_SWA ? Z_SQ : Z_NQ) + h * 64, kcol = (IS_SWA ? Z_SK : Z_KW) + hkv * 64, vcol = (IS_SWA ? Z_SV : Z_VW) + hkv * 64;
    const float* bd = BD + (IS_SWA ? 8 + h : h) * 4096;
    float q[64], o[64]; load_q64(q, Z + rowq * ZW + qcol, 0.125f);
#pragma unroll
    for (int d = 0; d < 64; ++d) o[d] = 0.f;
    float m = -1e30f, l = 0.f;
    const int s_lo = t0 - (WINDOW - 1) > 0 ? t0 - (WINDOW - 1) : 0, s_hi = t0 + 63;
    for (int s = s_lo; s <= s_hi; ++s) {
        const bf16_t* kr = Z + (size_t)(b * SEQ + s) * ZW; const int dist = t - s; const bool valid = dist >= 0 && dist < WINDOW;
        const float sc = dot64_bf(q, kr + kcol) + bd[valid ? dist : 0];
        if (valid) upd_bf(o, m, l, sc, kr + vcol);
    }
    if (IS_SWA) { const float sk = sinks[h], mf = fmaxf(m, sk), c = __expf(m - mf); const float den = l * c + __expf(sk - mf); store_o64<false>(O + rowq * 512 + h * 64, o, c / den); }
    else { const float g = sigmoidf_(bf2f(Z[rowq * ZW + Z_GATE + h * 3 + 2])); store_o64<false>(O + rowq * 512 + h * 64, o, g / l); }
}
__global__ void __launch_bounds__(64) k_nsa_cmp(const bf16_t* __restrict__ Z, const float* __restrict__ BD, const float* __restrict__ KC, const float* __restrict__ VC, bf16_t* __restrict__ OA, unsigned long long* __restrict__ SEL) {
    __shared__ float imp[64 * 65];
    const int lane = threadIdx.x, t0 = blockIdx.x * 64, hkv = blockIdx.y, b = blockIdx.z, t = t0 + lane;
    const size_t rowq = (size_t)(b * SEQ + t);
    for (int j = 0; j < 64; ++j) imp[lane * 65 + j] = 0.f;
    const int ncmax = (t0 + 63 >= 31) ? (t0 + 63 - 31) / 16 + 1 : 0;
    const int ncv = (t >= 31) ? (t - 31) / 16 + 1 : 0;
    for (int g = 0; g < 4; ++g) {
        const int h = hkv * 4 + g; const float* bd = BD + h * 4096;
        float q[64], o[64]; load_q64(q, Z + rowq * ZW + Z_NQ + h * 64, 0.125f);
        float m = -1e30f, l = 0.f;
        for (int c = 0; c < ncmax; ++c) { const bool valid = c < ncv; const int dist = t - (16 * c + 31);
            const float sc = dot64_f(q, KC + ((size_t)(b * NCMP + c) * 2 + hkv) * 64) + bd[valid ? dist : 0];
            if (valid) { const float mn = fmaxf(m, sc); l = l * __expf(m - mn) + __expf(sc - mn); m = mn; } }
        const float rl = l > 0.f ? 1.0f / l : 0.f;
#pragma unroll
        for (int d = 0; d < 64; ++d) o[d] = 0.f;
        for (int c = 0; c < ncmax; ++c) { const bool valid = c < ncv; const int dist = t - (16 * c + 31);
            const float* kc = KC + ((size_t)(b * NCMP + c) * 2 + hkv) * 64; const float* vc = VC + ((size_t)(b * NCMP + c) * 2 + hkv) * 64;
            const float sc = dot64_f(q, kc) + bd[valid ? dist : 0];
            const float p = valid ? __expf(sc - m) * rl : 0.f;
            const float4* v4 = (const float4*)vc;
#pragma unroll
            for (int i = 0; i < 16; ++i) { const float4 w = v4[i]; o[4 * i] += p * w.x; o[4 * i + 1] += p * w.y; o[4 * i + 2] += p * w.z; o[4 * i + 3] += p * w.w; }
            const int j = c >> 2;
            if ((c & 3) < 3) imp[lane * 65 + j] += p; else { imp[lane * 65 + j] += 0.5f * p; if (j + 1 < 64) imp[lane * 65 + j + 1] += 0.5f * p; } }
        const float gt = sigmoidf_(bf2f(Z[rowq * ZW + Z_GATE + h * 3 + 0]));
        store_o64<true>(OA + rowq * 512 + h * 64, o, gt);
    }
    const int cur = t >> 6;
    unsigned long long mask = 1ull | (1ull << cur); if (cur >= 1) mask |= 1ull << (cur - 1);
    int need = 16 - __popcll(mask);
    for (int it = 0; it < 13; ++it) { if (it >= need) break;
        float best = -1.f; int bj = -1;
        for (int j = 1; j <= cur - 2; ++j) { const float v = imp[lane * 65 + j]; if (!((mask >> j) & 1ull) && v > best) { best = v; bj = j; } }
        if (bj < 0) break; mask |= 1ull << bj; }
    SEL[(size_t)(b * 2 + hkv) * SEQ + t] = mask;
}
__global__ void __launch_bounds__(64) k_nsa_sel(const bf16_t* __restrict__ Z, const float* __restrict__ BD, const unsigned long long* __restrict__ SEL, bf16_t* __restrict__ OA) {
    const int lane = threadIdx.x, t0 = blockIdx.x * 64, h = blockIdx.y, b = blockIdx.z, t = t0 + lane, hkv = h >> 2, cur = t0 >> 6;
    const size_t rowq = (size_t)(b * SEQ + t);
    const float* bd = BD + h * 4096;
    const unsigned long long mask = SEL[(size_t)(b * 2 + hkv) * SEQ + t];
    float q[64], o[64]; load_q64(q, Z + rowq * ZW + Z_NQ + h * 64, 0.125f);
#pragma unroll
    for (int d = 0; d < 64; ++d) o[d] = 0.f;
    float m = -1e30f, l = 0.f;
    for (int j = 0; j <= cur; ++j) { const bool need = (mask >> j) & 1ull; if (!__any(need)) continue;
        for (int p = 0; p < 64; ++p) { const int s = 64 * j + p; const int dist = t - s; const bool valid = need && dist >= 0;
            const bf16_t* kr = Z + (size_t)(b * SEQ + s) * ZW;
            const float sc = dot64_bf(q, kr + Z_KS + hkv * 64) + bd[valid ? dist : 0];
            if (valid) upd_bf(o, m, l, sc, kr + Z_VS + hkv * 64); } }
    const float g = sigmoidf_(bf2f(Z[rowq * ZW + Z_GATE + h * 3 + 1]));
    store_o64<true>(OA + rowq * 512 + h * 64, o, g / l);
}
__global__ void __launch_bounds__(64) k_mla_attn(const bf16_t* __restrict__ MQ, const bf16_t* __restrict__ MKV, const float* __restrict__ KR, const float* __restrict__ RC, const float* __restrict__ RS, bf16_t* __restrict__ OC) {
    const int lane = threadIdx.x, t0 = blockIdx.x * 64, h = blockIdx.y, b = blockIdx.z, t = t0 + lane;
    const size_t rowq = (size_t)(b * SEQ + t);
    const float scale = 0.10206207261596577f;
    float q[64], qr[32], o[64]; load_q64(q, MQ + rowq * 768 + h * 96, scale);
    { const bf16_t* p = MQ + rowq * 768 + h * 96 + 64;
#pragma unroll
      for (int i = 0; i < 16; ++i) { const float x1 = bf2f(p[i]), x2 = bf2f(p[16 + i]); const float c = RC[t * 16 + i], sn = RS[t * 16 + i]; qr[i] = (x1 * c - x2 * sn) * scale; qr[16 + i] = (x1 * sn + x2 * c) * scale; } }
#pragma unroll
    for (int d = 0; d < 64; ++d) o[d] = 0.f;
    float m = -1e30f, l = 0.f;
    for (int s = 0; s <= t0 + 63; ++s) { const size_t rk = (size_t)(b * SEQ + s); const bf16_t* kv = MKV + rk * 1024 + h * 128; const float4* kr4 = (const float4*)(KR + rk * 32);
        float sc = dot64_bf(q, kv);
#pragma unroll
        for (int i = 0; i < 8; ++i) { const float4 w = kr4[i]; sc += qr[4 * i] * w.x + qr[4 * i + 1] * w.y + qr[4 * i + 2] * w.z + qr[4 * i + 3] * w.w; }
        if (s <= t) upd_bf(o, m, l, sc, kv + 64); }
    store_o64<false>(OC + rowq * 512 + h * 64, o, 1.0f / l);
}
template <bool SIG> __global__ void k_merge(const bf16_t* __restrict__ G, const bf16_t* __restrict__ Y, bf16_t* __restrict__ out) {
    const size_t i = (size_t)blockIdx.x * blockDim.x + threadIdx.x;
    const size_t row = i >> 7; const int c = (int)(i & 127) * 8;
    float r[8];
#pragma unroll
    for (int e = 0; e < 8; ++e) r[e] = 0.f;
#pragma unroll
    for (int n = 0; n < 3; ++n) { const uint4 g = *(const uint4*)(G + row * 3072 + n * 1024 + c); const uint4 y = *(const uint4*)(Y + row * 3072 + n * 1024 + c);
        float gg[8] = {bflo(g.x), bfhi(g.x), bflo(g.y), bfhi(g.y), bflo(g.z), bfhi(g.z), bflo(g.w), bfhi(g.w)};
        const float yy[8] = {bflo(y.x), bfhi(y.x), bflo(y.y), bfhi(y.y), bflo(y.z), bfhi(y.z), bflo(y.w), bfhi(y.w)};
#pragma unroll
        for (int e = 0; e < 8; ++e) { if (SIG) gg[e] = sigmoidf_(gg[e]); r[e] += gg[e] * yy[e]; } }
    uint4 w; w.x = (unsigned)f2bf(r[0]) | ((unsigned)f2bf(r[1]) << 16); w.y = (unsigned)f2bf(r[2]) | ((unsigned)f2bf(r[3]) << 16);
    w.z = (unsigned)f2bf(r[4]) | ((unsigned)f2bf(r[5]) << 16); w.w = (unsigned)f2bf(r[6]) | ((unsigned)f2bf(r[7]) << 16);
    *(uint4*)(out + row * 1024 + c) = w;
}

constexpr size_t MiB = 1ull << 20;
constexpr size_t WS_BD = 1 * MiB;
constexpr size_t WS_RC = WS_BD + 256 * 1024;
constexpr size_t WS_RS = WS_RC + 256 * 1024;
constexpr size_t WS_KC = 2 * MiB, WS_VC = 3 * MiB;
constexpr size_t WS_SEL = 4 * MiB;
constexpr size_t WS_KR = 4 * MiB + 512 * 1024;
constexpr size_t WS_WT = 9 * MiB;
constexpr size_t WT_GU1 = 0, WT_D1 = WT_GU1 + 11 * MiB, WT_GU2 = WT_D1 + 5632 * 1024, WT_D2 = WT_GU2 + 11 * MiB, WT_ZA = WT_D2 + 5632 * 1024,
                 WT_G = WT_ZA + 5632 * 1024, WT_B = WT_G + 6 * MiB, WT_OUT = WT_B + 3 * MiB, WT_QB = WT_OUT + 2 * MiB, WT_KVB = WT_QB + 768 * 384 * 2, WT_END = WT_KVB + 1024 * 256 * 2;
static_assert(WT_END <= 51 * MiB, "weights region");
constexpr size_t WS_HN = 60 * MiB;
constexpr size_t WS_RA = 124 * MiB;
constexpr size_t WS_RB = 300 * MiB;
constexpr size_t WS_RCC = 412 * MiB;
constexpr size_t WS_END = 508 * MiB;
constexpr size_t WS_YCAT = WS_RA, WS_G = WS_RA + 192 * MiB;
static_assert(WS_G + 192 * MiB == WS_END, "overlay map");

#ifndef BISECT
#define BISECT 0
#endif
__global__ void k_copyz(const bf16_t* Z, bf16_t* O) { size_t i = (size_t)blockIdx.x * 256 + threadIdx.x; size_t row = i / 1536; int c = (int)(i % 1536); O[(size_t)(c >> 9) * MTOK * 512 + row * 512 + (c & 511)] = Z[row * ZW + c]; }
#ifndef REFMASK
#define REFMASK 0
#endif
#ifndef GSTORE
#define GSTORE 0
#endif
#ifndef STOP_AT
#define STOP_AT 0
#endif
static void launch_transpose(const float* W, int K, int N, bf16_t* Wt, int Ndst, int mode, int a, int b, hipStream_t st) {
    k_transpose<<<dim3(K / 32, Ndst / 32), 256, 0, st>>>(W, K, N, Wt, mode, a, b);
}
template <class Epi> static void launch_gemm(const bf16_t* A, int lda, const bf16_t* Bt, int N, int K, bf16_t* O, long ldc, hipStream_t st) {
    static bool attr = false;
    if (!attr) { (void)hipFuncSetAttribute((const void*)k_gemm<Epi>, hipFuncAttributeMaxDynamicSharedMemorySize, 131072); attr = true; }
    pg8::Gemm g; g.A = A; g.Bt = Bt; g.M = MTOK; g.N = N; g.K = K; g.lda = lda;
    Epi e; e.O = O; e.ldc = ldc;
    k_gemm<Epi><<<256, 512, 131072, st>>>(g, e);
}


__global__ void k_gemm_ref(const bf16_t* __restrict__ A, int lda, const bf16_t* __restrict__ Bt, int N, int K, bf16_t* __restrict__ O, long ldc, int mode) {
    const int col = blockIdx.x * 16 + (threadIdx.x & 15), row = blockIdx.y * 16 + (threadIdx.x >> 4);
    const uint4* a = (const uint4*)(A + (size_t)row * lda); const uint4* b = (const uint4*)(Bt + (size_t)col * K);
    float s = 0.f;
    for (int k = 0; k < K / 8; ++k) { const uint4 x = a[k], y = b[k];
        s += bflo(x.x) * bflo(y.x) + bfhi(x.x) * bfhi(y.x) + bflo(x.y) * bflo(y.y) + bfhi(x.y) * bfhi(y.y) + bflo(x.z) * bflo(y.z) + bfhi(x.z) * bfhi(y.z) + bflo(x.w) * bflo(y.w) + bfhi(x.w) * bfhi(y.w); }
    if (mode == 1) s = 1.0f / (1.0f + __expf(-s));
    O[(size_t)row * ldc + col] = f2bf(s);
}
template <class Epi> static void launch_gemm_ref(const bf16_t* A, int lda, const bf16_t* Bt, int N, int K, bf16_t* O, long ldc, hipStream_t st, int mode) {
    k_gemm_ref<<<dim3(N / 16, MTOK / 16), 256, 0, st>>>(A, lda, Bt, N, K, O, ldc, mode);
}

extern "C" void kernel_launch(void* const* d_in, const int* in_sizes, int n_in, void* d_out, int out_size, void* d_ws, size_t ws_size, hipStream_t stream) {
    if (n_in != 26 || out_size != MTOK * DM || ws_size < WS_END) { fprintf(stderr, "kernel_launch: unexpected shapes (n_in %d out %d ws %zu)\n", n_in, out_size, ws_size); return; }
    const float* const* in = (const float* const*)d_in;
    unsigned char* ws = (unsigned char*)d_ws; float* xo = (float*)d_out;
    float *BD = (float*)(ws + WS_BD), *RC = (float*)(ws + WS_RC), *RS = (float*)(ws + WS_RS), *KC = (float*)(ws + WS_KC), *VC = (float*)(ws + WS_VC), *KR = (float*)(ws + WS_KR);
    unsigned long long* SEL = (unsigned long long*)(ws + WS_SEL);
    bf16_t* wt = (bf16_t*)(ws + WS_WT);
    bf16_t *Wgu1 = (bf16_t*)(ws + WS_WT + WT_GU1), *Wd1 = (bf16_t*)(ws + WS_WT + WT_D1), *Wgu2 = (bf16_t*)(ws + WS_WT + WT_GU2), *Wd2 = (bf16_t*)(ws + WS_WT + WT_D2), *Wza = (bf16_t*)(ws + WS_WT + WT_ZA),
           *Wg = (bf16_t*)(ws + WS_WT + WT_G), *Wb = (bf16_t*)(ws + WS_WT + WT_B), *Wout = (bf16_t*)(ws + WS_WT + WT_OUT), *Wqb = (bf16_t*)(ws + WS_WT + WT_QB), *Wkvb = (bf16_t*)(ws + WS_WT + WT_KVB);
    (void)wt;
    bf16_t *HN = (bf16_t*)(ws + WS_HN), *ACT = (bf16_t*)(ws + WS_RA), *Zb = (bf16_t*)(ws + WS_RA), *Y = (bf16_t*)(ws + WS_RB), *MQ = (bf16_t*)(ws + WS_RB), *MKV = (bf16_t*)(ws + WS_RB + 48 * MiB),
           *QN = (bf16_t*)(ws + WS_RCC), *KVN = (bf16_t*)(ws + WS_RCC + 24 * MiB), *OA = (bf16_t*)(ws + WS_RCC), *OB = (bf16_t*)(ws + WS_RCC + 32 * MiB), *OC = (bf16_t*)(ws + WS_RCC + 64 * MiB),
           *YCAT = (bf16_t*)(ws + WS_YCAT), *G = (bf16_t*)(ws + WS_G), *MERGED = HN, *MOUT = (bf16_t*)(ws + WS_YCAT);
    k_tables<<<256, 256, 0, stream>>>(in[1], BD, RC, RS);
    for (int l = 0; l < DEPTH; ++l) {
        const float *g_f1pre = in[2] + (size_t)l * DM, *w_gu1 = in[3] + (size_t)l * DM * 2 * DFF, *w_d1 = in[4] + (size_t)l * DFF * DM, *g_f1post = in[5] + (size_t)l * DM,
                    *g_mpre = in[6] + (size_t)l * DM, *w_in = in[7] + (size_t)l * DM * 5816, *pe_k = in[8] + (size_t)l * 2048, *w1_k = in[9] + (size_t)l * 2048 * 128, *w2_k = in[10] + (size_t)l * 128 * 64,
                    *pe_v = in[11] + (size_t)l * 2048, *w1_v = in[12] + (size_t)l * 2048 * 128, *w2_v = in[13] + (size_t)l * 128 * 64, *sinks = in[14] + (size_t)l * 8, *g_q = in[15] + (size_t)l * 384,
                    *w_qb = in[16] + (size_t)l * 384 * 768, *g_kv = in[17] + (size_t)l * 256, *w_kvb = in[18] + (size_t)l * 256 * 1024, *w_br = in[19] + (size_t)l * 3 * 512 * 1024, *w_out = in[20] + (size_t)l * DM * DM,
                    *g_mpost = in[21] + (size_t)l * DM, *g_f2pre = in[22] + (size_t)l * DM, *w_gu2 = in[23] + (size_t)l * DM * 2 * DFF, *w_d2 = in[24] + (size_t)l * DFF * DM, *g_f2post = in[25] + (size_t)l * DM;
        launch_transpose(w_gu1, DM, 2 * DFF, Wgu1, 2 * DFF, 1, 0, 0, stream);
        launch_transpose(w_d1, DFF, DM, Wd1, DM, 0, 0, DM, stream);
        launch_transpose(w_gu2, DM, 2 * DFF, Wgu2, 2 * DFF, 1, 0, 0, stream);
        launch_transpose(w_d2, DFF, DM, Wd2, DM, 0, 0, DM, stream);
        launch_transpose(w_in, DM, 5816, Wza, ZW, 2, 0, 0, stream);
        launch_transpose(w_in, DM, 5816, Wg, 3072, 0, 2744, 3072, stream);
        for (int n = 0; n < 3; ++n) launch_transpose(w_br + (size_t)n * 512 * 1024, 512, 1024, Wb + (size_t)n * 1024 * 512, 1024, 0, 0, 1024, stream);
        launch_transpose(w_out, DM, DM, Wout, DM, 0, 0, DM, stream);
        launch_transpose(w_qb, 384, 768, Wqb, 768, 0, 0, 768, stream);
        launch_transpose(w_kvb, 256, 1024, Wkvb, 1024, 0, 0, 1024, stream);
        if (l == 0) k_rmsnorm<<<MTOK / 4, 256, 0, stream>>>(in[0], g_f1pre, HN);
        launch_gemm<pg8::EpiSwiGLU>(HN, DM, Wgu1, 2 * DFF, DM, ACT, DFF, stream);
        launch_gemm<pg8::EpiStore>(ACT, DFF, Wd1, DM, DFF, Y, DM, stream);
        k_resnorm<<<MTOK / 4, 256, 0, stream>>>(Y, g_f1post, 0.5f, l == 0 ? in[0] : xo, xo, g_mpre, HN);
        if (STOP_AT == 1) return;
        if (REFMASK & 1) launch_gemm_ref<pg8::EpiStore>(HN, DM, Wza, ZW, DM, Zb, ZW, stream, 0); else launch_gemm<pg8::EpiStore>(HN, DM, Wza, ZW, DM, Zb, ZW, stream);
#if BISECT == 1
        k_copyz<<<MTOK * 1536 / 256, 256, 0, stream>>>(Zb, OA);
#else
        k_mla_prep<<<MTOK / 4, 256, 0, stream>>>(Zb, g_q, g_kv, RC, RS, QN, KVN, KR);
        launch_gemm<pg8::EpiStore>(QN, 384, Wqb, 768, 384, MQ, 768, stream);
        launch_gemm<pg8::EpiStore>(KVN, 256, Wkvb, 1024, 256, MKV, 1024, stream);
        k_nsa_compress<<<dim3(NCMP, 4, BATCH), 128, 0, stream>>>(Zb, pe_k, w1_k, w2_k, pe_v, w1_v, w2_v, KC, VC);
        k_band_attn<512, false><<<dim3(SEQ / 64, 8, BATCH), 64, 0, stream>>>(Zb, BD, sinks, OA);
        k_nsa_cmp<<<dim3(SEQ / 64, 2, BATCH), 64, 0, stream>>>(Zb, BD, KC, VC, OA, SEL);
        k_nsa_sel<<<dim3(SEQ / 64, 8, BATCH), 64, 0, stream>>>(Zb, BD, SEL, OA);
        k_band_attn<128, true><<<dim3(SEQ / 64, 8, BATCH), 64, 0, stream>>>(Zb, BD, sinks, OB);
        k_mla_attn<<<dim3(SEQ / 64, 8, BATCH), 64, 0, stream>>>(MQ, MKV, KR, RC, RS, OC);
#endif
        if (STOP_AT == 2) return;
        if (REFMASK & 2) launch_gemm_ref<pg8::EpiStore>(OA, 512, Wb, DM, 512, YCAT, 3072, stream, 0); else launch_gemm<pg8::EpiStore>(OA, 512, Wb, DM, 512, YCAT, 3072, stream);
        if (REFMASK & 2) launch_gemm_ref<pg8::EpiStore>(OB, 512, Wb + (size_t)1024 * 512, DM, 512, YCAT + 1024, 3072, stream, 0); else launch_gemm<pg8::EpiStore>(OB, 512, Wb + (size_t)1024 * 512, DM, 512, YCAT + 1024, 3072, stream);
        if (REFMASK & 2) launch_gemm_ref<pg8::EpiStore>(OC, 512, Wb + (size_t)2 * 1024 * 512, DM, 512, YCAT + 2048, 3072, stream, 0); else launch_gemm<pg8::EpiStore>(OC, 512, Wb + (size_t)2 * 1024 * 512, DM, 512, YCAT + 2048, 3072, stream);
        if (REFMASK & 4) launch_gemm_ref<pg8::EpiSigmoid>(HN, DM, Wg, 3072, DM, G, 3072, stream, 1); else if (GSTORE) launch_gemm<pg8::EpiStore>(HN, DM, Wg, 3072, DM, G, 3072, stream); else launch_gemm<pg8::EpiSigmoid>(HN, DM, Wg, 3072, DM, G, 3072, stream);
        if (GSTORE) k_merge<true><<<MTOK * DM / 8 / 256, 256, 0, stream>>>(G, YCAT, MERGED); else k_merge<false><<<MTOK * DM / 8 / 256, 256, 0, stream>>>(G, YCAT, MERGED);
        if (REFMASK & 8) launch_gemm_ref<pg8::EpiStore>(MERGED, DM, Wout, DM, DM, MOUT, DM, stream, 0); else launch_gemm<pg8::EpiStore>(MERGED, DM, Wout, DM, DM, MOUT, DM, stream);
        k_resnorm<<<MTOK / 4, 256, 0, stream>>>(MOUT, g_mpost, 1.0f, xo, xo, g_f2pre, HN);
        if (STOP_AT == 3) return;
        launch_gemm<pg8::EpiSwiGLU>(HN, DM, Wgu2, 2 * DFF, DM, ACT, DFF, stream);
        launch_gemm<pg8::EpiStore>(ACT, DFF, Wd2, DM, DFF, Y, DM, stream);
        k_resnorm<<<MTOK / 4, 256, 0, stream>>>(Y, g_f2post, 0.5f, xo, xo, l + 1 < DEPTH ? in[2] + (size_t)(l + 1) * DM : nullptr, l + 1 < DEPTH ? HN : nullptr);
    }
}
```

```cpp
#include <hip/hip_runtime.h>
#include <cstdio>
#include <cstdint>
namespace pg8 {
#define PG8_LAS __attribute__((address_space(3)))
typedef unsigned short bf16_t;
typedef short bf16x8 __attribute__((ext_vector_type(8)));
typedef float f32x4 __attribute__((ext_vector_type(4)));
typedef unsigned u32x4 __attribute__((ext_vector_type(4)));
constexpr int BM = 256, BK = 64, HALF = 128, HTB = HALF * BK * 2  , STAGE_BYTES = 8 * HTB, NXCD = 8, WGM = 8;

__host__ __device__ __forceinline__ int lds_byte(int r, int c) { const int st = (r >> 4) * 2 + (c >> 5), rr = r & 15, cc = c & 31, ob = rr * 64 + cc * 2; return st * 1024 + (ob ^ (((ob >> 9) & 1) << 5)); }
__host__ __device__ __forceinline__ void stage_rc(int b, int& R, int& C) { const int st = b / 1024, sb = b % 1024, swz = sb ^ (((sb >> 9) & 1) << 5); R = (st >> 1) * 16 + swz / 64; C = (st & 1) * 32 + (swz % 64) / 2; }
__host__ __device__ __forceinline__ int perm32(int rho) { const int n = rho >> 4, i = rho & 15; return 8 * (i >> 2) + 4 * n + (i & 3); }

struct Unit { int pm, pn; };
struct Gemm { const bf16_t* A; const bf16_t* Bt; int M, N, K, lda; };

struct StaticOrder {
    int nM, nN, nwg, G, c;
    __host__ __device__ void init(int M, int N, int G_, int c_) { nM = M / BM; nN = N / BM; nwg = nM * nN; G = G_; c = c_; }
    __host__ __device__ bool next(int i, Unit& u) const {
        const long L = (long)i * G + c; if (L >= nwg) return false;
        int wgid = (int)L; { const int q = nwg / NXCD, r = nwg % NXCD, xcd = wgid % NXCD, off = wgid / NXCD; wgid = (xcd < r ? xcd * (q + 1) : r * (q + 1) + (xcd - r) * q) + off; }
        const int nig = WGM * nN, gid = wgid / nig, fm = gid * WGM, gsz = (nM - fm) < WGM ? (nM - fm) : WGM;
        u.pm = fm + ((wgid % nig) % gsz); u.pn = (wgid % nig) / gsz; return true;
    }
    __device__ __forceinline__ void a_ready(const Unit&) const {}
    __device__ __forceinline__ void done(const Unit&) const {}
};

typedef float f32x2c_t __attribute__((ext_vector_type(2))); typedef __bf16 bf16x2c_t __attribute__((ext_vector_type(2)));
__device__ __forceinline__ unsigned cvt_pk_bf16(float lo, float hi) { f32x2c_t v = {lo, hi}; bf16x2c_t b = __builtin_convertvector(v, bf16x2c_t); return __builtin_bit_cast(unsigned, b); }
typedef float f32x2 __attribute__((ext_vector_type(2)));
__device__ __forceinline__ f32x2 gelu_pk(f32x2 v) {
    const f32x2 av = __builtin_elementwise_abs(v), d = av * 0.2316418882f + 1.0f;
    f32x2 t; t.x = __builtin_amdgcn_rcpf(d.x); t.y = __builtin_amdgcn_rcpf(d.y);
    f32x2 q = t * 0.5307027145f + (-0.7265760135f); q = q * t + 0.7107068705f; q = q * t + (-0.142248368f); q = q * t + 0.127414796f; q = q * t;
    const f32x2 s = (v * v) * (-0.72134752044f);
    f32x2 e; e.x = __builtin_amdgcn_exp2f(s.x); e.y = __builtin_amdgcn_exp2f(s.y);
    const f32x2 m = v * (q * e), r = v - m;
    f32x2 o; o.x = v.x < 0.f ? m.x : r.x; o.y = v.y < 0.f ? m.y : r.y; return o;
}

template <int ACT  > struct EpiBf16 {
    static constexpr bool PERM = true, AFTER_DRAIN = false; static_assert(ACT == 0 || ACT == 1, "EpiBf16: ACT is 0 (none) or 1 (gelu_pk)");
    bf16_t* O; int ldc; const float* bias; int split_cols; size_t split_stride; float scale0;
    __device__ __forceinline__ void operator()(const f32x4 (&acc)[2][2][4][2], const Unit& u, int wr, int wc, int fr, int fq) const {
        const int row0 = u.pm * BM + wr * 64 + fr; int colt = u.pn * BM; bf16_t* base = O;
        float sc = 1.f; if (split_cols) { const int t = colt / split_cols; base += (size_t)t * split_stride; colt -= t * split_cols; if (t == 0) sc = scale0; }
        const int col0 = colt + wc * 32 + 8 * fq, bcol0 = u.pn * BM + wc * 32 + 8 * fq;
        f32x4 bv[2][2];
#pragma unroll
        for (int bj = 0; bj < 2; ++bj)
#pragma unroll
            for (int n = 0; n < 2; ++n) bv[bj][n] = bias ? *(const f32x4*)(bias + bcol0 + bj * HALF + 4 * n) : (f32x4){0.f, 0.f, 0.f, 0.f};
#pragma unroll
        for (int ai = 0; ai < 2; ++ai)
#pragma unroll
            for (int m = 0; m < 4; ++m) { bf16_t* rowp = base + (size_t)(row0 + ai * HALF + m * 16) * ldc + col0;
#pragma unroll
                for (int bj = 0; bj < 2; ++bj) { f32x4 v0 = acc[ai][bj][m][0] + bv[bj][0], v1 = acc[ai][bj][m][1] + bv[bj][1];
                    if (ACT == 1) { f32x2 a = gelu_pk((f32x2){v0[0], v0[1]}), b = gelu_pk((f32x2){v0[2], v0[3]}), c = gelu_pk((f32x2){v1[0], v1[1]}), d = gelu_pk((f32x2){v1[2], v1[3]});
                        v0 = (f32x4){a.x, a.y, b.x, b.y}; v1 = (f32x4){c.x, c.y, d.x, d.y}; }
                    v0 = v0 * sc; v1 = v1 * sc; u32x4 w; w.x = cvt_pk_bf16(v0[0], v0[1]); w.y = cvt_pk_bf16(v0[2], v0[3]); w.z = cvt_pk_bf16(v1[0], v1[1]); w.w = cvt_pk_bf16(v1[2], v1[3]);
                    *(u32x4*)(rowp + bj * HALF) = w; } }
    }
};

struct PanelStats {
    unsigned* xbuf;
    unsigned* cnt;
    unsigned* tmo;
    int ntn; float eps;
    unsigned code;
    __device__ __forceinline__ bool run(const f32x4 (&v)[2][2][4][2], const Unit& u, int wr, int wc, int fr, int fq, PG8_LAS unsigned char* lds, int wid, int lane) const {
        typedef float f32x2v __attribute__((ext_vector_type(2)));
        PG8_LAS f32x2v* P = (PG8_LAS f32x2v*)lds;
        PG8_LAS f32x2v* S = (PG8_LAS f32x2v*)(lds + 8192);
        PG8_LAS unsigned* flag = (PG8_LAS unsigned*)(lds + 8192 + 2048);
#pragma unroll
        for (int ai = 0; ai < 2; ++ai)
#pragma unroll
            for (int m = 0; m < 4; ++m) {
                float s = 0.f;
#pragma unroll
                for (int bj = 0; bj < 2; ++bj)
#pragma unroll
                    for (int n = 0; n < 2; ++n) { const f32x4 x = v[ai][bj][m][n]; s += (x[0] + x[1]) + (x[2] + x[3]); }
                s += __shfl_xor(s, 16); s += __shfl_xor(s, 32);
                const float mw = s * (1.0f / 64.0f); float q = 0.f;
#pragma unroll
                for (int bj = 0; bj < 2; ++bj)
#pragma unroll
                    for (int n = 0; n < 2; ++n) { const f32x4 d = v[ai][bj][m][n] - mw; q += (d[0] * d[0] + d[1] * d[1]) + (d[2] * d[2] + d[3] * d[3]); }
                q += __shfl_xor(q, 16); q += __shfl_xor(q, 32);
                if (fq == 0) P[(ai * HALF + wr * 64 + m * 16 + fr) * 4 + wc] = (f32x2v){mw, q};
            }
        asm volatile("s_waitcnt lgkmcnt(0)" ::: "memory"); __builtin_amdgcn_s_barrier(); asm volatile("" ::: "memory");
#if defined(BROKEN_EXCHANGE_NO_WAIT)
#warning BROKEN CONTROL BUILD: the row-statistics exchange does not wait; results are wrong by design
        if (blockIdx.x >= 64) { const long long t0_ = clock64(); while (clock64() - t0_ < 60000) __builtin_amdgcn_s_sleep(8); }
#endif
        const int row = wid * 32 + (lane & 31);
        if (lane < 32) {
            const f32x2v a = P[row * 4 + 0], b = P[row * 4 + 1], c = P[row * 4 + 2], d = P[row * 4 + 3];
            const float mt = (a.x + b.x + c.x + d.x) * 0.25f;
            const float da = a.x - mt, db = b.x - mt, dc = c.x - mt, dd = d.x - mt;
            const float m2 = (a.y + b.y) + (c.y + d.y) + 64.0f * ((da * da + db * db) + (dc * dc + dd * dd));
            unsigned long long* slot = (unsigned long long*)xbuf + ((size_t)(u.pm * BM + row) * 4 + u.pn);
            __hip_atomic_store(slot, ((unsigned long long)__float_as_uint(m2) << 32) | __float_as_uint(mt), __ATOMIC_RELAXED, __HIP_MEMORY_SCOPE_AGENT);
        }
        asm volatile("s_waitcnt vmcnt(0)" ::: "memory");
        if (lane == 0) __hip_atomic_fetch_add(cnt + 64 * u.pm, 1u, __ATOMIC_RELAXED, __HIP_MEMORY_SCOPE_AGENT);
        if (wid == 0) {
            bool dead = false; const unsigned long long t0 = __builtin_amdgcn_s_memrealtime(); const unsigned want = 8u * (unsigned)ntn;
            for (;;) {
#if defined(BROKEN_EXCHANGE_NO_WAIT)
                break;
#endif
                if ((unsigned)__builtin_amdgcn_readfirstlane(__hip_atomic_load(cnt + 64 * u.pm, __ATOMIC_RELAXED, __HIP_MEMORY_SCOPE_AGENT)) >= want) break;
                if (__builtin_amdgcn_s_memrealtime() - t0 > 2000000ull) {
                    if (lane == 0) { unsigned expect = 0u; __hip_atomic_compare_exchange_strong(tmo + 1, &expect, code | (unsigned)(u.pm & 0xff), __ATOMIC_RELAXED, __ATOMIC_RELAXED, __HIP_MEMORY_SCOPE_AGENT);
                                     __hip_atomic_store(tmo, 1u, __ATOMIC_RELAXED, __HIP_MEMORY_SCOPE_AGENT); }
                    dead = true; break; }
                __builtin_amdgcn_s_sleep(2);
            }
            __builtin_amdgcn_fence(__ATOMIC_ACQUIRE, "agent");
            if (lane == 0) flag[0] = dead ? 1u : 0u;
        }
        asm volatile("s_waitcnt vmcnt(0) lgkmcnt(0)" ::: "memory"); __builtin_amdgcn_s_barrier(); asm volatile("" ::: "memory");
        const bool bad = flag[0] != 0u;
        if (lane < 32) {
            const unsigned long long* slot = (const unsigned long long*)xbuf + (size_t)(u.pm * BM + row) * 4; float mt[4], m2[4]; float ms = 0.f;
#pragma unroll
            for (int t = 0; t < 4; ++t) { if (t < ntn) { const unsigned long long w = __hip_atomic_load(slot + t, __ATOMIC_RELAXED, __HIP_MEMORY_SCOPE_AGENT); mt[t] = __uint_as_float((unsigned)w); m2[t] = __uint_as_float((unsigned)(w >> 32)); } else { mt[t] = 0.f; m2[t] = 0.f; } ms += mt[t]; }
            const float mean = ms / (float)ntn; float q = 0.f;
#pragma unroll
            for (int t = 0; t < 4; ++t) if (t < ntn) { const float dm = mt[t] - mean; q += m2[t] + 256.0f * dm * dm; }
            S[row] = (f32x2v){mean, 1.0f / sqrtf(q / (256.0f * (float)ntn) + eps)};
        }
        asm volatile("s_waitcnt lgkmcnt(0)" ::: "memory"); __builtin_amdgcn_s_barrier(); asm volatile("" ::: "memory");
        return bad;
    }
};
struct EpiLnRes {
    static constexpr bool PERM = false, AFTER_DRAIN = true;
    const float* base; float* out; int ldc; const float* bias; PanelStats st; unsigned poison;
    __device__ __forceinline__ void fused(f32x4 (&acc)[2][2][4][2], const Unit& u, int wr, int wc, int fr, int fq, PG8_LAS unsigned char* lds, int wid, int lane) const {
        typedef float f32x2v __attribute__((ext_vector_type(2)));
        const PG8_LAS f32x2v* S = (const PG8_LAS f32x2v*)(lds + 8192);
        const int col0 = u.pn * BM + wc * 32 + 4 * fq;
#pragma unroll
        for (int bj = 0; bj < 2; ++bj)
#pragma unroll
            for (int n = 0; n < 2; ++n) { const f32x4 bv = bias ? *(const f32x4*)(bias + col0 + bj * HALF + n * 16) : (f32x4){0.f, 0.f, 0.f, 0.f};
#pragma unroll
                for (int ai = 0; ai < 2; ++ai)
#pragma unroll
                    for (int m = 0; m < 4; ++m) acc[ai][bj][m][n] += bv; }
        f32x4 pre[4][2][2];
#pragma unroll
        for (int m = 0; m < 4; ++m) { const size_t off = (size_t)(u.pm * BM + wr * 64 + m * 16 + fr) * ldc + col0;
#pragma unroll
            for (int bj = 0; bj < 2; ++bj)
#pragma unroll
                for (int n = 0; n < 2; ++n) pre[m][bj][n] = *(const f32x4*)(base + off + bj * HALF + n * 16); }
        const bool bad = st.run(acc, u, wr, wc, fr, fq, lds, wid, lane) || poison != 0u;
        const float qnan = __builtin_nanf("");
#pragma unroll
        for (int ai = 0; ai < 2; ++ai)
#pragma unroll
            for (int m = 0; m < 4; ++m) { const int r = ai * HALF + wr * 64 + m * 16 + fr; const f32x2v sr = S[r]; const size_t off = (size_t)(u.pm * BM + r) * ldc + col0;
#pragma unroll
                for (int bj = 0; bj < 2; ++bj)
#pragma unroll
                    for (int n = 0; n < 2; ++n) { const f32x4 bs = ai == 0 ? pre[m][bj][n] : *(const f32x4*)(base + off + bj * HALF + n * 16); f32x4 o = bs + (acc[ai][bj][m][n] - sr.x) * sr.y;
                        if (bad) o = (f32x4){qnan, qnan, qnan, qnan}; *(f32x4*)(out + off + bj * HALF + n * 16) = o; }
                if (m & 1) asm volatile("" ::: "memory"); }
    }
};
struct EpiLnResLn {
    static constexpr bool PERM = false, AFTER_DRAIN = true;
    const float* base; float* out; bf16_t* xn; int ldc; const float* bias; PanelStats st1, st2; unsigned poison;
    __device__ __forceinline__ void fused(f32x4 (&acc)[2][2][4][2], const Unit& u, int wr, int wc, int fr, int fq, PG8_LAS unsigned char* lds, int wid, int lane) const {
        typedef float f32x2v __attribute__((ext_vector_type(2))); typedef unsigned u32x2v __attribute__((ext_vector_type(2)));
        const PG8_LAS f32x2v* S = (const PG8_LAS f32x2v*)(lds + 8192);
        const int col0 = u.pn * BM + wc * 32 + 4 * fq;
#pragma unroll
        for (int bj = 0; bj < 2; ++bj)
#pragma unroll
            for (int n = 0; n < 2; ++n) { const f32x4 bv = bias ? *(const f32x4*)(bias + col0 + bj * HALF + n * 16) : (f32x4){0.f, 0.f, 0.f, 0.f};
#pragma unroll
                for (int ai = 0; ai < 2; ++ai)
#pragma unroll
                    for (int m = 0; m < 4; ++m) acc[ai][bj][m][n] += bv; }
        bool bad = st1.run(acc, u, wr, wc, fr, fq, lds, wid, lane) || poison != 0u;
        const float qnan = __builtin_nanf("");
#pragma unroll
        for (int ai = 0; ai < 2; ++ai)
#pragma unroll
            for (int m = 0; m < 4; ++m) { const int r = ai * HALF + wr * 64 + m * 16 + fr; const f32x2v sr = S[r]; const size_t off = (size_t)(u.pm * BM + r) * ldc + col0;
#pragma unroll
                for (int bj = 0; bj < 2; ++bj)
#pragma unroll
                    for (int n = 0; n < 2; ++n) { const f32x4 bs = *(const f32x4*)(base + off + bj * HALF + n * 16); acc[ai][bj][m][n] = bs + (acc[ai][bj][m][n] - sr.x) * sr.y; }
                asm volatile("" : "+v"(acc[ai][0][m][0]), "+v"(acc[ai][0][m][1]), "+v"(acc[ai][1][m][0]), "+v"(acc[ai][1][m][1]));
                if (m & 1) asm volatile("" ::: "memory"); }
        const bool bad1 = bad;
        bad = st2.run(acc, u, wr, wc, fr, fq, lds, wid, lane) || bad;
#pragma unroll
        for (int ai = 0; ai < 2; ++ai)
#pragma unroll
            for (int m = 0; m < 4; ++m) { const int r = ai * HALF + wr * 64 + m * 16 + fr; const f32x2v sr = S[r]; const size_t off = (size_t)(u.pm * BM + r) * ldc + col0;
#pragma unroll
                for (int bj = 0; bj < 2; ++bj)
#pragma unroll
                    for (int n = 0; n < 2; ++n) { const f32x4 x1 = acc[ai][bj][m][n]; *(f32x4*)(out + off + bj * HALF + n * 16) = bad1 ? (f32x4){qnan, qnan, qnan, qnan} : x1;
                        const f32x4 o = (x1 - sr.x) * sr.y; u32x2v w; w.x = cvt_pk_bf16(o[0], o[1]); w.y = cvt_pk_bf16(o[2], o[3]);
                        if (bad) { w.x = 0x7fc07fc0u; w.y = 0x7fc07fc0u; } *(u32x2v*)(xn + off + bj * HALF + n * 16) = w; }
                asm volatile("" ::: "memory"); }
    }
};

template <class Epi, class Sched, bool ALIGN_EPI = false, bool SP2 = false, bool CHAIN = false>
__device__ __forceinline__ void gemm_phase(PG8_LAS unsigned char* lds, const Gemm g, const Sched& S, const Epi& E, int wave_id) {
    int lane_o; asm volatile("v_mbcnt_lo_u32_b32 %0, -1, 0\n\tv_mbcnt_hi_u32_b32 %0, -1, %0" : "=v"(lane_o));
    int tid_o = wave_id * 64 + lane_o;
    const int tid = tid_o, wid = __builtin_amdgcn_readfirstlane(tid >> 6), lane = tid & 63, wr = wid >> 2, wc = wid & 3, fr = lane & 15, fq = lane >> 4;
    const int K = g.K, nt = K / BK;
    unsigned voffA[2], voffB[2];
#pragma unroll
    for (int i = 0; i < 2; ++i) { int R, C; stage_rc(tid * 16 + i * 8192, R, C); const int Rb = Epi::PERM ? ((R & ~31) + perm32(R & 31)) : R;
        voffA[i] = (unsigned)(R * g.lda + C) * 2u; voffB[i] = (unsigned)(Rb * K + C) * 2u; }
    const size_t kstep = (size_t)(BK * 2);
    const size_t hstep = (size_t)HALF * K * 2;
    const size_t tstep = 2 * hstep; const size_t hstepA = (size_t)HALF * g.lda * 2, tstepA = 2 * hstepA;
    const unsigned ldsw = (unsigned)wid * 1024u;
    const int aoff = lds_byte(wr * 64 + fr, fq * 8), boff = lds_byte(wc * 32 + fr, fq * 8);
#define PG8_SA(b, h) (((b) * 2 + (h)) * HTB)
#define PG8_SB(b, h) ((4 + (b) * 2 + (h)) * HTB)
#define PG8_STAGE(bufoff, gbase, voff) do { _Pragma("unroll") for (int _i = 0; _i < 2; ++_i) \
        __builtin_amdgcn_global_load_lds((const unsigned*)((const char*)(gbase) + (voff)[_i]), (PG8_LAS unsigned*)(lds + (bufoff) + ldsw + _i * 8192), 16, 0, 0); } while (0)
#define PG8_LDA(dst, b, h) do { _Pragma("unroll") for (int m = 0; m < 4; ++m) _Pragma("unroll") for (int k = 0; k < 2; ++k) dst[m][k] = *(const PG8_LAS bf16x8*)(lds + PG8_SA(b, h) + aoff + m * 2048 + k * 1024); } while (0)
#define PG8_LDB(dst, b, h) do { _Pragma("unroll") for (int n = 0; n < 2; ++n) _Pragma("unroll") for (int k = 0; k < 2; ++k) dst[n][k] = *(const PG8_LAS bf16x8*)(lds + PG8_SB(b, h) + boff + n * 2048 + k * 1024); } while (0)
#define PG8_MMA(ai, bj, At, Bt) do { __builtin_amdgcn_s_setprio(1); _Pragma("unroll") for (int m = 0; m < 4; ++m) _Pragma("unroll") for (int n = 0; n < 2; ++n) _Pragma("unroll") for (int k = 0; k < 2; ++k) \
        acc[ai][bj][m][n] = __builtin_amdgcn_mfma_f32_16x16x32_bf16(Bt[n][k], At[m][k], acc[ai][bj][m][n], 0, 0, 0); __builtin_amdgcn_s_setprio(0); } while (0)
#define PG8_WAIT_V(n) asm volatile("s_waitcnt vmcnt(" #n ")" ::: "memory")
#define PG8_WAIT_L(n) asm volatile("s_waitcnt lgkmcnt(" #n ")" ::: "memory")
#define PG8_BAR __builtin_amdgcn_s_barrier()
#define PG8_SCHED __builtin_amdgcn_sched_barrier(0)
    Unit cur, nxt; int ui = 0;
    if (!S.next(0, cur)) return;
    f32x4 acc[2][2][4][2];
#pragma unroll
    for (int a = 0; a < 2; ++a)
#pragma unroll
        for (int b = 0; b < 2; ++b)
#pragma unroll
            for (int m = 0; m < 4; ++m)
#pragma unroll
                for (int n = 0; n < 2; ++n) acc[a][b][m][n] = (f32x4){0.f, 0.f, 0.f, 0.f};
    bf16x8 At[4][2], B0[2][2], B1[2][2];
    const char* cA = (const char*)g.A + (size_t)cur.pm * tstepA; const char* cB = (const char*)g.Bt + (size_t)cur.pn * tstep;
    S.a_ready(cur);
    if constexpr (SP2) {
        PG8_STAGE(PG8_SB(0, 0), cB, voffB); PG8_STAGE(PG8_SB(0, 1), cB + hstep, voffB); PG8_STAGE(PG8_SA(0, 0), cA, voffA); PG8_STAGE(PG8_SA(0, 1), cA + hstepA, voffA);
        if (wr == 1) PG8_BAR;
        PG8_WAIT_V(2); PG8_BAR;
        PG8_STAGE(PG8_SB(1, 0), cB + kstep, voffB); PG8_STAGE(PG8_SA(1, 0), cA + kstep, voffA); PG8_STAGE(PG8_SB(1, 1), cB + hstep + kstep, voffB);
        PG8_WAIT_V(6); PG8_BAR;
    } else {
        PG8_STAGE(PG8_SB(0, 0), cB, voffB); PG8_STAGE(PG8_SA(0, 0), cA, voffA); PG8_STAGE(PG8_SB(0, 1), cB + hstep, voffB); PG8_STAGE(PG8_SA(0, 1), cA + hstepA, voffA);
        if (wr == 1) PG8_BAR;
        PG8_WAIT_V(4); PG8_BAR;
        PG8_STAGE(PG8_SB(1, 0), cB + kstep, voffB); PG8_STAGE(PG8_SA(1, 0), cA + kstep, voffA); PG8_STAGE(PG8_SB(1, 1), cB + hstep + kstep, voffB);
        PG8_WAIT_V(6); PG8_BAR;
    }
    for (;;) {
        const bool has_next = S.next(ui + 1, nxt);
        const char* nA = has_next ? (const char*)g.A + (size_t)nxt.pm * tstepA : cA; const char* nB = has_next ? (const char*)g.Bt + (size_t)nxt.pn * tstep : cB;
        for (int t = 0; t < nt; t += 2) {
            const bool last = (t == nt - 2);
            const char* a1 = cA + (size_t)(t + 1) * kstep;
            const char* a2 = last ? nA : cA + (size_t)(t + 2) * kstep; const char* b2 = last ? nB : cB + (size_t)(t + 2) * kstep;
            const char* a3 = a2 + kstep; const char* b3 = b2 + kstep;
            if (last && has_next) S.a_ready(nxt);
            if constexpr (SP2) {
            PG8_LDB(B0, 0, 0); PG8_LDB(B1, 0, 1); PG8_SCHED; PG8_LDA(At, 0, 0); PG8_STAGE(PG8_SA(1, 1), a1 + hstepA, voffA);
            PG8_WAIT_V(8); PG8_WAIT_L(0); PG8_BAR; PG8_MMA(0, 0, At, B0); PG8_MMA(0, 1, At, B1); PG8_BAR; PG8_SCHED;
            PG8_LDA(At, 0, 1); PG8_STAGE(PG8_SB(0, 0), b2, voffB); PG8_STAGE(PG8_SB(0, 1), b2 + hstep, voffB); PG8_STAGE(PG8_SA(0, 0), a2, voffA);
            PG8_WAIT_V(8); PG8_WAIT_L(0); PG8_BAR; PG8_MMA(1, 0, At, B0); PG8_MMA(1, 1, At, B1); PG8_BAR; PG8_SCHED;
            PG8_LDB(B0, 1, 0); PG8_LDB(B1, 1, 1); PG8_SCHED; PG8_LDA(At, 1, 0); PG8_STAGE(PG8_SA(0, 1), a2 + hstepA, voffA);
            PG8_WAIT_V(8); PG8_WAIT_L(0); PG8_BAR; PG8_MMA(0, 0, At, B0); PG8_MMA(0, 1, At, B1); PG8_BAR; PG8_SCHED;
            PG8_LDA(At, 1, 1); PG8_STAGE(PG8_SB(1, 0), b3, voffB); PG8_STAGE(PG8_SB(1, 1), b3 + hstep, voffB); PG8_STAGE(PG8_SA(1, 0), a3, voffA);
            PG8_WAIT_V(8); PG8_WAIT_L(0); PG8_BAR; PG8_MMA(1, 0, At, B0); PG8_MMA(1, 1, At, B1); PG8_BAR; PG8_SCHED;
            } else {
            PG8_LDB(B0, 0, 0); PG8_SCHED; PG8_LDA(At, 0, 0); PG8_STAGE(PG8_SA(1, 1), a1 + hstepA, voffA);
            PG8_WAIT_L(8); PG8_BAR; PG8_WAIT_L(0); PG8_MMA(0, 0, At, B0); PG8_BAR; PG8_SCHED;
            PG8_LDB(B1, 0, 1); PG8_STAGE(PG8_SB(0, 0), b2, voffB);
            PG8_BAR; PG8_WAIT_L(0); PG8_MMA(0, 1, At, B1); PG8_BAR;
            PG8_LDA(At, 0, 1); PG8_STAGE(PG8_SA(0, 0), a2, voffA);
            PG8_BAR; PG8_WAIT_L(0); PG8_MMA(1, 0, At, B0); PG8_BAR; PG8_SCHED;
            PG8_STAGE(PG8_SB(0, 1), b2 + hstep, voffB);
            PG8_WAIT_V(6); PG8_BAR; PG8_MMA(1, 1, At, B1); PG8_BAR;
            PG8_LDB(B0, 1, 0); PG8_SCHED; PG8_LDA(At, 1, 0); PG8_STAGE(PG8_SA(0, 1), a2 + hstepA, voffA);
            PG8_WAIT_L(8); PG8_BAR; PG8_WAIT_L(0); PG8_MMA(0, 0, At, B0); PG8_BAR; PG8_SCHED;
            PG8_LDB(B1, 1, 1); PG8_STAGE(PG8_SB(1, 0), b3, voffB);
            PG8_BAR; PG8_WAIT_L(0); PG8_MMA(0, 1, At, B1); PG8_BAR;
            PG8_LDA(At, 1, 1); PG8_STAGE(PG8_SA(1, 0), a3, voffA);
            PG8_BAR; PG8_WAIT_L(0); PG8_MMA(1, 0, At, B0); PG8_BAR; PG8_SCHED;
            PG8_STAGE(PG8_SB(1, 1), b3 + hstep, voffB);
            PG8_WAIT_V(6); PG8_BAR; PG8_MMA(1, 1, At, B1); PG8_BAR;
            }
        }
        if constexpr (ALIGN_EPI) { if (wr == 0) PG8_BAR; }
        bool keep_ = false;
        if constexpr (!Epi::AFTER_DRAIN) { if constexpr (CHAIN) keep_ = E.chain(acc, cur, wr, wc, fr, fq); else E(acc, cur, wr, wc, fr, fq); S.done(cur); }
        if (!has_next) break;
        if (!keep_) {
#pragma unroll
        for (int a = 0; a < 2; ++a)
#pragma unroll
            for (int b = 0; b < 2; ++b)
#pragma unroll
                for (int m = 0; m < 4; ++m)
#pragma unroll
                    for (int n = 0; n < 2; ++n) acc[a][b][m][n] = (f32x4){0.f, 0.f, 0.f, 0.f};
        }
        cur = nxt; cA = nA; cB = nB; ++ui;
        if constexpr (ALIGN_EPI) { if (wr == 1) PG8_BAR; }
    }
    PG8_WAIT_V(0);
    if constexpr (!ALIGN_EPI) { if (wr == 0) PG8_BAR; }
    PG8_BAR;
    if constexpr (Epi::AFTER_DRAIN) { E.fused(acc, cur, wr, wc, fr, fq, lds, wid, lane); S.done(cur); }
#undef PG8_SA
#undef PG8_SB
#undef PG8_STAGE
#undef PG8_LDA
#undef PG8_LDB
#undef PG8_MMA
#undef PG8_WAIT_V
#undef PG8_WAIT_L
#undef PG8_BAR
#undef PG8_SCHED
}
}

constexpr int BATCH = 8, SEQ = 4096, DM = 1024, DEPTH = 4, DFF = 2816, MTOK = BATCH * SEQ;
constexpr int ZW = 2816;
constexpr int Z_NQ = 0, Z_KC = 512, Z_VC = 640, Z_KS = 768, Z_VS = 896, Z_KW = 1024, Z_VW = 1152, Z_MQ = 1280, Z_MKV = 1664, Z_MKR = 1920, Z_GATE = 1952,
              Z_SQ = 2048, Z_SK = 2560, Z_SV = 2688;
constexpr int NCMP = 255;
constexpr float NORM_EPS = 1e-6f;
typedef unsigned short bf16_t;
typedef unsigned u32x4_t __attribute__((ext_vector_type(4)));

__device__ __forceinline__ float bf2f(bf16_t v) { return __uint_as_float(((unsigned)v) << 16); }
__device__ __forceinline__ float bflo(unsigned w) { return __uint_as_float(w << 16); }
__device__ __forceinline__ float bfhi(unsigned w) { return __uint_as_float(w & 0xffff0000u); }
__device__ __forceinline__ bf16_t f2bf(float f) { unsigned u = __float_as_uint(f); return (bf16_t)((u + 0x7fffu + ((u >> 16) & 1u)) >> 16); }
__device__ __forceinline__ float wave_sum(float v) {
#pragma unroll
    for (int o = 1; o < 64; o <<= 1) v += __shfl_xor(v, o);
    return v;
}
__device__ __forceinline__ int t5_bucket(int d) {
    if (d < 16) return d < 0 ? 0 : d;
    int b = 16;
    b += (d >= 21); b += (d >= 27); b += (d >= 35); b += (d >= 46); b += (d >= 59); b += (d >= 77); b += (d >= 99); b += (d >= 128);
    b += (d >= 166); b += (d >= 216); b += (d >= 280); b += (d >= 363); b += (d >= 470); b += (d >= 609); b += (d >= 790);
    return b;
}

namespace pg8 {
struct EpiStore {
    static constexpr bool PERM = true, AFTER_DRAIN = false;
    bf16_t* O; long ldc; const float* rs;
    __device__ __forceinline__ void operator()(const f32x4 (&acc)[2][2][4][2], const Unit& u, int wr, int wc, int fr, int fq) const {
        const int row0 = u.pm * BM + wr * 64 + fr, col0 = u.pn * BM + wc * 32 + 8 * fq;
#pragma unroll
        for (int ai = 0; ai < 2; ++ai)
#pragma unroll
            for (int m = 0; m < 4; ++m) { bf16_t* rowp = O + (size_t)(row0 + ai * HALF + m * 16) * ldc + col0; const float sc = rs ? rs[row0 + ai * HALF + m * 16] : 1.0f;
#pragma unroll
                for (int bj = 0; bj < 2; ++bj) { const f32x4 v0 = acc[ai][bj][m][0] * sc, v1 = acc[ai][bj][m][1] * sc;
                    u32x4 w; w.x = cvt_pk_bf16(v0[0], v0[1]); w.y = cvt_pk_bf16(v0[2], v0[3]); w.z = cvt_pk_bf16(v1[0], v1[1]); w.w = cvt_pk_bf16(v1[2], v1[3]);
                    *(u32x4*)(rowp + bj * HALF) = w; } }
    }
};
__device__ __forceinline__ float sigm(float x) { return __builtin_amdgcn_rcpf(1.0f + __expf(-x)); }
struct EpiSigmoid {
    static constexpr bool PERM = true, AFTER_DRAIN = false;
    bf16_t* O; long ldc; const float* rs;
    __device__ __forceinline__ void operator()(const f32x4 (&acc)[2][2][4][2], const Unit& u, int wr, int wc, int fr, int fq) const {
        const int row0 = u.pm * BM + wr * 64 + fr, col0 = u.pn * BM + wc * 32 + 8 * fq;
#pragma unroll
        for (int ai = 0; ai < 2; ++ai)
#pragma unroll
            for (int m = 0; m < 4; ++m) { bf16_t* rowp = O + (size_t)(row0 + ai * HALF + m * 16) * ldc + col0; const float sc = rs ? rs[row0 + ai * HALF + m * 16] : 1.0f;
#pragma unroll
                for (int bj = 0; bj < 2; ++bj) { const f32x4 v0 = acc[ai][bj][m][0] * sc, v1 = acc[ai][bj][m][1] * sc;
                    u32x4 w; w.x = cvt_pk_bf16(sigm(v0[0]), sigm(v0[1])); w.y = cvt_pk_bf16(sigm(v0[2]), sigm(v0[3])); w.z = cvt_pk_bf16(sigm(v1[0]), sigm(v1[1])); w.w = cvt_pk_bf16(sigm(v1[2]), sigm(v1[3]));
                    *(u32x4*)(rowp + bj * HALF) = w; } }
    }
};
struct EpiSwiGLU {
    static constexpr bool PERM = true, AFTER_DRAIN = false;
    bf16_t* O; long ldc; const float* rs;
    __device__ __forceinline__ void operator()(const f32x4 (&acc)[2][2][4][2], const Unit& u, int wr, int wc, int fr, int fq) const {
        const int row0 = u.pm * BM + wr * 64 + fr, col0 = u.pn * HALF + wc * 32 + 8 * fq;
#pragma unroll
        for (int ai = 0; ai < 2; ++ai)
#pragma unroll
            for (int m = 0; m < 4; ++m) { bf16_t* rowp = O + (size_t)(row0 + ai * HALF + m * 16) * ldc + col0;
                const float sc = rs ? rs[row0 + ai * HALF + m * 16] : 1.0f;
                const f32x4 g0 = acc[ai][0][m][0] * sc, g1 = acc[ai][0][m][1] * sc, u0 = acc[ai][1][m][0] * sc, u1 = acc[ai][1][m][1] * sc;
                float r[8];
#pragma unroll
                for (int e = 0; e < 4; ++e) { r[e] = g0[e] * sigm(g0[e]) * u0[e]; r[4 + e] = g1[e] * sigm(g1[e]) * u1[e]; }
                u32x4 w; w.x = cvt_pk_bf16(r[0], r[1]); w.y = cvt_pk_bf16(r[2], r[3]); w.z = cvt_pk_bf16(r[4], r[5]); w.w = cvt_pk_bf16(r[6], r[7]);
                *(u32x4*)rowp = w; }
    }
};

struct EpiSigMul {
    static constexpr bool PERM = true, AFTER_DRAIN = false;
    bf16_t* O; long ldc;
    __device__ __forceinline__ void operator()(const f32x4 (&acc)[2][2][4][2], const Unit& u, int wr, int wc, int fr, int fq) const {
        const int row0 = u.pm * BM + wr * 64 + fr, col0 = u.pn * BM + wc * 32 + 8 * fq;
#pragma unroll
        for (int ai = 0; ai < 2; ++ai)
#pragma unroll
            for (int m = 0; m < 4; ++m) { bf16_t* rowp = O + (size_t)(row0 + ai * HALF + m * 16) * ldc + col0;
#pragma unroll
                for (int bj = 0; bj < 2; ++bj) { const f32x4 v0 = acc[ai][bj][m][0], v1 = acc[ai][bj][m][1]; const u32x4 y = *(const u32x4*)(rowp + bj * HALF);
                    u32x4 w;
                    w.x = cvt_pk_bf16(sigm(v0[0]) * __uint_as_float(y.x << 16), sigm(v0[1]) * __uint_as_float(y.x & 0xffff0000u));
                    w.y = cvt_pk_bf16(sigm(v0[2]) * __uint_as_float(y.y << 16), sigm(v0[3]) * __uint_as_float(y.y & 0xffff0000u));
                    w.z = cvt_pk_bf16(sigm(v1[0]) * __uint_as_float(y.z << 16), sigm(v1[1]) * __uint_as_float(y.z & 0xffff0000u));
                    w.w = cvt_pk_bf16(sigm(v1[2]) * __uint_as_float(y.w << 16), sigm(v1[3]) * __uint_as_float(y.w & 0xffff0000u));
                    *(u32x4*)(rowp + bj * HALF) = w; } }
    }
};

template <bool FIRST> struct EpiGate {
    static constexpr bool PERM = true, AFTER_DRAIN = false;
    bf16_t* O; long ldc; const bf16_t* Gp; long ldg;
    __device__ __forceinline__ void operator()(const f32x4 (&acc)[2][2][4][2], const Unit& u, int wr, int wc, int fr, int fq) const {
        typedef __attribute__((address_space(1))) u32x4 gv4;
        const int row0 = u.pm * BM + wr * 64 + fr, col0 = u.pn * BM + wc * 32 + 8 * fq;
#pragma unroll
        for (int ai = 0; ai < 2; ++ai) {
            u32x4 g[4][2], y[4][2];
#pragma unroll
            for (int m = 0; m < 4; ++m) { const size_t row = (size_t)(row0 + ai * HALF + m * 16);
#pragma unroll
                for (int bj = 0; bj < 2; ++bj) { g[m][bj] = *(const gv4*)(Gp + row * ldg + col0 + bj * HALF); if (!FIRST) y[m][bj] = *(const gv4*)(O + row * ldc + col0 + bj * HALF); else y[m][bj] = (u32x4){0u, 0u, 0u, 0u}; } }
#pragma unroll
            for (int m = 0; m < 4; ++m) { const size_t row = (size_t)(row0 + ai * HALF + m * 16);
#pragma unroll
                for (int bj = 0; bj < 2; ++bj) { const f32x4 v0 = acc[ai][bj][m][0], v1 = acc[ai][bj][m][1]; const u32x4 gg = g[m][bj], yy = y[m][bj];
                    u32x4 w;
                    w.x = cvt_pk_bf16(fmaf(v0[0], __uint_as_float(gg.x << 16), __uint_as_float(yy.x << 16)), fmaf(v0[1], __uint_as_float(gg.x & 0xffff0000u), __uint_as_float(yy.x & 0xffff0000u)));
                    w.y = cvt_pk_bf16(fmaf(v0[2], __uint_as_float(gg.y << 16), __uint_as_float(yy.y << 16)), fmaf(v0[3], __uint_as_float(gg.y & 0xffff0000u), __uint_as_float(yy.y & 0xffff0000u)));
                    w.z = cvt_pk_bf16(fmaf(v1[0], __uint_as_float(gg.z << 16), __uint_as_float(yy.z << 16)), fmaf(v1[1], __uint_as_float(gg.z & 0xffff0000u), __uint_as_float(yy.z & 0xffff0000u)));
                    w.w = cvt_pk_bf16(fmaf(v1[2], __uint_as_float(gg.w << 16), __uint_as_float(yy.w << 16)), fmaf(v1[3], __uint_as_float(gg.w & 0xffff0000u), __uint_as_float(yy.w & 0xffff0000u)));
                    *(gv4*)(O + row * ldc + col0 + bj * HALF) = w; } }
        }
    }
};

struct GateOrder {
    StaticOrder so;
    __device__ void init(int M, int G_, int c_) { so.init(M, 1024, G_, c_); }
    __device__ bool next(int i, Unit& u) const { const int t = i / 3, n = i - 3 * t; Unit b; if (!so.next(t, b)) return false; u.pm = 128 * n + b.pm; u.pn = 4 * n + b.pn; return true; }
    __device__ __forceinline__ void a_ready(const Unit&) const {}
    __device__ __forceinline__ void done(const Unit&) const {}
};
struct EpiGateCat {
    static constexpr bool PERM = true, AFTER_DRAIN = false;
    bf16_t* O; long ldc; const bf16_t* Gp; long ldg;
    __device__ __forceinline__ void operator()(const f32x4 (&acc)[2][2][4][2], const Unit& u, int wr, int wc, int fr, int fq) const {
        typedef __attribute__((address_space(1))) u32x4 gv4;
        const int n = u.pm >> 7, pm = u.pm & 127, pn = u.pn & 3;
        const int row0 = pm * BM + wr * 64 + fr, col0 = pn * BM + wc * 32 + 8 * fq;
        const bf16_t* gb = Gp + 1024 * n;
#pragma unroll
        for (int ai = 0; ai < 2; ++ai) {
            u32x4 g[4][2], y[4][2];
#pragma unroll
            for (int m = 0; m < 4; ++m) { const size_t row = (size_t)(row0 + ai * HALF + m * 16);
#pragma unroll
                for (int bj = 0; bj < 2; ++bj) { g[m][bj] = *(const gv4*)(gb + row * ldg + col0 + bj * HALF); y[m][bj] = (u32x4){0u, 0u, 0u, 0u}; } }
            if (n != 0) {
#pragma unroll
                for (int m = 0; m < 4; ++m) { const size_t row = (size_t)(row0 + ai * HALF + m * 16);
#pragma unroll
                    for (int bj = 0; bj < 2; ++bj) y[m][bj] = *(const gv4*)(O + row * ldc + col0 + bj * HALF); } }
#pragma unroll
            for (int m = 0; m < 4; ++m) { const size_t row = (size_t)(row0 + ai * HALF + m * 16);
#pragma unroll
                for (int bj = 0; bj < 2; ++bj) { const f32x4 v0 = acc[ai][bj][m][0], v1 = acc[ai][bj][m][1]; const u32x4 gg = g[m][bj], yy = y[m][bj];
                    u32x4 w;
                    w.x = cvt_pk_bf16(fmaf(v0[0], __uint_as_float(gg.x << 16), __uint_as_float(yy.x << 16)), fmaf(v0[1], __uint_as_float(gg.x & 0xffff0000u), __uint_as_float(yy.x & 0xffff0000u)));
                    w.y = cvt_pk_bf16(fmaf(v0[2], __uint_as_float(gg.y << 16), __uint_as_float(yy.y << 16)), fmaf(v0[3], __uint_as_float(gg.y & 0xffff0000u), __uint_as_float(yy.y & 0xffff0000u)));
                    w.z = cvt_pk_bf16(fmaf(v1[0], __uint_as_float(gg.z << 16), __uint_as_float(yy.z << 16)), fmaf(v1[1], __uint_as_float(gg.z & 0xffff0000u), __uint_as_float(yy.z & 0xffff0000u)));
                    w.w = cvt_pk_bf16(fmaf(v1[2], __uint_as_float(gg.w << 16), __uint_as_float(yy.w << 16)), fmaf(v1[3], __uint_as_float(gg.w & 0xffff0000u), __uint_as_float(yy.w & 0xffff0000u)));
                    *(gv4*)(O + row * ldc + col0 + bj * HALF) = w; } }
        }
    }
};
struct EpiGateChain {
    static constexpr bool PERM = true, AFTER_DRAIN = false;
    bf16_t* O; long ldc; const bf16_t* Gp; long ldg;
    __device__ __forceinline__ bool chain(f32x4 (&acc)[2][2][4][2], const Unit& u, int wr, int wc, int fr, int fq) const {
        typedef __attribute__((address_space(1))) u32x4 gv4;
        const int n = u.pm >> 7, pm = u.pm & 127, pn = u.pn & 3;
        const int row0 = pm * BM + wr * 64 + fr, col0 = pn * BM + wc * 32 + 8 * fq;
        const bf16_t* gb = Gp + 1024 * n;
        const float tiny = 1e-30f;
        if (n < 2) {
#pragma unroll
            for (int ai = 0; ai < 2; ++ai) {
                u32x4 g[4][2], h[4][2];
#pragma unroll
                for (int m = 0; m < 4; ++m) { const size_t row = (size_t)(row0 + ai * HALF + m * 16);
#pragma unroll
                    for (int bj = 0; bj < 2; ++bj) { g[m][bj] = *(const gv4*)(gb + row * ldg + col0 + bj * HALF); h[m][bj] = *(const gv4*)(gb + 1024 + row * ldg + col0 + bj * HALF); } }
#pragma unroll
                for (int m = 0; m < 4; ++m)
#pragma unroll
                    for (int bj = 0; bj < 2; ++bj) { const u32x4 gg = g[m][bj], hh = h[m][bj];
#define PG8_RAT(GW, HW, LO) (fmaxf((LO) ? __uint_as_float((GW) << 16) : __uint_as_float((GW) & 0xffff0000u), tiny) * __builtin_amdgcn_rcpf(fmaxf((LO) ? __uint_as_float((HW) << 16) : __uint_as_float((HW) & 0xffff0000u), tiny)))
                        f32x4 v0 = acc[ai][bj][m][0], v1 = acc[ai][bj][m][1];
                        v0[0] *= PG8_RAT(gg.x, hh.x, true); v0[1] *= PG8_RAT(gg.x, hh.x, false); v0[2] *= PG8_RAT(gg.y, hh.y, true); v0[3] *= PG8_RAT(gg.y, hh.y, false);
                        v1[0] *= PG8_RAT(gg.z, hh.z, true); v1[1] *= PG8_RAT(gg.z, hh.z, false); v1[2] *= PG8_RAT(gg.w, hh.w, true); v1[3] *= PG8_RAT(gg.w, hh.w, false);
#undef PG8_RAT
                        acc[ai][bj][m][0] = v0; acc[ai][bj][m][1] = v1; }
            }
            return true;
        }
#pragma unroll
        for (int ai = 0; ai < 2; ++ai) {
            u32x4 g[4][2];
#pragma unroll
            for (int m = 0; m < 4; ++m) { const size_t row = (size_t)(row0 + ai * HALF + m * 16);
#pragma unroll
                for (int bj = 0; bj < 2; ++bj) g[m][bj] = *(const gv4*)(gb + row * ldg + col0 + bj * HALF); }
#pragma unroll
            for (int m = 0; m < 4; ++m) { const size_t row = (size_t)(row0 + ai * HALF + m * 16);
#pragma unroll
                for (int bj = 0; bj < 2; ++bj) { const f32x4 v0 = acc[ai][bj][m][0], v1 = acc[ai][bj][m][1]; const u32x4 gg = g[m][bj];
#define PG8_GV(GW, LO) fmaxf((LO) ? __uint_as_float((GW) << 16) : __uint_as_float((GW) & 0xffff0000u), tiny)
                    u32x4 w;
                    w.x = cvt_pk_bf16(v0[0] * PG8_GV(gg.x, true), v0[1] * PG8_GV(gg.x, false)); w.y = cvt_pk_bf16(v0[2] * PG8_GV(gg.y, true), v0[3] * PG8_GV(gg.y, false));
                    w.z = cvt_pk_bf16(v1[0] * PG8_GV(gg.z, true), v1[1] * PG8_GV(gg.z, false)); w.w = cvt_pk_bf16(v1[2] * PG8_GV(gg.w, true), v1[3] * PG8_GV(gg.w, false));
#undef PG8_GV
                    *(gv4*)(O + row * ldc + col0 + bj * HALF) = w; } }
        }
        return false;
    }
};
}


__device__ __forceinline__ int srccol(int mode, int n, int a, int b) {
    if (mode == 0) return n < b ? a + n : -1;
    if (mode == 1) { const int t = n >> 8, r = n & 255; return r < 128 ? 128 * t + r : DFF + 128 * t + (r - 128); }
    if (n < 1280) return n; if (n < 1952) return n + 792; if (n < 1976) return 1280 + (n - 1952); if (n < 2048) return -1; return 1304 + (n - 2048);
}
__device__ __forceinline__ float gelu_tanh(float x) { const float u = 0.7978845608028654f * (x + 0.044715f * x * x * x); return 0.5f * x * (1.0f + tanhf(u)); }
__device__ __forceinline__ void load_q64(float (&q)[64], const bf16_t* p, float scale) {
    const uint4* p4 = (const uint4*)p;
#pragma unroll
    for (int i = 0; i < 8; ++i) { const uint4 w = p4[i];
        q[8 * i + 0] = bflo(w.x) * scale; q[8 * i + 1] = bfhi(w.x) * scale; q[8 * i + 2] = bflo(w.y) * scale; q[8 * i + 3] = bfhi(w.y) * scale;
        q[8 * i + 4] = bflo(w.z) * scale; q[8 * i + 5] = bfhi(w.z) * scale; q[8 * i + 6] = bflo(w.w) * scale; q[8 * i + 7] = bfhi(w.w) * scale; }
}
__device__ __forceinline__ float dot64_bf(const float (&q)[64], const bf16_t* k) {
    const uint4* k4 = (const uint4*)k; float s = 0.f;
#pragma unroll
    for (int i = 0; i < 8; ++i) { const uint4 w = k4[i];
        s += q[8 * i + 0] * bflo(w.x) + q[8 * i + 1] * bfhi(w.x) + q[8 * i + 2] * bflo(w.y) + q[8 * i + 3] * bfhi(w.y)
           + q[8 * i + 4] * bflo(w.z) + q[8 * i + 5] * bfhi(w.z) + q[8 * i + 6] * bflo(w.w) + q[8 * i + 7] * bfhi(w.w); if ((i & 3) == 3) asm volatile("" ::: "memory"); }
    return s;
}
__device__ __forceinline__ float dot64_f(const float (&q)[64], const float* k) {
    const float4* k4 = (const float4*)k; float s = 0.f;
#pragma unroll
    for (int i = 0; i < 16; ++i) { const float4 w = k4[i]; s += q[4 * i] * w.x + q[4 * i + 1] * w.y + q[4 * i + 2] * w.z + q[4 * i + 3] * w.w; if ((i & 3) == 3) asm volatile("" ::: "memory"); }
    return s;
}
__device__ __forceinline__ void upd_bf(float (&o)[64], float& m, float& l, float s, const bf16_t* v) {
    const float mn = fmaxf(m, s), c = __expf(m - mn), p = __expf(s - mn); l = l * c + p; m = mn;
    const uint4* v4 = (const uint4*)v;
#pragma unroll
    for (int i = 0; i < 8; ++i) { const uint4 w = v4[i];
        o[8 * i + 0] = o[8 * i + 0] * c + p * bflo(w.x); o[8 * i + 1] = o[8 * i + 1] * c + p * bfhi(w.x); o[8 * i + 2] = o[8 * i + 2] * c + p * bflo(w.y); o[8 * i + 3] = o[8 * i + 3] * c + p * bfhi(w.y);
        o[8 * i + 4] = o[8 * i + 4] * c + p * bflo(w.z); o[8 * i + 5] = o[8 * i + 5] * c + p * bfhi(w.z); o[8 * i + 6] = o[8 * i + 6] * c + p * bflo(w.w); o[8 * i + 7] = o[8 * i + 7] * c + p * bfhi(w.w);  if ((i & 3) == 3) asm volatile("" ::: "memory"); }
}
template <bool ACCUM> __device__ __forceinline__ void store_o64(bf16_t* O, const float (&o)[64], float f) {
    uint4* O4 = (uint4*)O;
#pragma unroll
    for (int i = 0; i < 8; ++i) { float r[8];
#pragma unroll
        for (int e = 0; e < 8; ++e) r[e] = o[8 * i + e] * f;
        if (ACCUM) { const uint4 w = O4[i]; r[0] += bflo(w.x); r[1] += bfhi(w.x); r[2] += bflo(w.y); r[3] += bfhi(w.y); r[4] += bflo(w.z); r[5] += bfhi(w.z); r[6] += bflo(w.w); r[7] += bfhi(w.w); }
        uint4 w; w.x = (unsigned)f2bf(r[0]) | ((unsigned)f2bf(r[1]) << 16); w.y = (unsigned)f2bf(r[2]) | ((unsigned)f2bf(r[3]) << 16);
        w.z = (unsigned)f2bf(r[4]) | ((unsigned)f2bf(r[5]) << 16); w.w = (unsigned)f2bf(r[6]) | ((unsigned)f2bf(r[7]) << 16); O4[i] = w; }
}
__device__ __forceinline__ float sigmoidf_(float x) { return 1.0f / (1.0f + __expf(-x)); }


#define LAS __attribute__((address_space(3)))
#define LDS_WAIT() asm volatile("s_waitcnt lgkmcnt(0)" ::: "memory")
#define VM_WAIT() asm volatile("s_waitcnt vmcnt(0)" ::: "memory")
#define XB_TMO      128
#define XB_XCNT(j)  (256  + 64 * (j))
#define XB_XSUB(j)  (1280 + 64 * (j))
#define XB_XGEN(j)  (2304 + 64 * (j))
#define XB_TOP      3328
#define XB_TOPGEN   3392
#define XCD_BAR_WORDS 3456
#define XB_SPIN_CAP (1u << 18)

__device__ __forceinline__ unsigned xb_ld(unsigned* p)              { return __hip_atomic_load(p, __ATOMIC_RELAXED, __HIP_MEMORY_SCOPE_AGENT); }
__device__ __forceinline__ unsigned xb_add(unsigned* p, unsigned v) { return __hip_atomic_fetch_add(p, v, __ATOMIC_RELAXED, __HIP_MEMORY_SCOPE_AGENT); }
__device__ __forceinline__ unsigned xb_xcc_id() { return (unsigned)__builtin_amdgcn_s_getreg((3 << 11) | 20) & 0xFu; }
#define XB_SPIN(cond, bar) do { unsigned _sp = 0; while (cond) { __builtin_amdgcn_s_sleep(1); \
    if ((++_sp & 255u) == 0u) { if (xb_ld(&(bar)[XB_TMO])) break; if (_sp > XB_SPIN_CAP) { atomicAdd(&(bar)[XB_TMO], 1u); break; } } } } while (0)

struct XcdBarrier {
    unsigned* bar; unsigned x;
    volatile LAS unsigned* st;
};

__device__ __forceinline__ XcdBarrier xcd_barrier_post(unsigned* bar, volatile LAS unsigned* st) {
    XcdBarrier b; b.bar = bar; b.x = xb_xcc_id(); b.st = st;
    if (threadIdx.x == 0) (void)xb_add(&bar[XB_XCNT(b.x)], 1u);
    return b;
}
__device__ __forceinline__ void xcd_barrier_complete(unsigned* bar, unsigned x, unsigned& nloc, unsigned& nx) {
    const unsigned G = gridDim.x * gridDim.y * gridDim.z;
    unsigned sum, cnt, mine, sp = 0u;
    for (;;) {
        sum = 0u; cnt = 0u; mine = 0u;
#pragma unroll
        for (unsigned j = 0; j < 16; ++j) { const unsigned c = xb_ld(&bar[XB_XCNT(j)]); sum += c; cnt += (c > 0u) ? 1u : 0u; mine = (j == x) ? c : mine; }
        if (sum == G) break;
        __builtin_amdgcn_s_sleep(1);
        if ((++sp & 255u) == 0u) { if (xb_ld(&bar[XB_TMO])) break; if (sp > XB_SPIN_CAP) { atomicAdd(&bar[XB_TMO], 1u); break; } }
    }
    nloc = mine > 0u ? mine : 1u; nx = cnt > 0u ? cnt : 1u;
}

__device__ __forceinline__ void xcd_barrier(const XcdBarrier& b) {
    asm volatile("s_waitcnt vmcnt(0)" ::: "memory");
    __syncthreads();
    if (threadIdx.x == 0) {
        unsigned* bar = b.bar;
        __builtin_amdgcn_s_waitcnt(0);
        unsigned nloc = b.st[0], nx = b.st[1];
        if (nloc == 0u) { xcd_barrier_complete(bar, b.x, nloc, nx); b.st[0] = nloc; b.st[1] = nx; }
        const unsigned old = xb_add(&bar[XB_XSUB(b.x)], 1u);
        const unsigned gen = old / nloc;
        if (old + 1u == (gen + 1u) * nloc) {
            __builtin_amdgcn_fence(__ATOMIC_RELEASE, "agent");
            asm volatile("s_waitcnt vmcnt(0)" ::: "memory");
            const unsigned og = xb_add(&bar[XB_TOP], 1u);
            const unsigned tg = og / nx;
            if (og + 1u == (tg + 1u) * nx) xb_add(&bar[XB_TOPGEN], 1u);
            else XB_SPIN(xb_ld(&bar[XB_TOPGEN]) == tg, bar);
            __builtin_amdgcn_fence(__ATOMIC_ACQUIRE, "agent");
            xb_add(&bar[XB_XGEN(b.x)], 1u);
            asm volatile("s_waitcnt vmcnt(0)" ::: "memory");
        } else {
            XB_SPIN(xb_ld(&bar[XB_XGEN(b.x)]) == gen, bar);
            __builtin_amdgcn_fence(__ATOMIC_ACQUIRE, "agent");
            asm volatile("s_waitcnt vmcnt(0)" ::: "memory");
        }
    }
    __syncthreads();
}

constexpr int RING_BYTES = 131072, LDSCTL_OFF = RING_BYTES, MISC_OFF = LDSCTL_OFF + 320, LDS_BYTES = 147456;
constexpr int NWAVES = 8;
constexpr size_t MiB = 1ull << 20;
constexpr size_t WS_CTL = 0, CTL_ZERO_BYTES = 1 * MiB; constexpr int CW_BAR = 4096;
constexpr size_t WS_BD = 1 * MiB;
constexpr size_t WS_RC = WS_BD + 256 * 1024;
constexpr size_t WS_RS = WS_RC + 256 * 1024;
constexpr size_t WS_KC = 2 * MiB, WS_VC = 3 * MiB;
constexpr size_t WS_SEL = 4 * MiB;
constexpr size_t WS_KR = 4 * MiB + 512 * 1024;
constexpr size_t WS_WT = 9 * MiB;
constexpr size_t WT_GU1 = 0, WT_D1 = WT_GU1 + 11 * MiB, WT_GU2 = WT_D1 + 5632 * 1024, WT_D2 = WT_GU2 + 11 * MiB, WT_ZA = WT_D2 + 5632 * 1024,
                 WT_G = WT_ZA + 5632 * 1024, WT_B = WT_G + 6 * MiB, WT_OUT = WT_B + 3 * MiB, WT_QB = WT_OUT + 2 * MiB, WT_KVB = WT_QB + 768 * 384 * 2, WT_END = WT_KVB + 1024 * 256 * 2;
static_assert(WT_END <= 51 * MiB, "weights region");
constexpr size_t WS_HN = 60 * MiB;
constexpr size_t WS_RA = 124 * MiB;
constexpr size_t WS_RB = 300 * MiB;
constexpr size_t WS_RCC = 412 * MiB;
constexpr size_t WS_END = 508 * MiB;
constexpr size_t WS_YCAT = WS_RA;

struct Params { const float* in[26]; float* out; unsigned char* ws; };

__device__ __forceinline__ void tr_item2(const float* __restrict__ W, int K, int N, bf16_t* __restrict__ Wt, int Ndst, int mode, int a, int b, const float* __restrict__ gain, int item0, int item1, bool two, LAS float* scr, int lane) {
    const int nblk = Ndst >> 5;
    float v[2][32];
    typedef __attribute__((address_space(1))) const float gfl;
#pragma unroll
    for (int q = 0; q < 2; ++q) { const int item = (q == 0 || two) ? (q ? item1 : item0) : item0; const int kb = item / nblk, nb = item - kb * nblk, k0 = kb << 6, n0 = nb << 5;
        const int sc = srccol(mode, n0 + (lane & 31), a, b); const float keep = sc >= 0 ? 1.0f : 0.0f; const int scc = sc >= 0 ? sc : 0;
        gfl* wp = (gfl*)(W + (size_t)(k0 + (lane >> 5)) * N + scc);
#pragma unroll
        for (int i = 0; i < 32; ++i) v[q][i] = wp[(size_t)(2 * i) * N] * keep; }
    if (gain) {
#pragma unroll
        for (int q = 0; q < 2; ++q) { const int item = (q == 0 || two) ? (q ? item1 : item0) : item0; const int kb = item / nblk, k0 = kb << 6;
            gfl* gp = (gfl*)(gain + k0 + (lane >> 5));
#pragma unroll
            for (int i = 0; i < 32; ++i) v[q][i] *= gp[2 * i]; } }
#pragma unroll
    for (int q = 0; q < 2; ++q) { if (q == 1 && !two) break;
#pragma unroll
        for (int i = 0; i < 32; ++i) scr[(2 * i + (lane >> 5)) * 33 + (lane & 31)] = v[q][i];
        LDS_WAIT();
        const int item = q ? item1 : item0; const int kb = item / nblk, nb = item - kb * nblk, k0 = kb << 6, n0 = nb << 5;
        const int c = lane & 7;
#pragma unroll
        for (int j = 0; j < 4; ++j) { const int n = (lane >> 3) + 8 * j; LAS const float* s = scr + (8 * c) * 33 + n;
            u32x4_t o; o.x = (unsigned)f2bf(s[0]) | ((unsigned)f2bf(s[33]) << 16); o.y = (unsigned)f2bf(s[66]) | ((unsigned)f2bf(s[99]) << 16);
            o.z = (unsigned)f2bf(s[132]) | ((unsigned)f2bf(s[165]) << 16); o.w = (unsigned)f2bf(s[198]) | ((unsigned)f2bf(s[231]) << 16);
            *(u32x4_t*)(Wt + (size_t)(n0 + n) * K + k0 + 8 * c) = o; }
        LDS_WAIT(); }
}
__device__ __forceinline__ void tr_matrix(const float* W, int K, int N, bf16_t* Wt, int Ndst, int mode, int a, int b, const float* gain, LAS float* scr, int lane, int gw, int NGW, int& rot) {
    const int cnt = (K >> 6) * (Ndst >> 5), npair = (cnt + 1) >> 1;
    int first = gw - rot; if (first < 0) first += NGW;
    for (int pr = first; pr < npair; pr += NGW) tr_item2(W, K, N, Wt, Ndst, mode, a, b, gain, 2 * pr, 2 * pr + 1, 2 * pr + 1 < cnt, scr, lane);
    rot = (rot + npair) % NGW;
}
__device__ __forceinline__ void rmsnorm_row(const float* __restrict__ x, const float* __restrict__ g, bf16_t* __restrict__ out, int row, int lane) {
    asm volatile("" : "+v"(lane));
    const float4* xr = (const float4*)(x + (size_t)row * DM); const float4* gr = (const float4*)g;
    float4 v[4]; float s = 0.f;
#pragma unroll
    for (int j = 0; j < 4; ++j) { v[j] = xr[j * 64 + lane]; s += v[j].x * v[j].x + v[j].y * v[j].y + v[j].z * v[j].z + v[j].w * v[j].w; }
    const float inv = rsqrtf(wave_sum(s) * (1.0f / DM) + NORM_EPS);
#pragma unroll
    for (int j = 0; j < 4; ++j) { const float4 gg = gr[j * 64 + lane]; ushort4 o; o.x = f2bf(v[j].x * inv * gg.x); o.y = f2bf(v[j].y * inv * gg.y); o.z = f2bf(v[j].z * inv * gg.z); o.w = f2bf(v[j].w * inv * gg.w);
        ((ushort4*)(out + (size_t)row * DM))[j * 64 + lane] = o; }
}
__device__ __forceinline__ void resnorm_row(const bf16_t* __restrict__ y, const float* __restrict__ gpost, float scale, const float* xin, float* xout, const float* __restrict__ gnext, bf16_t* __restrict__ hn, int row, int lane) {
    asm volatile("" : "+v"(lane));
    const ushort4* yr = (const ushort4*)(y + (size_t)row * DM); const float4* xr = (const float4*)(xin + (size_t)row * DM);
    float4 v[4]; float s = 0.f;
#pragma unroll
    for (int j = 0; j < 4; ++j) { const ushort4 t = yr[j * 64 + lane]; v[j] = make_float4(bf2f(t.x), bf2f(t.y), bf2f(t.z), bf2f(t.w)); s += v[j].x * v[j].x + v[j].y * v[j].y + v[j].z * v[j].z + v[j].w * v[j].w; }
    const float inv = rsqrtf(wave_sum(s) * (1.0f / DM) + NORM_EPS) * scale;
    float s2 = 0.f;
#pragma unroll
    for (int j = 0; j < 4; ++j) { const float4 gg = ((const float4*)gpost)[j * 64 + lane]; const float4 xx = xr[j * 64 + lane];
        v[j].x = xx.x + v[j].x * inv * gg.x; v[j].y = xx.y + v[j].y * inv * gg.y; v[j].z = xx.z + v[j].z * inv * gg.z; v[j].w = xx.w + v[j].w * inv * gg.w;
        s2 += v[j].x * v[j].x + v[j].y * v[j].y + v[j].z * v[j].z + v[j].w * v[j].w; }
#pragma unroll
    for (int j = 0; j < 4; ++j) ((float4*)(xout + (size_t)row * DM))[j * 64 + lane] = v[j];
    if (hn) { const float inv2 = rsqrtf(wave_sum(s2) * (1.0f / DM) + NORM_EPS);
#pragma unroll
        for (int j = 0; j < 4; ++j) { const float4 gg = ((const float4*)gnext)[j * 64 + lane]; ushort4 o; o.x = f2bf(v[j].x * inv2 * gg.x); o.y = f2bf(v[j].y * inv2 * gg.y); o.z = f2bf(v[j].z * inv2 * gg.z); o.w = f2bf(v[j].w * inv2 * gg.w);
            ((ushort4*)(hn + (size_t)row * DM))[j * 64 + lane] = o; } }
}
__device__ __forceinline__ void mla_prep_row(const bf16_t* __restrict__ Z, const float* __restrict__ gq, const float* __restrict__ gkv, const float* __restrict__ RC, const float* __restrict__ RS,
                                             bf16_t* __restrict__ QN, bf16_t* __restrict__ KVN, bf16_t* __restrict__ KR, int row, int lane) {
    asm volatile("" : "+v"(lane));
    const int pos = row & (SEQ - 1);
    const bf16_t* z = Z + (size_t)row * ZW;
    const bool hq = lane < 48, hk = lane < 32;
    uint4 wq = *(const uint4*)(z + Z_MQ + (hq ? lane : 0) * 8), wk = *(const uint4*)(z + Z_MKV + (hk ? lane : 0) * 8);
    const int l16 = lane & 15; const float x1 = bf2f(z[Z_MKR + l16]), x2 = bf2f(z[Z_MKR + 16 + l16]); const float c = RC[pos * 16 + l16], sn = RS[pos * 16 + l16];
    if (!hq) wq = make_uint4(0u, 0u, 0u, 0u);
    if (!hk) wk = make_uint4(0u, 0u, 0u, 0u);
    float q[8] = {bflo(wq.x), bfhi(wq.x), bflo(wq.y), bfhi(wq.y), bflo(wq.z), bfhi(wq.z), bflo(wq.w), bfhi(wq.w)};
    float kv[8] = {bflo(wk.x), bfhi(wk.x), bflo(wk.y), bfhi(wk.y), bflo(wk.z), bfhi(wk.z), bflo(wk.w), bfhi(wk.w)};
    float sq = 0.f, sk = 0.f;
#pragma unroll
    for (int e = 0; e < 8; ++e) { sq += q[e] * q[e]; sk += kv[e] * kv[e]; }
    const float invq = rsqrtf(wave_sum(sq) * (1.0f / 384.0f) + NORM_EPS), invk = rsqrtf(wave_sum(sk) * (1.0f / 256.0f) + NORM_EPS);
    const float4 gq0 = ((const float4*)gq)[(hq ? lane : 0) * 2], gq1 = ((const float4*)gq)[(hq ? lane : 0) * 2 + 1], gk0 = ((const float4*)gkv)[(hk ? lane : 0) * 2], gk1 = ((const float4*)gkv)[(hk ? lane : 0) * 2 + 1];
    if (hq) { const float4 g0 = gq0, g1 = gq1; uint4 w;
        w.x = (unsigned)f2bf(q[0] * invq * g0.x) | ((unsigned)f2bf(q[1] * invq * g0.y) << 16); w.y = (unsigned)f2bf(q[2] * invq * g0.z) | ((unsigned)f2bf(q[3] * invq * g0.w) << 16);
        w.z = (unsigned)f2bf(q[4] * invq * g1.x) | ((unsigned)f2bf(q[5] * invq * g1.y) << 16); w.w = (unsigned)f2bf(q[6] * invq * g1.z) | ((unsigned)f2bf(q[7] * invq * g1.w) << 16);
        *(uint4*)(QN + (size_t)row * 384 + lane * 8) = w; }
    if (hk) { const float4 g0 = gk0, g1 = gk1; uint4 w;
        w.x = (unsigned)f2bf(kv[0] * invk * g0.x) | ((unsigned)f2bf(kv[1] * invk * g0.y) << 16); w.y = (unsigned)f2bf(kv[2] * invk * g0.z) | ((unsigned)f2bf(kv[3] * invk * g0.w) << 16);
        w.z = (unsigned)f2bf(kv[4] * invk * g1.x) | ((unsigned)f2bf(kv[5] * invk * g1.y) << 16); w.w = (unsigned)f2bf(kv[6] * invk * g1.z) | ((unsigned)f2bf(kv[7] * invk * g1.w) << 16);
        *(uint4*)(KVN + (size_t)row * 256 + lane * 8) = w; }
    if (lane < 16) { KR[(size_t)row * 32 + lane] = f2bf(x1 * c - x2 * sn); KR[(size_t)row * 32 + 16 + lane] = f2bf(x1 * sn + x2 * c); }
}
__device__ __forceinline__ void compress_item(const bf16_t* __restrict__ Z, const float* __restrict__ pe, const float* __restrict__ w1, const float* __restrict__ w2, float* __restrict__ out,
                                              int b, int c, int hkv, int col, LAS float* scr, int lane) {
    asm volatile("" : "+v"(lane));
    LAS float* flat = scr; LAS float* hid = scr + 2048;
    for (int i = lane; i < 2048; i += 64) { const int l = i >> 6, d = i & 63; flat[i] = bf2f(Z[(size_t)(b * SEQ + 16 * c + l) * ZW + col + d]) + pe[i]; }
    LDS_WAIT();
    float h0 = 0.f, h1 = 0.f;
    for (int i = 0; i < 2048; ++i) { const float f = flat[i]; h0 += f * w1[i * 128 + lane]; h1 += f * w1[i * 128 + 64 + lane]; }
    hid[lane] = gelu_tanh(h0); hid[64 + lane] = gelu_tanh(h1);
    LDS_WAIT();
    float o = 0.f;
    for (int j = 0; j < 128; ++j) o += hid[j] * w2[j * 64 + lane];
    out[((size_t)(b * NCMP + c) * 2 + hkv) * 64 + lane] = o;
    LDS_WAIT();
}
__device__ __forceinline__ void swa_unit(const bf16_t* __restrict__ Z, const float* __restrict__ BD, const float* __restrict__ sinks, bf16_t* __restrict__ O, int b, int h, int t0, int lane) {
    asm volatile("" : "+v"(lane));
    const int t = t0 + lane, hkv = h >> 2; const size_t rowq = (size_t)(b * SEQ + t);
    const int qcol = Z_SQ + h * 64, kcol = Z_SK + hkv * 64, vcol = Z_SV + hkv * 64;
    const float* bd = BD + (8 + h) * 4096;
    float q[64], o[64]; load_q64(q, Z + rowq * ZW + qcol, 0.125f);
#pragma unroll
    for (int d = 0; d < 64; ++d) o[d] = 0.f;
    float m = -1e30f, l = 0.f;
    const int s_lo = t0 - 127 > 0 ? t0 - 127 : 0, s_hi = t0 + 63;
    for (int s = s_lo; s <= s_hi; ++s) { const bf16_t* kr = Z + (size_t)(b * SEQ + s) * ZW; const int dist = t - s; const bool valid = dist >= 0 && dist < 128;
        const float sc = dot64_bf(q, kr + kcol) + bd[valid ? dist : 0];
        if (valid) upd_bf(o, m, l, sc, kr + vcol); }
    const float sk = sinks[h], mf = fmaxf(m, sk), c = __expf(m - mf); const float den = l * c + __expf(sk - mf);
    store_o64<false>(O + rowq * 512 + h * 64, o, c / den);
}
__device__ __forceinline__ void cmp_unit(const bf16_t* __restrict__ Z, const float* __restrict__ BD, const float* __restrict__ KC, const float* __restrict__ VC, bf16_t* __restrict__ OA, unsigned long long* __restrict__ SEL,
                                         int b, int hkv, int t0, LAS float* imp, int lane) {
    asm volatile("" : "+v"(lane));
    const int t = t0 + lane; const size_t rowq = (size_t)(b * SEQ + t);
#define IMP(j) imp[lane * 64 + ((j) ^ lane)]
#pragma unroll 1
    for (int j = 0; j < 64; ++j) IMP(j) = 0.f;
    const int ncmax = (t0 + 63 >= 31) ? (t0 + 63 - 31) / 16 + 1 : 0;
    const int ncv = (t >= 31) ? (t - 31) / 16 + 1 : 0;
    for (int g = 0; g < 4; ++g) {
        const int h = hkv * 4 + g; const float* bd = BD + h * 4096;
        float q[64], o[64]; load_q64(q, Z + rowq * ZW + Z_NQ + h * 64, 0.125f);
        float m = -1e30f, l = 0.f;
        for (int c = 0; c < ncmax; ++c) { const bool valid = c < ncv; const int dist = t - (16 * c + 31);
            const float sc = dot64_f(q, KC + ((size_t)(b * NCMP + c) * 2 + hkv) * 64) + bd[valid ? dist : 0];
            if (valid) { const float mn = fmaxf(m, sc); l = l * __expf(m - mn) + __expf(sc - mn); m = mn; } }
        const float rl = l > 0.f ? 1.0f / l : 0.f;
#pragma unroll
        for (int d = 0; d < 64; ++d) o[d] = 0.f;
        for (int c = 0; c < ncmax; ++c) { const bool valid = c < ncv; const int dist = t - (16 * c + 31);
            const float* kc = KC + ((size_t)(b * NCMP + c) * 2 + hkv) * 64; const float* vc = VC + ((size_t)(b * NCMP + c) * 2 + hkv) * 64;
            const float sc = dot64_f(q, kc) + bd[valid ? dist : 0];
            const float p = valid ? __expf(sc - m) * rl : 0.f;
            const float4* v4 = (const float4*)vc;
#pragma unroll
            for (int i = 0; i < 16; ++i) { const float4 w = v4[i]; o[4 * i] += p * w.x; o[4 * i + 1] += p * w.y; o[4 * i + 2] += p * w.z; o[4 * i + 3] += p * w.w;  if ((i & 3) == 3) asm volatile("" ::: "memory"); }
            const int j = c >> 2;
            if ((c & 3) < 3) IMP(j) += p; else { IMP(j) += 0.5f * p; if (j + 1 < 64) IMP(j + 1) += 0.5f * p; } }
        const float gt = sigmoidf_(bf2f(Z[rowq * ZW + Z_GATE + h * 3 + 0]));
        store_o64<false>(OA + rowq * 512 + h * 64, o, gt);
    }
    const int cur = t >> 6;
    unsigned long long mask = 1ull | (1ull << cur); if (cur >= 1) mask |= 1ull << (cur - 1);
    const int need = 16 - __popcll(mask);
    for (int it = 0; it < 13; ++it) { if (it >= need) break;
        float best = -1.f; int bj = -1;
#pragma unroll 1
        for (int j = 1; j <= cur - 2; ++j) { const float v = IMP(j); if (!((mask >> j) & 1ull) && v > best) { best = v; bj = j; } }
        if (bj < 0) break; mask |= 1ull << bj; }
    SEL[(size_t)(b * 2 + hkv) * SEQ + t] = mask;
    LDS_WAIT();
#undef IMP
}
__device__ __forceinline__ void winsel_unit(const bf16_t* __restrict__ Z, const float* __restrict__ BD, const unsigned long long* __restrict__ SEL, bf16_t* __restrict__ OA, int b, int h, int t0, int lane) {
    asm volatile("" : "+v"(lane));
    const int t = t0 + lane, hkv = h >> 2, cur = t0 >> 6; const size_t rowq = (size_t)(b * SEQ + t);
    const float* bd = BD + h * 4096;
    float q[64], o[64]; load_q64(q, Z + rowq * ZW + Z_NQ + h * 64, 0.125f);
#pragma unroll
    for (int d = 0; d < 64; ++d) o[d] = 0.f;
    float m = -1e30f, l = 0.f;
    { const int s_lo = t0 - 511 > 0 ? t0 - 511 : 0, s_hi = t0 + 63;
      for (int s = s_lo; s <= s_hi; ++s) { const bf16_t* kr = Z + (size_t)(b * SEQ + s) * ZW; const int dist = t - s; const bool valid = dist >= 0 && dist < 512;
          const float sc = dot64_bf(q, kr + Z_KW + hkv * 64) + bd[valid ? dist : 0];
          if (valid) upd_bf(o, m, l, sc, kr + Z_VW + hkv * 64); } }
    store_o64<true>(OA + rowq * 512 + h * 64, o, sigmoidf_(bf2f(Z[rowq * ZW + Z_GATE + h * 3 + 2])) / l);
    const unsigned long long mask = SEL[(size_t)(b * 2 + hkv) * SEQ + t];
#pragma unroll
    for (int d = 0; d < 64; ++d) o[d] = 0.f;
    m = -1e30f; l = 0.f;
    for (int j = 0; j <= cur; ++j) { const bool need = (mask >> j) & 1ull; if (!__any(need)) continue;
        for (int p = 0; p < 64; ++p) { const int s = 64 * j + p; const int dist = t - s; const bool valid = need && dist >= 0;
            const bf16_t* kr = Z + (size_t)(b * SEQ + s) * ZW;
            const float sc = dot64_bf(q, kr + Z_KS + hkv * 64) + bd[valid ? dist : 0];
            if (valid) upd_bf(o, m, l, sc, kr + Z_VS + hkv * 64); } }
    store_o64<true>(OA + rowq * 512 + h * 64, o, sigmoidf_(bf2f(Z[rowq * ZW + Z_GATE + h * 3 + 1])) / l);
}
__device__ __forceinline__ void mla_unit(const bf16_t* __restrict__ MQ, const bf16_t* __restrict__ MKV, const float* __restrict__ KR, const float* __restrict__ RC, const float* __restrict__ RS, bf16_t* __restrict__ OC, int b, int h, int t0, int lane) {
    asm volatile("" : "+v"(lane));
    const int t = t0 + lane; const size_t rowq = (size_t)(b * SEQ + t);
    const float scale = 0.10206207261596577f;
    float q[64], qr[32], o[64]; load_q64(q, MQ + rowq * 768 + h * 96, scale);
    { const bf16_t* p = MQ + rowq * 768 + h * 96 + 64;
#pragma unroll
      for (int i = 0; i < 16; ++i) { const float x1 = bf2f(p[i]), x2 = bf2f(p[16 + i]); const float c = RC[t * 16 + i], sn = RS[t * 16 + i]; qr[i] = (x1 * c - x2 * sn) * scale; qr[16 + i] = (x1 * sn + x2 * c) * scale; } }
#pragma unroll
    for (int d = 0; d < 64; ++d) o[d] = 0.f;
    float m = -1e30f, l = 0.f;
    for (int s = 0; s <= t0 + 63; ++s) { const size_t rk = (size_t)(b * SEQ + s); const bf16_t* kv = MKV + rk * 1024 + h * 128; const float4* kr4 = (const float4*)(KR + rk * 32);
        float sc = dot64_bf(q, kv);
#pragma unroll
        for (int i = 0; i < 8; ++i) { const float4 w = kr4[i]; sc += qr[4 * i] * w.x + qr[4 * i + 1] * w.y + qr[4 * i + 2] * w.z + qr[4 * i + 3] * w.w; }
        if (s <= t) upd_bf(o, m, l, sc, kv + 64); }
    store_o64<false>(OC + rowq * 512 + h * 64, o, 1.0f / l);
}
__device__ __forceinline__ void merge_row(const bf16_t* __restrict__ GY, bf16_t* __restrict__ out, int row, int lane) {
    asm volatile("" : "+v"(lane));
#pragma unroll
    for (int j = 0; j < 2; ++j) { const int c = j * 512 + lane * 8; float r[8];
#pragma unroll
        for (int e = 0; e < 8; ++e) r[e] = 0.f;
#pragma unroll
        for (int n = 0; n < 3; ++n) { const uint4 g = *(const uint4*)(GY + (size_t)row * 3072 + n * 1024 + c);
            r[0] += bflo(g.x); r[1] += bfhi(g.x); r[2] += bflo(g.y); r[3] += bfhi(g.y); r[4] += bflo(g.z); r[5] += bfhi(g.z); r[6] += bflo(g.w); r[7] += bfhi(g.w); }
        uint4 w; w.x = (unsigned)f2bf(r[0]) | ((unsigned)f2bf(r[1]) << 16); w.y = (unsigned)f2bf(r[2]) | ((unsigned)f2bf(r[3]) << 16);
        w.z = (unsigned)f2bf(r[4]) | ((unsigned)f2bf(r[5]) << 16); w.w = (unsigned)f2bf(r[6]) | ((unsigned)f2bf(r[7]) << 16);
        *(uint4*)(out + (size_t)row * 1024 + c) = w; }
}

template <bool XIN32> __device__ __forceinline__ void resid_row2(const bf16_t* __restrict__ y, const float* __restrict__ gpost, float scale, const float* __restrict__ xin32, const bf16_t* xinb, bf16_t* xb, float* rs,
                                                                float* __restrict__ out32, int row0, int row1, int lane) {
    float4 v[2][4], xx[2][4]; float s[2] = {0.f, 0.f};
    const float ri0 = XIN32 ? 1.0f : 1.0f / rs[row0], ri1 = XIN32 ? 1.0f : 1.0f / rs[row1];
#pragma unroll
    for (int q = 0; q < 2; ++q) { const int row = q ? row1 : row0; const ushort4* yr = (const ushort4*)(y + (size_t)row * DM);
#pragma unroll
        for (int j = 0; j < 4; ++j) { const ushort4 t = yr[j * 64 + lane]; v[q][j] = make_float4(bf2f(t.x), bf2f(t.y), bf2f(t.z), bf2f(t.w));
            if (XIN32) xx[q][j] = ((const float4*)(xin32 + (size_t)row * DM))[j * 64 + lane];
            else { const ushort4 u = ((const ushort4*)(xinb + (size_t)row * DM))[j * 64 + lane]; xx[q][j] = make_float4(bf2f(u.x), bf2f(u.y), bf2f(u.z), bf2f(u.w)); } } }
#pragma unroll
    for (int q = 0; q < 2; ++q)
#pragma unroll
        for (int j = 0; j < 4; ++j) s[q] += v[q][j].x * v[q][j].x + v[q][j].y * v[q][j].y + v[q][j].z * v[q][j].z + v[q][j].w * v[q][j].w;
    const float inv0 = rsqrtf(wave_sum(s[0]) * (1.0f / DM) + NORM_EPS) * scale, inv1 = rsqrtf(wave_sum(s[1]) * (1.0f / DM) + NORM_EPS) * scale;
    float s2[2] = {0.f, 0.f};
#pragma unroll
    for (int j = 0; j < 4; ++j) { const float4 gg = ((const float4*)gpost)[j * 64 + lane];
#pragma unroll
        for (int q = 0; q < 2; ++q) { const float inv = q ? inv1 : inv0, ri = q ? ri1 : ri0;
            v[q][j].x = xx[q][j].x * ri + v[q][j].x * inv * gg.x; v[q][j].y = xx[q][j].y * ri + v[q][j].y * inv * gg.y; v[q][j].z = xx[q][j].z * ri + v[q][j].z * inv * gg.z; v[q][j].w = xx[q][j].w * ri + v[q][j].w * inv * gg.w;
            s2[q] += v[q][j].x * v[q][j].x + v[q][j].y * v[q][j].y + v[q][j].z * v[q][j].z + v[q][j].w * v[q][j].w; } }
    if (out32) {
#pragma unroll
        for (int q = 0; q < 2; ++q) { const int row = q ? row1 : row0;
#pragma unroll
            for (int j = 0; j < 4; ++j) ((float4*)(out32 + (size_t)row * DM))[j * 64 + lane] = v[q][j]; }
    } else {
        const float r0 = rsqrtf(wave_sum(s2[0]) * (1.0f / DM) + NORM_EPS), r1 = rsqrtf(wave_sum(s2[1]) * (1.0f / DM) + NORM_EPS);
#pragma unroll
        for (int q = 0; q < 2; ++q) { const int row = q ? row1 : row0; const float r = q ? r1 : r0;
#pragma unroll
            for (int j = 0; j < 4; ++j) { ushort4 o; o.x = f2bf(v[q][j].x * r); o.y = f2bf(v[q][j].y * r); o.z = f2bf(v[q][j].z * r); o.w = f2bf(v[q][j].w * r); ((ushort4*)(xb + (size_t)row * DM))[j * 64 + lane] = o; } }
        if (lane == 0) { rs[row0] = r0; rs[row1] = r1; }
    }
}
__device__ __forceinline__ void xinit_row(const float* __restrict__ x, bf16_t* __restrict__ xb, float* __restrict__ rs, int row, int lane) {
    const float4* xr = (const float4*)(x + (size_t)row * DM); float4 v[4]; float s = 0.f;
#pragma unroll
    for (int j = 0; j < 4; ++j) { v[j] = xr[j * 64 + lane]; s += v[j].x * v[j].x + v[j].y * v[j].y + v[j].z * v[j].z + v[j].w * v[j].w; }
    const float r = rsqrtf(wave_sum(s) * (1.0f / DM) + NORM_EPS);
#pragma unroll
    for (int j = 0; j < 4; ++j) { ushort4 o; o.x = f2bf(v[j].x * r); o.y = f2bf(v[j].y * r); o.z = f2bf(v[j].z * r); o.w = f2bf(v[j].w * r); ((ushort4*)(xb + (size_t)row * DM))[j * 64 + lane] = o; }
    if (lane == 0) rs[row] = r;
}

__device__ __forceinline__ void mla_prep_rows4(const bf16_t* __restrict__ Z, const float* __restrict__ gq, const float* __restrict__ gkv, const float* __restrict__ RC, const float* __restrict__ RS,
                                               bf16_t* __restrict__ QN, bf16_t* __restrict__ KVN, bf16_t* __restrict__ KR, int row0, int rstep, int lane) {
    asm volatile("" : "+v"(lane));
    const bool hq = lane < 48, hk = lane < 32; const int lq = hq ? lane : 0, lk = hk ? lane : 0, l16 = lane & 15;
    uint4 wq[4], wk[4]; float x1[4], x2[4], cs[4], sn[4];
#pragma unroll
    for (int r = 0; r < 4; ++r) { const int row = row0 + r * rstep; const bf16_t* z = Z + (size_t)row * ZW; const int pos = row & (SEQ - 1);
        wq[r] = *(const uint4*)(z + Z_MQ + lq * 8); wk[r] = *(const uint4*)(z + Z_MKV + lk * 8);
        x1[r] = bf2f(z[Z_MKR + l16]); x2[r] = bf2f(z[Z_MKR + 16 + l16]); cs[r] = RC[pos * 16 + l16]; sn[r] = RS[pos * 16 + l16]; }
    const float4 gq0 = ((const float4*)gq)[lq * 2], gq1 = ((const float4*)gq)[lq * 2 + 1], gk0 = ((const float4*)gkv)[lk * 2], gk1 = ((const float4*)gkv)[lk * 2 + 1];
#pragma unroll
    for (int r = 0; r < 4; ++r) { const int row = row0 + r * rstep;
        if (!hq) wq[r] = make_uint4(0u, 0u, 0u, 0u);
        if (!hk) wk[r] = make_uint4(0u, 0u, 0u, 0u);
        float q[8] = {bflo(wq[r].x), bfhi(wq[r].x), bflo(wq[r].y), bfhi(wq[r].y), bflo(wq[r].z), bfhi(wq[r].z), bflo(wq[r].w), bfhi(wq[r].w)};
        float kv[8] = {bflo(wk[r].x), bfhi(wk[r].x), bflo(wk[r].y), bfhi(wk[r].y), bflo(wk[r].z), bfhi(wk[r].z), bflo(wk[r].w), bfhi(wk[r].w)};
        float sq = 0.f, sk = 0.f;
#pragma unroll
        for (int e = 0; e < 8; ++e) { sq += q[e] * q[e]; sk += kv[e] * kv[e]; }
        const float invq = rsqrtf(wave_sum(sq) * (1.0f / 384.0f) + NORM_EPS), invk = rsqrtf(wave_sum(sk) * (1.0f / 256.0f) + NORM_EPS);
        if (hq) { uint4 w;
            w.x = (unsigned)f2bf(q[0] * invq * gq0.x) | ((unsigned)f2bf(q[1] * invq * gq0.y) << 16); w.y = (unsigned)f2bf(q[2] * invq * gq0.z) | ((unsigned)f2bf(q[3] * invq * gq0.w) << 16);
            w.z = (unsigned)f2bf(q[4] * invq * gq1.x) | ((unsigned)f2bf(q[5] * invq * gq1.y) << 16); w.w = (unsigned)f2bf(q[6] * invq * gq1.z) | ((unsigned)f2bf(q[7] * invq * gq1.w) << 16);
            *(uint4*)(QN + (size_t)row * 384 + lane * 8) = w; }
        if (hk) { uint4 w;
            w.x = (unsigned)f2bf(kv[0] * invk * gk0.x) | ((unsigned)f2bf(kv[1] * invk * gk0.y) << 16); w.y = (unsigned)f2bf(kv[2] * invk * gk0.z) | ((unsigned)f2bf(kv[3] * invk * gk0.w) << 16);
            w.z = (unsigned)f2bf(kv[4] * invk * gk1.x) | ((unsigned)f2bf(kv[5] * invk * gk1.y) << 16); w.w = (unsigned)f2bf(kv[6] * invk * gk1.z) | ((unsigned)f2bf(kv[7] * invk * gk1.w) << 16);
            *(uint4*)(KVN + (size_t)row * 256 + lane * 8) = w; }
        if (lane < 16) { KR[(size_t)row * 32 + lane] = f2bf(x1[r] * cs[r] - x2[r] * sn[r]); KR[(size_t)row * 32 + 16 + lane] = f2bf(x1[r] * sn[r] + x2[r] * cs[r]); } }
}

typedef short bf16x8_t __attribute__((ext_vector_type(8)));
typedef float f32x16_t __attribute__((ext_vector_type(16)));
typedef short v4i16_t __attribute__((ext_vector_type(4)));
constexpr int AT_LUT = 0, AT_K0 = 16384, AT_KB = 64 * 104 * 2, AT_V0 = AT_K0 + 2 * AT_KB, AT_VP = 96, AT_VB = 64 * AT_VP * 2, AT_MISC = AT_V0 + 2 * AT_VB;
static_assert(AT_MISC + 64 <= RING_BYTES, "attention LDS map");
constexpr float LOG2E = 1.4426950408889634f;
#define MAX_DEFER 6.0f
#define MFMA32(a, b, c) __builtin_amdgcn_mfma_f32_32x32x16_bf16((a), (b), (c), 0, 0, 0)
__device__ __forceinline__ float swap_max(float x) { auto rr = __builtin_amdgcn_permlane32_swap(__float_as_uint(x), __float_as_uint(x), false, false); return fmaxf(__uint_as_float(rr[0]), __uint_as_float(rr[1])); }
__device__ __forceinline__ float swap_sum(float x) { auto rr = __builtin_amdgcn_permlane32_swap(__float_as_uint(x), __float_as_uint(x), false, false); return __uint_as_float(rr[0]) + __uint_as_float(rr[1]); }
__device__ __forceinline__ bf16x8_t pack8(const f32x16_t& p, int base) {
    u32x4_t w; w.x = pg8::cvt_pk_bf16(p[base + 0], p[base + 1]); w.y = pg8::cvt_pk_bf16(p[base + 2], p[base + 3]); w.z = pg8::cvt_pk_bf16(p[base + 4], p[base + 5]); w.w = pg8::cvt_pk_bf16(p[base + 6], p[base + 7]);
    return __builtin_bit_cast(bf16x8_t, w);
}
__device__ __forceinline__ v4i16_t tr_read(LAS const unsigned char* p) { return __builtin_amdgcn_ds_read_tr16_b64_v4i16((LAS v4i16_t*)p); }

#define GAS __attribute__((address_space(1)))
#define WG_BAR_LDS() asm volatile("s_waitcnt lgkmcnt(0)\n\ts_barrier" ::: "memory")
__device__ __forceinline__ u32x4_t gload16(const void* p) { return *(const GAS u32x4_t*)p; }
template <int DQK, int MODE>
__device__ __forceinline__ void attn_s1(LAS const unsigned char* Kl, LAS const float* lut, const bf16x8_t (&qf)[DQK / 16], f32x16_t (&o)[2], float& m, f32x16_t& lacc,
                                        int qpos, int kbase, bool flag, int kind, float c2, float cb, int lane, bf16x8_t (&pf)[4]) {
    constexpr int KP = DQK + 8, ND = DQK / 16;
    const int r32 = lane & 31, hi = lane >> 5;
    f32x16_t p0, p1;
#pragma unroll
    for (int r = 0; r < 16; ++r) { p0[r] = 0.f; p1[r] = 0.f; }
    { LAS const unsigned char* kp = Kl + (r32 * KP + 8 * hi) * 2;
      bf16x8_t kf[2 * ND];
#pragma unroll
      for (int d0 = 0; d0 < ND; ++d0) kf[d0] = *(LAS const bf16x8_t*)(kp + d0 * 32);
#pragma unroll
      for (int d0 = 0; d0 < ND; ++d0) kf[ND + d0] = *(LAS const bf16x8_t*)(kp + d0 * 32 + 32 * KP * 2);
      __builtin_amdgcn_sched_barrier(0);
#pragma unroll
      for (int d0 = 0; d0 < ND; ++d0) p0 = MFMA32(kf[d0], qf[d0], p0);
#pragma unroll
      for (int d0 = 0; d0 < ND; ++d0) p1 = MFMA32(kf[ND + d0], qf[d0], p1);
    }
    constexpr int KS = (MODE == 4) ? 16 : 1;
    const int d00 = qpos - (MODE == 4 ? 31 : 0) - KS * (kbase + 4 * hi);
    float alpha;
    if (MODE != 3 && (kind & 2)) {
        if (MODE == 1 || MODE == 2) {
            typedef float f32x2_l __attribute__((ext_vector_type(2)));
            LAS const float* lp = lut + kbase;
#pragma unroll
            for (int g4 = 0; g4 < 4; ++g4) {
                const f32x2_l a0 = *(LAS const f32x2_l*)(lp + 8 * g4), b0 = *(LAS const f32x2_l*)(lp + 8 * g4 + 2), a1 = *(LAS const f32x2_l*)(lp + 32 + 8 * g4), b1 = *(LAS const f32x2_l*)(lp + 32 + 8 * g4 + 2);
                p0[4 * g4] = fmaf(p0[4 * g4], c2, a0.x); p0[4 * g4 + 1] = fmaf(p0[4 * g4 + 1], c2, a0.y); p0[4 * g4 + 2] = fmaf(p0[4 * g4 + 2], c2, b0.x); p0[4 * g4 + 3] = fmaf(p0[4 * g4 + 3], c2, b0.y);
                p1[4 * g4] = fmaf(p1[4 * g4], c2, a1.x); p1[4 * g4 + 1] = fmaf(p1[4 * g4 + 1], c2, a1.y); p1[4 * g4 + 2] = fmaf(p1[4 * g4 + 2], c2, b1.x); p1[4 * g4 + 3] = fmaf(p1[4 * g4 + 3], c2, b1.y); }
        } else {
#pragma unroll
        for (int r = 0; r < 16; ++r) { const int dist0 = d00 - KS * ((r & 3) + 8 * (r >> 2)), dist1 = dist0 - 32 * KS;
            p0[r] = fmaf(p0[r], c2, lut[min(max(dist0, 0), 1023)]); p1[r] = fmaf(p1[r], c2, lut[min(max(dist1, 0), 1023)]); }
        }
        if (kind & 1) {
#pragma unroll
            for (int r = 0; r < 16; ++r) { const int dist0 = d00 - KS * ((r & 3) + 8 * (r >> 2)), dist1 = dist0 - 32 * KS;
                bool k0, k1;
                if (MODE == 0) { k0 = (unsigned)dist0 < 128u; k1 = (unsigned)dist1 < 128u; }
                else if (MODE == 1) { k0 = (unsigned)dist0 < 512u; k1 = (unsigned)dist1 < 512u; }
                else { k0 = dist0 >= 0; k1 = dist1 >= 0; }
                p0[r] = k0 ? p0[r] : -INFINITY; p1[r] = k1 ? p1[r] : -INFINITY; }
        }
        float mx = -INFINITY;
#pragma unroll
        for (int r = 0; r < 16; ++r) mx = fmaxf(mx, fmaxf(p0[r], p1[r]));
        if (MODE == 2) mx = flag ? mx : -INFINITY;
        mx = swap_max(mx);
        const float mn = (mx > m + MAX_DEFER) ? mx : m, mne = (MODE == 2) ? (flag ? mn : INFINITY) : mn;
        alpha = __builtin_amdgcn_exp2f(m - mn); m = mn;
#pragma unroll
        for (int r = 0; r < 16; ++r) { p0[r] = __builtin_amdgcn_exp2f(p0[r] - mne); p1[r] = __builtin_amdgcn_exp2f(p1[r] - mne); }
    } else {
        if (kind & 1) {
#pragma unroll
            for (int r = 0; r < 16; ++r) { const int dist0 = d00 - KS * ((r & 3) + 8 * (r >> 2)), dist1 = dist0 - 32 * KS;
                p0[r] = dist0 >= 0 ? p0[r] : -INFINITY; p1[r] = dist1 >= 0 ? p1[r] : -INFINITY; }
        }
        float mx;
        { float pinf = INFINITY; asm volatile("" : "+s"(pinf));
          float q0 = __builtin_amdgcn_fmed3f(p0[0], p1[0], pinf), q1 = __builtin_amdgcn_fmed3f(p0[1], p1[1], pinf), q2 = __builtin_amdgcn_fmed3f(p0[2], p1[2], pinf), q3 = __builtin_amdgcn_fmed3f(p0[3], p1[3], pinf);
#pragma unroll
          for (int r = 4; r < 16; r += 4) { q0 = __builtin_amdgcn_fmed3f(q0, __builtin_amdgcn_fmed3f(p0[r], p1[r], pinf), pinf); q1 = __builtin_amdgcn_fmed3f(q1, __builtin_amdgcn_fmed3f(p0[r + 1], p1[r + 1], pinf), pinf);
              q2 = __builtin_amdgcn_fmed3f(q2, __builtin_amdgcn_fmed3f(p0[r + 2], p1[r + 2], pinf), pinf); q3 = __builtin_amdgcn_fmed3f(q3, __builtin_amdgcn_fmed3f(p0[r + 3], p1[r + 3], pinf), pinf); }
          mx = __builtin_amdgcn_fmed3f(__builtin_amdgcn_fmed3f(q0, q1, pinf), __builtin_amdgcn_fmed3f(q2, q3, pinf), pinf); }
        mx = fmaf(mx, c2, cb);
        if (MODE == 2) mx = flag ? mx : -INFINITY;
        mx = swap_max(mx);
        const float mn = (mx > m + MAX_DEFER) ? mx : m, sub = (MODE == 2) ? (flag ? cb - mn : -INFINITY) : cb - mn;
        alpha = __builtin_amdgcn_exp2f(m - mn); m = mn;
#pragma unroll
        for (int r = 0; r < 16; ++r) { p0[r] = __builtin_amdgcn_exp2f(fmaf(p0[r], c2, sub)); p1[r] = __builtin_amdgcn_exp2f(fmaf(p1[r], c2, sub)); }
    }
    if (__any(alpha != 1.0f)) {
#pragma unroll
        for (int r = 0; r < 16; ++r) { o[0][r] *= alpha; o[1][r] *= alpha; }
        lacc[0] *= alpha;
    }
    pf[0] = pack8(p0, 0); pf[1] = pack8(p0, 8); pf[2] = pack8(p1, 0); pf[3] = pack8(p1, 8);
}
__device__ __forceinline__ void attn_s2(LAS const unsigned char* Vl, const bf16x8_t (&pf)[4], f32x16_t (&o)[2], f32x16_t& lacc, int lane) {
    const int hi = lane >> 5, i16 = lane & 15, blk = (lane >> 4) & 1;
    LAS const unsigned char* vp = Vl + ((4 * hi + (i16 >> 2)) * AT_VP + 16 * blk) * 2 + 8 * (i16 & 3);
    bf16x8_t vf[4], vg2[4];
#pragma unroll
    for (int s = 0; s < 2; ++s)
#pragma unroll
        for (int db = 0; db < 2; ++db) { const v4i16_t lo = tr_read(vp + (16 * s) * AT_VP * 2 + db * 64), hh = tr_read(vp + (16 * s + 8) * AT_VP * 2 + db * 64);
            vf[2 * s + db] = __builtin_shufflevector(lo, hh, 0, 1, 2, 3, 4, 5, 6, 7); }
#pragma unroll
    for (int s = 2; s < 4; ++s)
#pragma unroll
        for (int db = 0; db < 2; ++db) { const v4i16_t lo = tr_read(vp + (16 * s) * AT_VP * 2 + db * 64), hh = tr_read(vp + (16 * s + 8) * AT_VP * 2 + db * 64);
            vg2[2 * (s - 2) + db] = __builtin_shufflevector(lo, hh, 0, 1, 2, 3, 4, 5, 6, 7); }
    __builtin_amdgcn_sched_barrier(0);
#pragma unroll
    for (int s = 0; s < 2; ++s)
#pragma unroll
        for (int db = 0; db < 2; ++db) o[db] = MFMA32(vf[2 * s + db], pf[s], o[db]);
#pragma unroll
    for (int s = 2; s < 4; ++s)
#pragma unroll
        for (int db = 0; db < 2; ++db) o[db] = MFMA32(vg2[2 * (s - 2) + db], pf[s], o[db]);
    { const bf16x8_t ones = {0x3f80, 0x3f80, 0x3f80, 0x3f80, 0x3f80, 0x3f80, 0x3f80, 0x3f80};
#pragma unroll
      for (int s = 0; s < 4; ++s) lacc = MFMA32(ones, pf[s], lacc); }
}
template <int DQK, int MODE>
__device__ __forceinline__ void attn_tile(LAS const unsigned char* Kl, LAS const unsigned char* Vl, LAS const float* lut, const bf16x8_t (&qf)[DQK / 16], f32x16_t (&o)[2], float& m, f32x16_t& lacc,
                                          int qpos, int kbase, bool flag, int kind, float c2, float cb, int lane) {
    bf16x8_t pf[4];
    attn_s1<DQK, MODE>(Kl, lut, qf, o, m, lacc, qpos, kbase, flag, kind, c2, cb, lane, pf);
    attn_s2(Vl, pf, o, lacc, lane);
}

template <int MODE>
__device__ __forceinline__ void gqa_pass(LAS unsigned char* lds, const bf16_t* __restrict__ Zb_, int kcol, int vcol, unsigned long long tmask, const bf16x8_t (&qf)[4], int qpos, unsigned long long selmask,
                                         LAS const float* lut, float c31, f32x16_t (&o)[2], float& m, f32x16_t& lacc, int tid, int lane) {
    constexpr int KP = 72;
    const int srow = tid >> 3, sch = tid & 7, q0w = __builtin_amdgcn_readfirstlane(qpos - (lane & 31));
    const bf16_t* kg = Zb_ + (size_t)srow * ZW + kcol + sch * 8; const bf16_t* vg = Zb_ + (size_t)srow * ZW + vcol + sch * 8;
    LAS unsigned char* kdst = lds + AT_K0 + (srow * KP + sch * 8) * 2; LAS unsigned char* vdst = lds + AT_V0 + (srow * AT_VP + sch * 8) * 2;
    int j = __builtin_ctzll(tmask);
    { const u32x4_t k0 = gload16(kg + (size_t)j * 64 * ZW), v0 = gload16(vg + (size_t)j * 64 * ZW); *(LAS u32x4_t*)kdst = k0; *(LAS u32x4_t*)vdst = v0; }
    WG_BAR_LDS();
    int buf = 0;
    for (;;) {
        tmask &= tmask - 1; const bool has_next = tmask != 0ull; const int jn = has_next ? __builtin_ctzll(tmask) : 0;
        u32x4_t kr, vr;
        if (has_next) { kr = gload16(kg + (size_t)jn * 64 * ZW); vr = gload16(vg + (size_t)jn * 64 * ZW); }
        { const int dmin = q0w - 64 * j - 63, dmax = q0w + 31 - 64 * j;
          int kind; bool fl = true;
          if (MODE == 2) { fl = (selmask >> j) & 1ull; kind = (dmin >= 790 ? 0 : 2) | (dmin >= 0 ? 0 : 1); }
          else { constexpr int W = MODE == 0 ? 128 : 512; kind = 2 | ((dmin >= 0 && dmax < W) ? 0 : 1); }
          attn_tile<64, MODE>(lds + AT_K0 + buf * AT_KB, lds + AT_V0 + buf * AT_VB, lut, qf, o, m, lacc, qpos, j * 64, fl, kind, 0.125f * LOG2E, c31, lane); }
        if (!has_next) break;
        *(LAS u32x4_t*)(kdst + (buf ^ 1) * AT_KB) = kr; *(LAS u32x4_t*)(vdst + (buf ^ 1) * AT_VB) = vr;
        WG_BAR_LDS();
        buf ^= 1; j = jn;
    }
    __syncthreads();
}
__device__ __forceinline__ void fill_lut(LAS unsigned char* lds, const float* __restrict__ L1G, int head0, int tid) {
    typedef __attribute__((address_space(1))) const u32x4_t gv4c;
    gv4c* src = (gv4c*)(L1G + (head0 >> 2) * 4096);
    const u32x4_t a0 = src[tid], a1 = src[512 + tid];
    ((LAS u32x4_t*)(lds + AT_LUT))[tid] = a0; ((LAS u32x4_t*)(lds + AT_LUT))[512 + tid] = a1;
}
__device__ __forceinline__ void swa_wg_unit(LAS unsigned char* lds, const bf16_t* __restrict__ Z, const float* __restrict__ BD, const float* __restrict__ sinks, bf16_t* __restrict__ OB, int b, int hkv, int ch, int wave, int lane) {
    asm volatile("" : "+v"(lane));
    const int tid = wave * 64 + lane, r32 = lane & 31, hi = lane >> 5, g = wave >> 1, h = hkv * 4 + g, t0 = ch * 64, qpos = t0 + (wave & 1) * 32 + r32;
    const bf16_t* Zb_ = Z + (size_t)b * SEQ * ZW;
    bf16x8_t qf[4];
#pragma unroll
    for (int d0 = 0; d0 < 4; ++d0) qf[d0] = *(const bf16x8_t*)(Zb_ + (size_t)qpos * ZW + Z_SQ + h * 64 + 16 * d0 + 8 * hi);
    f32x16_t o[2];
#pragma unroll
    for (int r = 0; r < 16; ++r) { o[0][r] = 0.f; o[1][r] = 0.f; }
    float m = -1e30f; f32x16_t lacc;
#pragma unroll
    for (int r = 0; r < 16; ++r) lacc[r] = 0.f;
    const int jlo = ch - 2 > 0 ? ch - 2 : 0;
    const unsigned long long tmask = ((ch == 63 ? ~0ull : ((1ull << (ch + 1)) - 1ull))) & ~((1ull << jlo) - 1ull);
    __syncthreads();
    gqa_pass<0>(lds, Zb_, Z_SK + hkv * 64, Z_SV + hkv * 64, tmask, qf, qpos, 0ull, (LAS const float*)(lds + AT_LUT) + g * 1024, 0.f, o, m, lacc, tid, lane);
    const float lt = lacc[0], sk = sinks[h] * LOG2E, mf = fmaxf(m, sk), c = __builtin_amdgcn_exp2f(m - mf), f = c / (lt * c + __builtin_amdgcn_exp2f(sk - mf));
    bf16_t* orow = OB + (size_t)(b * SEQ + qpos) * 512 + h * 64;
#pragma unroll
    for (int db = 0; db < 2; ++db)
#pragma unroll
        for (int g4 = 0; g4 < 4; ++g4) { uint2 w; w.x = pg8::cvt_pk_bf16(o[db][4 * g4] * f, o[db][4 * g4 + 1] * f); w.y = pg8::cvt_pk_bf16(o[db][4 * g4 + 2] * f, o[db][4 * g4 + 3] * f);
            *(uint2*)(orow + 32 * db + 8 * g4 + 4 * hi) = w; }
}
__device__ __forceinline__ void mla_wg_unit(LAS unsigned char* lds, const bf16_t* __restrict__ MQ, const bf16_t* __restrict__ MKV, const bf16_t* __restrict__ KRb, const float* __restrict__ RC, const float* __restrict__ RS,
                                            bf16_t* __restrict__ OC, int b, int h, int qc, int wave, int lane) {
    asm volatile("" : "+v"(lane));
    constexpr int KP = 104;
    const int tid = wave * 64 + lane, r32 = lane & 31, hi = lane >> 5, t0 = qc * 256, qpos = t0 + wave * 32 + r32;
    const size_t rowq = (size_t)(b * SEQ + qpos);
    bf16x8_t qf[6];
#pragma unroll
    for (int d0 = 0; d0 < 4; ++d0) qf[d0] = *(const bf16x8_t*)(MQ + rowq * 768 + h * 96 + 16 * d0 + 8 * hi);
    { const bf16x8_t x1 = *(const bf16x8_t*)(MQ + rowq * 768 + h * 96 + 64 + 8 * hi), x2 = *(const bf16x8_t*)(MQ + rowq * 768 + h * 96 + 80 + 8 * hi);
      float a[8], c[8];
#pragma unroll
      for (int e = 0; e < 8; ++e) { const float v1 = bf2f((bf16_t)x1[e]), v2 = bf2f((bf16_t)x2[e]); const float cs = RC[qpos * 16 + 8 * hi + e], sn = RS[qpos * 16 + 8 * hi + e]; a[e] = v1 * cs - v2 * sn; c[e] = v1 * sn + v2 * cs; }
      u32x4_t w; w.x = pg8::cvt_pk_bf16(a[0], a[1]); w.y = pg8::cvt_pk_bf16(a[2], a[3]); w.z = pg8::cvt_pk_bf16(a[4], a[5]); w.w = pg8::cvt_pk_bf16(a[6], a[7]); qf[4] = __builtin_bit_cast(bf16x8_t, w);
      w.x = pg8::cvt_pk_bf16(c[0], c[1]); w.y = pg8::cvt_pk_bf16(c[2], c[3]); w.z = pg8::cvt_pk_bf16(c[4], c[5]); w.w = pg8::cvt_pk_bf16(c[6], c[7]); qf[5] = __builtin_bit_cast(bf16x8_t, w); }
    f32x16_t o[2];
#pragma unroll
    for (int r = 0; r < 16; ++r) { o[0][r] = 0.f; o[1][r] = 0.f; }
    float m = -1e30f; f32x16_t lacc;
#pragma unroll
    for (int r = 0; r < 16; ++r) lacc[r] = 0.f;
    const int srow = tid >> 3, sch = tid & 7, rrow = (tid & 255) >> 2, rch = tid & 3;
    const bf16_t* kg = MKV + (size_t)(b * SEQ + srow) * 1024 + h * 128 + sch * 8; const bf16_t* rg = KRb + (size_t)(b * SEQ + rrow) * 32 + rch * 8;
    LAS unsigned char* kdst = lds + AT_K0 + (srow * KP + sch * 8) * 2; LAS unsigned char* vdst = lds + AT_V0 + (srow * AT_VP + sch * 8) * 2; LAS unsigned char* rdst = lds + AT_K0 + (rrow * KP + 64 + rch * 8) * 2;
    const int nt = 4 * qc + 4, jmine = 4 * qc + (wave >> 1);
    { const u32x4_t k0 = gload16(kg), v0 = gload16(kg + 64), r0 = gload16(rg); *(LAS u32x4_t*)kdst = k0; *(LAS u32x4_t*)vdst = v0; if (tid < 256) *(LAS u32x4_t*)rdst = r0; }
    WG_BAR_LDS();
    const float c2 = 0.10206207261596577f * LOG2E;
    for (int j = 0; j < nt; ++j) { const int buf = j & 1; const bool has_next = j + 1 < nt;
        u32x4_t kr, vr, rr;
        if (has_next) { kr = gload16(kg + (size_t)(j + 1) * 64 * 1024); vr = gload16(kg + (size_t)(j + 1) * 64 * 1024 + 64); rr = gload16(rg + (size_t)(j + 1) * 64 * 32); }
        if (j <= jmine) attn_tile<96, 3>(lds + AT_K0 + buf * AT_KB, lds + AT_V0 + buf * AT_VB, nullptr, qf, o, m, lacc, qpos, j * 64, true, j == jmine ? 1 : 0, c2, 0.f, lane);
        if (has_next) { *(LAS u32x4_t*)(kdst + (buf ^ 1) * AT_KB) = kr; *(LAS u32x4_t*)(vdst + (buf ^ 1) * AT_VB) = vr; if (tid < 256) *(LAS u32x4_t*)(rdst + (buf ^ 1) * AT_KB) = rr; }
        WG_BAR_LDS();
    }
    const float f = 1.0f / lacc[0];
    bf16_t* orow = OC + rowq * 512 + h * 64;
#pragma unroll
    for (int db = 0; db < 2; ++db)
#pragma unroll
        for (int g4 = 0; g4 < 4; ++g4) { uint2 w; w.x = pg8::cvt_pk_bf16(o[db][4 * g4] * f, o[db][4 * g4 + 1] * f); w.y = pg8::cvt_pk_bf16(o[db][4 * g4 + 2] * f, o[db][4 * g4 + 3] * f);
            *(uint2*)(orow + 32 * db + 8 * g4 + 4 * hi) = w; }
}

typedef float f32x4_t __attribute__((ext_vector_type(4)));
__device__ __forceinline__ float gelu_tanh_fast(float x) { const float u = 1.5957691216057308f * (x + 0.044715f * x * x * x); return x * __builtin_amdgcn_rcpf(1.0f + __expf(-u)); }
constexpr int CP_HID = 0, CP_Z = 16384, CP_ZG = 33 * 144;
__device__ __forceinline__ void compress_wg_unit(LAS unsigned char* lds, const bf16_t* __restrict__ Z, const bf16_t* __restrict__ W1F, const bf16_t* __restrict__ W2t, const float* __restrict__ cpe, bf16_t* __restrict__ out,
                                                 int b, int hkv, int col, int ct, int wave, int lane) {
    asm volatile("" : "+v"(lane));
    const int r32 = lane & 31, hi = lane >> 5, c = 32 * ct + r32, tid = wave * 64 + lane;
    LAS int* hidT = (LAS int*)(lds + CP_HID);
    for (int i = tid; i < 128 * 32; i += 512) hidT[i] = 0;
    {
      const bf16_t* zsrc = Z + (size_t)(b * SEQ) * ZW + col; u32x4_t zz[9];
#pragma unroll
      for (int it = 0; it < 9; ++it) { const int i = it * 512 + tid, row = (i < 528 * 8 ? i : 0) >> 3, c8 = i & 7; int tok = 512 * ct + row; tok = tok < SEQ ? tok : SEQ - 1; zz[it] = gload16(zsrc + (size_t)tok * ZW + c8 * 8); }
#pragma unroll
      for (int it = 0; it < 9; ++it) { const int i = it * 512 + tid, row = i >> 3, c8 = i & 7; if (i < 528 * 8) *(LAS u32x4_t*)(lds + CP_Z + (row & 15) * CP_ZG + (row >> 4) * 144 + c8 * 16) = zz[it]; } }
    f32x16_t acc[4];
#pragma unroll
    for (int nt = 0; nt < 4; ++nt)
#pragma unroll
        for (int r = 0; r < 16; ++r) acc[nt][r] = 0.f;
    __syncthreads();
    typedef __attribute__((address_space(1))) const bf16x8_t gb8;
    gb8* wf = (gb8*)W1F + lane;
#pragma unroll 4
    for (int k_ = 0; k_ < 16; ++k_) { const int ks = wave * 16 + k_, lrow = ks >> 2;
        const int row = 16 * r32 + lrow;
        const bf16x8_t fb = *(LAS const bf16x8_t*)(lds + CP_Z + (row & 15) * CP_ZG + (row >> 4) * 144 + (16 * (ks & 3) + 8 * hi) * 2);
#pragma unroll
        for (int nt = 0; nt < 4; ++nt) { const bf16x8_t wa = wf[(ks * 4 + nt) * 64]; acc[nt] = MFMA32(wa, fb, acc[nt]); }
    }
#pragma unroll
    for (int nt = 0; nt < 4; ++nt)
#pragma unroll
        for (int r = 0; r < 16; ++r) (void)__hip_atomic_fetch_add(hidT + (32 * nt + (r & 3) + 8 * (r >> 2) + 4 * hi) * 32 + r32, __float2int_rn(acc[nt][r] * 1048576.0f), __ATOMIC_RELAXED, __HIP_MEMORY_SCOPE_WORKGROUP);
    __syncthreads();
    if (wave == 0) {
        typedef __attribute__((address_space(1))) const f32x4_t gf4; typedef __attribute__((address_space(1))) const v4i16_t gv4s;
        f32x4_t cb[4][4]; v4i16_t w2l[4][2][2], w2h[4][2][2];
#pragma unroll
        for (int nt = 0; nt < 4; ++nt) {
#pragma unroll
            for (int g4 = 0; g4 < 4; ++g4) cb[nt][g4] = *(gf4*)(cpe + 32 * nt + 8 * g4 + 4 * hi);
#pragma unroll
            for (int s = 0; s < 2; ++s)
#pragma unroll
                for (int et = 0; et < 2; ++et) { const bf16_t* w2p = W2t + (size_t)(32 * et + r32) * 128 + 32 * nt + 16 * s + 4 * hi; w2l[nt][s][et] = *(gv4s*)w2p; w2h[nt][s][et] = *(gv4s*)(w2p + 8); } }
        f32x16_t o2[2];
#pragma unroll
        for (int r = 0; r < 16; ++r) { o2[0][r] = 0.f; o2[1][r] = 0.f; }
#pragma unroll
        for (int nt = 0; nt < 4; ++nt) {
#pragma unroll
            for (int r = 0; r < 16; ++r) { const int n = 32 * nt + (r & 3) + 8 * (r >> 2) + 4 * hi; acc[nt][r] = gelu_tanh_fast((float)hidT[n * 32 + r32] * (1.0f / 1048576.0f) + cb[nt][r >> 2][r & 3]); }
#pragma unroll
            for (int s = 0; s < 2; ++s) { const bf16x8_t pf = pack8(acc[nt], 8 * s);
#pragma unroll
                for (int et = 0; et < 2; ++et) { const bf16x8_t wa = __builtin_shufflevector(w2l[nt][s][et], w2h[nt][s][et], 0, 1, 2, 3, 4, 5, 6, 7);
                    o2[et] = MFMA32(wa, pf, o2[et]); } }
        }
        bf16_t* orow = out + ((size_t)(b * 2 + hkv) * 256 + c) * 64;
        const bool pad = c >= NCMP;
#pragma unroll
        for (int et = 0; et < 2; ++et)
#pragma unroll
            for (int g4 = 0; g4 < 4; ++g4) { uint2 w; w.x = pg8::cvt_pk_bf16(o2[et][4 * g4], o2[et][4 * g4 + 1]); w.y = pg8::cvt_pk_bf16(o2[et][4 * g4 + 2], o2[et][4 * g4 + 3]);
                if (pad) { w.x = 0u; w.y = 0u; } *(uint2*)(orow + 32 * et + 8 * g4 + 4 * hi) = w; }
    }
    __syncthreads();
}
__device__ __forceinline__ void cpe_item(const float* __restrict__ pe, const float* __restrict__ w1, float* __restrict__ cpe, int n, int lane) {
    float s = 0.f;
#pragma unroll 8
    for (int i = lane; i < 2048; i += 64) s += pe[i] * w1[i * 128 + n];
    s = wave_sum(s);
    if (lane == 0) cpe[n] = s;
}

constexpr int NS_CK = 16384, NS_CV = NS_CK + 256 * 72 * 2, NS_IMP = NS_CV + 256 * AT_VP * 2, NS_MASK = NS_IMP + 64 * 65 * 4, NS_END = NS_MASK + 64 * 8;
constexpr int NS_L2 = AT_MISC + 64, NS_L2N = 1028;
static_assert(NS_CV == 53248 && NS_IMP == 102400 && NS_END <= RING_BYTES && NS_L2 % 8 == 0 && NS_L2 + 4 * 2 * NS_L2N * 4 <= NS_IMP, "NSA LDS map");

__device__ __forceinline__ void cmp_imp_tile(LAS const unsigned char* Kl, LAS const float* lut, const bf16x8_t (&qf)[4], float m, float rl, int qpos, int T, LAS unsigned* imp_row, int lane) {
    constexpr int KP = 72;
    const int r32 = lane & 31, hi = lane >> 5;
    f32x16_t p0, p1;
#pragma unroll
    for (int r = 0; r < 16; ++r) { p0[r] = 0.f; p1[r] = 0.f; }
    LAS const unsigned char* kp = Kl + (r32 * KP + 8 * hi) * 2;
#pragma unroll
    for (int d0 = 0; d0 < 4; ++d0) { const bf16x8_t k0 = *(LAS const bf16x8_t*)(kp + d0 * 32), k1 = *(LAS const bf16x8_t*)(kp + d0 * 32 + 32 * KP * 2); p0 = MFMA32(k0, qf[d0], p0); p1 = MFMA32(k1, qf[d0], p1); }
    const int d00 = qpos - 31 - 16 * (64 * T + 4 * hi);
#pragma unroll
    for (int r = 0; r < 16; ++r) { const int dist0 = d00 - 16 * ((r & 3) + 8 * (r >> 2)), dist1 = dist0 - 512;
        const float s0 = p0[r] * (0.125f * LOG2E) + lut[min(max(dist0, 0), 1023)], s1 = p1[r] * (0.125f * LOG2E) + lut[min(max(dist1, 0), 1023)];
        p0[r] = dist0 >= 0 ? __builtin_amdgcn_exp2f(s0 - m) * rl : 0.f; p1[r] = dist1 >= 0 ? __builtin_amdgcn_exp2f(s1 - m) * rl : 0.f; }
#pragma unroll
    for (int g4 = 0; g4 < 4; ++g4) {
        { const int j = 16 * T + 2 * g4 + hi; const float hb = 0.5f * p0[4 * g4 + 3]; (void)__hip_atomic_fetch_add(imp_row + j, (unsigned)__float2int_rn((p0[4 * g4] + p0[4 * g4 + 1] + p0[4 * g4 + 2] + hb) * 67108864.0f), __ATOMIC_RELAXED, __HIP_MEMORY_SCOPE_WORKGROUP); if (j + 1 < 64) (void)__hip_atomic_fetch_add(imp_row + j + 1, (unsigned)__float2int_rn(hb * 67108864.0f), __ATOMIC_RELAXED, __HIP_MEMORY_SCOPE_WORKGROUP); }
        { const int j = 16 * T + 8 + 2 * g4 + hi; const float hb = 0.5f * p1[4 * g4 + 3]; (void)__hip_atomic_fetch_add(imp_row + j, (unsigned)__float2int_rn((p1[4 * g4] + p1[4 * g4 + 1] + p1[4 * g4 + 2] + hb) * 67108864.0f), __ATOMIC_RELAXED, __HIP_MEMORY_SCOPE_WORKGROUP); if (j + 1 < 64) (void)__hip_atomic_fetch_add(imp_row + j + 1, (unsigned)__float2int_rn(hb * 67108864.0f), __ATOMIC_RELAXED, __HIP_MEMORY_SCOPE_WORKGROUP); }
    }
}

__device__ __forceinline__ void nsa_fused_unit(LAS unsigned char* lds, const bf16_t* __restrict__ Z, const float* __restrict__ L1G, const float* __restrict__ L2G, const bf16_t* __restrict__ KCb, const bf16_t* __restrict__ VCb, bf16_t* __restrict__ OA,
                                               int b, int hkv, int ch, int wave, int lane) {
    asm volatile("" : "+v"(lane));
    const int tid = wave * 64 + lane, r32 = lane & 31, hi = lane >> 5, g = wave >> 1, h = hkv * 4 + g, t0 = ch * 64, tok = (wave & 1) * 32 + r32, qpos = t0 + tok;
    fill_lut(lds, L1G, hkv * 4, tid);
    for (int i = tid; i < 64 * 65; i += 512) ((LAS unsigned*)(lds + NS_IMP))[i] = 0u;
    const int cmax = 4 * ch + 2;
    const int ntc = ch == 0 ? 1 : (cmax >> 6) + 1;
    {
      const bf16_t* kc = KCb + (size_t)(b * 2 + hkv) * 256 * 64; const bf16_t* vc = VCb + (size_t)(b * 2 + hkv) * 256 * 64;
      u32x4_t kk_[4], vv_[4];
#pragma unroll
      for (int T = 0; T < 4; ++T) { const int i = (T < ntc ? T : 0) * 512 + tid, row = i >> 3, c8 = i & 7; kk_[T] = gload16(kc + row * 64 + c8 * 8); vv_[T] = gload16(vc + row * 64 + c8 * 8); }
#pragma unroll
      for (int T = 0; T < 4; ++T) if (T < ntc) { const int i = T * 512 + tid, row = i >> 3, c8 = i & 7;
          *(LAS u32x4_t*)(lds + NS_CK + (row * 72 + c8 * 8) * 2) = kk_[T]; *(LAS u32x4_t*)(lds + NS_CV + (row * AT_VP + c8 * 8) * 2) = vv_[T]; } }
    const bf16_t* Zb_ = Z + (size_t)b * SEQ * ZW; const size_t rowq = (size_t)(b * SEQ + qpos);
    bf16x8_t qf[4];
#pragma unroll
    for (int d0 = 0; d0 < 4; ++d0) qf[d0] = *(const bf16x8_t*)(Zb_ + (size_t)qpos * ZW + Z_NQ + h * 64 + 16 * d0 + 8 * hi);
    LAS const float* lut = (LAS const float*)(lds + AT_LUT) + g * 1024;
    __syncthreads();
    f32x16_t o[2], lacc; unsigned accp[2][8];
    float m;
#pragma unroll
    for (int r = 0; r < 16; ++r) { o[0][r] = 0.f; o[1][r] = 0.f; }
    m = -1e30f;
#pragma unroll
    for (int r = 0; r < 16; ++r) lacc[r] = 0.f;
    for (int T = 0; T < ntc; ++T) attn_tile<64, 4>(lds + NS_CK + T * 64 * 72 * 2, lds + NS_CV + T * 64 * AT_VP * 2, lut, qf, o, m, lacc, qpos, 64 * T, true, 3, 0.125f * LOG2E, 0.f, lane);
    { const float lt = lacc[0], rl = lt > 0.f ? 1.0f / lt : 0.f;
      const float f = sigmoidf_(bf2f(Z[rowq * ZW + Z_GATE + h * 3 + 0])) * rl;
#pragma unroll
      for (int r = 0; r < 8; ++r) { accp[0][r] = pg8::cvt_pk_bf16(o[0][2 * r] * f, o[0][2 * r + 1] * f); accp[1][r] = pg8::cvt_pk_bf16(o[1][2 * r] * f, o[1][2 * r + 1] * f); }
      LAS unsigned* imp_row = (LAS unsigned*)(lds + NS_IMP) + tok * 65;
      for (int T = 0; T < ntc; ++T) cmp_imp_tile(lds + NS_CK + T * 64 * 72 * 2, lut, qf, m, rl, qpos, T, imp_row, lane); }
    __syncthreads();
    {
      typedef __attribute__((address_space(1))) const u32x4_t gv4c;
      gv4c* src = (gv4c*)(L2G + hkv * (4 * 2 * NS_L2N));
      u32x4_t lv[5];
#pragma unroll
      for (int it = 0; it < 5; ++it) { const int i = it * 512 + tid; lv[it] = src[i < 2 * NS_L2N ? i : 0]; }
#pragma unroll
      for (int it = 0; it < 5; ++it) { const int i = it * 512 + tid; if (i < 2 * NS_L2N) ((LAS u32x4_t*)(lds + NS_L2))[i] = lv[it]; } }
    { const int cur = ch; unsigned long long forced = 1ull | (1ull << cur); if (cur >= 1) forced |= 1ull << (cur - 1);
      const int need = 16 - __popcll(forced);
      for (int tt = 0; tt < 8; ++tt) { const int token = wave * 8 + tt;
          const unsigned v = ((LAS const unsigned*)(lds + NS_IMP))[token * 65 + lane];
          const bool cand = lane >= 1 && lane <= cur - 2;
          const unsigned long long cm = __ballot(cand);
          unsigned long long selb = cm;
          if (__popcll(cm) > need) {
              unsigned T = 0u;
              for (int bit = 28; bit >= 0; --bit) { const unsigned t = T | (1u << bit); if (__popcll(__ballot(cand && v >= t)) >= need) T = t; }
              const unsigned long long gt = __ballot(cand && v > T), eq = __ballot(cand && v == T);
              const int rem = need - __popcll(gt);
              const int below = (int)__builtin_amdgcn_mbcnt_hi((unsigned)(eq >> 32), __builtin_amdgcn_mbcnt_lo((unsigned)eq, 0u));
              selb = gt | __ballot(cand && v == T && below < rem);
          }
          if (lane == 0) ((LAS unsigned long long*)(lds + NS_MASK))[token] = selb | forced; } }
    __syncthreads();
    const unsigned long long selmask = ((LAS const unsigned long long*)(lds + NS_MASK))[tok];
    unsigned long long umask;
    { const unsigned long long u = ((LAS const unsigned long long*)(lds + NS_MASK))[lane]; unsigned lo = (unsigned)u, hh = (unsigned)(u >> 32);
#pragma unroll
      for (int s = 1; s < 64; s <<= 1) { lo |= __shfl_xor(lo, s); hh |= __shfl_xor(hh, s); }
      umask = ((unsigned long long)__builtin_amdgcn_readfirstlane(hh) << 32) | (unsigned long long)__builtin_amdgcn_readfirstlane(lo); }
    const float c31 = lut[1023];
    LAS const float* lutv;
    { const int xl = 959 - qpos + 4 * hi, k = xl & 1; lutv = (LAS const float*)(lds + NS_L2) + (g * 2 + k) * NS_L2N + (xl - k); }
#pragma unroll
    for (int r = 0; r < 16; ++r) { o[0][r] = 0.f; o[1][r] = 0.f; }
    m = -1e30f;
#pragma unroll
    for (int r = 0; r < 16; ++r) lacc[r] = 0.f;
    { const int jlo = ch - 8 > 0 ? ch - 8 : 0; const unsigned long long tmask = ((ch == 63 ? ~0ull : ((1ull << (ch + 1)) - 1ull))) & ~((1ull << jlo) - 1ull);
      gqa_pass<1>(lds, Zb_, Z_KW + hkv * 64, Z_VW + hkv * 64, tmask, qf, qpos, 0ull, lutv, c31, o, m, lacc, tid, lane); }
    { const float f = sigmoidf_(bf2f(Z[rowq * ZW + Z_GATE + h * 3 + 2])) / lacc[0];
#pragma unroll
      for (int r = 0; r < 8; ++r) { accp[0][r] = pg8::cvt_pk_bf16(fmaf(o[0][2 * r], f, bflo(accp[0][r])), fmaf(o[0][2 * r + 1], f, bfhi(accp[0][r]))); accp[1][r] = pg8::cvt_pk_bf16(fmaf(o[1][2 * r], f, bflo(accp[1][r])), fmaf(o[1][2 * r + 1], f, bfhi(accp[1][r]))); } }
#pragma unroll
    for (int r = 0; r < 16; ++r) { o[0][r] = 0.f; o[1][r] = 0.f; }
    m = -1e30f;
#pragma unroll
    for (int r = 0; r < 16; ++r) lacc[r] = 0.f;
    gqa_pass<2>(lds, Zb_, Z_KS + hkv * 64, Z_VS + hkv * 64, umask, qf, qpos, selmask, lutv, c31, o, m, lacc, tid, lane);
    { const float f = sigmoidf_(bf2f(Z[rowq * ZW + Z_GATE + h * 3 + 1])) / lacc[0];
#pragma unroll
      for (int r = 0; r < 8; ++r) { accp[0][r] = pg8::cvt_pk_bf16(fmaf(o[0][2 * r], f, bflo(accp[0][r])), fmaf(o[0][2 * r + 1], f, bfhi(accp[0][r]))); accp[1][r] = pg8::cvt_pk_bf16(fmaf(o[1][2 * r], f, bflo(accp[1][r])), fmaf(o[1][2 * r + 1], f, bfhi(accp[1][r]))); } }
    int b_o = b; asm volatile("" : "+s"(b_o));
    bf16_t* orow = OA + (size_t)(b_o * SEQ + qpos) * 512 + h * 64;
#pragma unroll
    for (int db = 0; db < 2; ++db)
#pragma unroll
        for (int g4 = 0; g4 < 4; ++g4) { uint2 w; w.x = accp[db][2 * g4]; w.y = accp[db][2 * g4 + 1]; *(uint2*)(orow + 32 * db + 8 * g4 + 4 * hi) = w; }
}

#ifdef NO_MLA_UNIT
#define U_MLA_UNIT(x) ((void)0)
#else
#define U_MLA_UNIT(x) x
#endif
#ifdef NO_WINSEL_UNIT
#define U_WINSEL_UNIT(x) ((void)0)
#else
#define U_WINSEL_UNIT(x) x
#endif
#ifdef NO_CMP_UNIT
#define U_CMP_UNIT(x) ((void)0)
#else
#define U_CMP_UNIT(x) x
#endif
#ifdef NO_SWA_UNIT
#define U_SWA_UNIT(x) ((void)0)
#else
#define U_SWA_UNIT(x) x
#endif
#ifdef NO_COMPRESS_ITEM
#define U_COMPRESS_ITEM(x) ((void)0)
#else
#define U_COMPRESS_ITEM(x) x
#endif
#ifdef NO_MLA_PREP_ROW
#define U_MLA_PREP_ROW(x) ((void)0)
#else
#define U_MLA_PREP_ROW(x) x
#endif
#ifdef NO_RESNORM_ROW
#define U_RESNORM_ROW(x) ((void)0)
#else
#define U_RESNORM_ROW(x) x
#endif
#ifdef NO_RMSNORM_ROW
#define U_RMSNORM_ROW(x) ((void)0)
#else
#define U_RMSNORM_ROW(x) x
#endif
#ifdef NO_MERGE_ROW
#define U_MERGE_ROW(x) ((void)0)
#else
#define U_MERGE_ROW(x) x
#endif
#ifdef NO_TR
#define U_TR(x) ((void)0)
#else
#define U_TR(x) x
#endif
#ifndef REP_FFN
#define REP_FFN 0
#endif
#ifndef REP_Z
#define REP_Z 0
#endif
#ifndef REP_CMP
#define REP_CMP 0
#endif
#ifndef REP_CPR
#define REP_CPR 0
#endif
#ifndef REP_G
#define REP_G 0
#endif
#ifndef REP_P5
#define REP_P5 0
#endif
#ifndef REP_BAR
#define REP_BAR 0
#endif
#ifndef REP_RN
#define REP_RN 0
#endif
#ifndef REP_MLA
#define REP_MLA 0
#endif
#ifndef REP_NSA
#define REP_NSA 0
#endif
#ifndef REP_SWA
#define REP_SWA 0
#endif
__device__ __forceinline__ int lane_id_opaque() { int l_; asm volatile("v_mbcnt_lo_u32_b32 %0, -1, 0\n\tv_mbcnt_hi_u32_b32 %0, -1, %0" : "=v"(l_)); return l_; }
__device__ __forceinline__ unsigned char* ws_opaque(const Params& p) { unsigned char* w = p.ws; asm volatile("" : "+s"(w)); return w; }
__device__ __forceinline__ const float* in_opaque(const Params& p, int i) { const float* w = p.in[i]; asm volatile("" : "+s"(w)); return w; }
__device__ __forceinline__ float* out_opaque(const Params& p) { float* w = p.out; asm volatile("" : "+s"(w)); return w; }
#define GEMM_PHASE(EPI, Aptr, LDA, BT, NN, KK, OUT, LDC, RSP) do { pg8::Gemm g_; g_.A = (Aptr); g_.Bt = (BT); g_.M = MTOK; g_.N = (NN); g_.K = (KK); g_.lda = (LDA); \
        pg8::StaticOrder S_; S_.init(MTOK, (NN), G, (int)blockIdx.x); EPI e_; e_.O = (OUT); e_.ldc = (LDC); e_.rs = (RSP); \
        pg8::gemm_phase<EPI, pg8::StaticOrder, true, true>((PG8_LAS unsigned char*)lds, g_, S_, e_, wave); } while (0)

typedef __attribute__((address_space(1))) unsigned gu32_t;
constexpr int CW_QUEUE = 16384;
#define GEMM_GATE(FIRST, Aptr, BT, GP) do { pg8::Gemm g_; g_.A = (Aptr); g_.Bt = (BT); g_.M = MTOK; g_.N = DM; g_.K = 512; g_.lda = 512; \
        pg8::StaticOrder S_; S_.init(MTOK, DM, G, (int)blockIdx.x); pg8::EpiGate<FIRST> e_; e_.O = MERGED; e_.ldc = DM; e_.Gp = (GP); e_.ldg = 3072; \
        pg8::gemm_phase<pg8::EpiGate<FIRST>, pg8::StaticOrder, true, true>((PG8_LAS unsigned char*)lds, g_, S_, e_, wave); } while (0)

__global__ void __launch_bounds__(512, 2) mega_fwd(Params p) {
    extern __shared__ __attribute__((aligned(16))) unsigned char lds[];
    const int tid = threadIdx.x, wave = __builtin_amdgcn_readfirstlane(tid >> 6);
#define lane (lane_id_opaque())
#define G ((int)gridDim.x)
#define gw ((int)blockIdx.x * NWAVES + wave)
#define NGW ((int)gridDim.x * NWAVES)
    for (int u = tid; u < (LDS_BYTES - LDSCTL_OFF) / 4; u += NWAVES * 64) ((LAS unsigned*)((LAS unsigned char*)lds + LDSCTL_OFF))[u] = 0u;
    __syncthreads();
    (void)xcd_barrier_post((unsigned*)(p.ws + WS_CTL) + CW_BAR, (volatile LAS unsigned*)((LAS unsigned char*)lds + MISC_OFF) + 8);
#define GRID_BAR() do { XcdBarrier b_; b_.bar = (unsigned*)(ws_opaque(p) + WS_CTL) + CW_BAR; b_.x = xb_xcc_id(); b_.st = (volatile LAS unsigned*)((LAS unsigned char*)lds + MISC_OFF) + 8; xcd_barrier(b_); if (REP_BAR) xcd_barrier(b_); } while (0)
#define scr ((LAS float*)((LAS unsigned char*)lds + wave * 16384))
#define WSP(T, off) ((T*)(ws_opaque(p) + (off)))
#define INP(i, off) (in_opaque(p, (i)) + (size_t)(off))
#define xo (out_opaque(p))
#define BD WSP(float, WS_BD)
#define RC WSP(float, WS_RC)
#define RS WSP(float, WS_RS)
#define KCb WSP(bf16_t, WS_KC)
#define VCb WSP(bf16_t, WS_KC + 512 * 1024)
#define W1T WSP(bf16_t, WS_VC)
#define W2T WSP(bf16_t, WS_RS + 256 * 1024)
#define CPE WSP(float, WS_RS + 256 * 1024 + 64 * 1024)
#define KR WSP(bf16_t, WS_KR)
#define SEL WSP(unsigned long long, WS_SEL)
#define Wgu1 WSP(bf16_t, WS_WT + WT_GU1)
#define Wd1 WSP(bf16_t, WS_WT + WT_D1)
#define Wgu2 WSP(bf16_t, WS_WT + WT_GU2)
#define Wd2 WSP(bf16_t, WS_WT + WT_D2)
#define Wza WSP(bf16_t, WS_WT + WT_ZA)
#define Wg WSP(bf16_t, WS_WT + WT_G)
#define Wb WSP(bf16_t, WS_WT + WT_B)
#define Wout WSP(bf16_t, WS_WT + WT_OUT)
#define Wqb WSP(bf16_t, WS_WT + WT_QB)
#define Wkvb WSP(bf16_t, WS_WT + WT_KVB)
#define XB WSP(bf16_t, WS_HN)
#define RSTAT WSP(float, WS_SEL)
#define L1G WSP(float, WS_SEL + 128 * 1024)
#define L2G WSP(float, WS_SEL + 192 * 1024)
#define ACT WSP(bf16_t, WS_RA)
#define Zb WSP(bf16_t, WS_RA)
#define Y WSP(bf16_t, WS_RB)
#define MQ WSP(bf16_t, WS_RB)
#define MKV WSP(bf16_t, WS_RB + 48 * MiB)
#define QN WSP(bf16_t, WS_RCC)
#define KVN WSP(bf16_t, WS_RCC + 24 * MiB)
#define OA WSP(bf16_t, WS_RCC)
#define OB WSP(bf16_t, WS_RCC + 32 * MiB)
#define OC WSP(bf16_t, WS_RCC + 64 * MiB)
#define YCAT WSP(bf16_t, WS_YCAT)
#define MERGED WSP(bf16_t, WS_RB + 20 * MiB)
#define MOUT WSP(bf16_t, WS_RCC)
#define g_f1pre INP(2, l * DM)
#define w_gu1 INP(3, (size_t)l * DM * 2 * DFF)
#define w_d1 INP(4, (size_t)l * DFF * DM)
#define g_f1post INP(5, l * DM)
#define g_mpre INP(6, l * DM)
#define w_in INP(7, (size_t)l * DM * 5816)
#define pe_k INP(8, l * 2048)
#define w1_k INP(9, (size_t)l * 2048 * 128)
#define w2_k INP(10, l * 128 * 64)
#define pe_v INP(11, l * 2048)
#define w1_v INP(12, (size_t)l * 2048 * 128)
#define w2_v INP(13, l * 128 * 64)
#define sinks INP(14, l * 8)
#define g_q INP(15, l * 384)
#define w_qb INP(16, (size_t)l * 384 * 768)
#define g_kv INP(17, l * 256)
#define w_kvb INP(18, (size_t)l * 256 * 1024)
#define w_br INP(19, (size_t)l * 3 * 512 * 1024)
#define w_out INP(20, (size_t)l * DM * DM)
#define g_mpost INP(21, l * DM)
#define g_f2pre INP(22, l * DM)
#define w_gu2 INP(23, (size_t)l * DM * 2 * DFF)
#define w_d2 INP(24, (size_t)l * DFF * DM)
#define g_f2post INP(25, l * DM)
#define PW_BODY() do { int rot = 0; \
          U_TR(tr_matrix(w_gu1, DM, 2 * DFF, Wgu1, 2 * DFF, 1, 0, 0, g_f1pre, scr, lane, gw, NGW, rot)); \
          U_TR(tr_matrix(w_d1, DFF, DM, Wd1, DM, 0, 0, DM, nullptr, scr, lane, gw, NGW, rot)); \
          U_TR(tr_matrix(w_gu2, DM, 2 * DFF, Wgu2, 2 * DFF, 1, 0, 0, g_f2pre, scr, lane, gw, NGW, rot)); \
          U_TR(tr_matrix(w_d2, DFF, DM, Wd2, DM, 0, 0, DM, nullptr, scr, lane, gw, NGW, rot)); \
          U_TR(tr_matrix(w_in, DM, 5816, Wza, ZW, 2, 0, 0, g_mpre, scr, lane, gw, NGW, rot)); \
          U_TR(tr_matrix(w_in, DM, 5816, Wg, 3072, 0, 2744, 3072, g_mpre, scr, lane, gw, NGW, rot)); \
          for (int n = 0; n < 3; ++n) U_TR(tr_matrix(w_br + (size_t)n * 512 * 1024, 512, 1024, Wb + (size_t)n * 1024 * 512, 1024, 0, 0, 1024, nullptr, scr, lane, gw, NGW, rot)); \
          U_TR(tr_matrix(w_out, DM, DM, Wout, DM, 0, 0, DM, nullptr, scr, lane, gw, NGW, rot)); \
          U_TR(tr_matrix(w_qb, 384, 768, Wqb, 768, 0, 0, 768, nullptr, scr, lane, gw, NGW, rot)); \
          U_TR(tr_matrix(w_kvb, 256, 1024, Wkvb, 1024, 0, 0, 1024, nullptr, scr, lane, gw, NGW, rot)); \
          for (int i = gw * 64 + lane; i < 2 * 128 * 4 * 64; i += NGW * 64) { const int which_ = i >> 15, r_ = i & 32767, ks_ = r_ >> 8, nt_ = (r_ >> 6) & 3, ln_ = r_ & 63; \
              const float* w1_ = which_ ? w1_v : w1_k; const int n_ = 32 * nt_ + (ln_ & 31), kb_ = 16 * ks_ + 8 * (ln_ >> 5); u32x4_t o_; \
              o_.x = (unsigned)f2bf(w1_[(kb_ + 0) * 128 + n_]) | ((unsigned)f2bf(w1_[(kb_ + 1) * 128 + n_]) << 16); o_.y = (unsigned)f2bf(w1_[(kb_ + 2) * 128 + n_]) | ((unsigned)f2bf(w1_[(kb_ + 3) * 128 + n_]) << 16); \
              o_.z = (unsigned)f2bf(w1_[(kb_ + 4) * 128 + n_]) | ((unsigned)f2bf(w1_[(kb_ + 5) * 128 + n_]) << 16); o_.w = (unsigned)f2bf(w1_[(kb_ + 6) * 128 + n_]) | ((unsigned)f2bf(w1_[(kb_ + 7) * 128 + n_]) << 16); \
              ((u32x4_t*)W1T)[i] = o_; } \
          U_TR(tr_matrix(w2_k, 128, 64, W2T, 64, 0, 0, 64, nullptr, scr, lane, gw, NGW, rot)); \
          U_TR(tr_matrix(w2_v, 128, 64, W2T + 64 * 128, 64, 0, 0, 64, nullptr, scr, lane, gw, NGW, rot)); \
          for (int it = wave * G + (int)blockIdx.x; it < 256; it += NGW) cpe_item((it >> 7) ? pe_v : pe_k, (it >> 7) ? w1_v : w1_k, CPE + (it >> 7) * 128, it & 127, lane); } while (0)
    { const int l = 0; PW_BODY();

              for (int i = gw * 64 + lane; i < 16 * 4096; i += NGW * 64) { const int h = i >> 12, d = i & 4095; BD[i] = INP(1, 0)[t5_bucket(d) * 16 + h];
                  const int pos = i >> 4, j = i & 15; const float inv_freq = powf(10000.0f, -(float)j / 16.0f); const float ang = (float)pos * inv_freq; RC[i] = cosf(ang); RS[i] = sinf(ang); }
              for (int i = gw * 64 + lane; i < 4 * 4096; i += NGW * 64) { const int h = i >> 10, d = i & 1023; L1G[i] = INP(1, 0)[t5_bucket(d) * 16 + h] * 1.4426950408889634f; }
              for (int i = gw * 64 + lane; i < 2 * 8 * 1028; i += NGW * 64) { const int hk = i / (8 * 1028), r1 = i - hk * (8 * 1028), hg = r1 / (2 * 1028), r2 = r1 - hg * (2 * 1028), k = r2 >= 1028 ? 1 : 0, idx = r2 - k * 1028, dist = 959 - (idx + k);
                  L2G[i] = dist >= 0 ? INP(1, 0)[t5_bucket(dist) * 16 + hk * 4 + hg] * 1.4426950408889634f : 0.f; }
              for (int row = gw; row < MTOK; row += NGW) xinit_row(INP(0, 0), XB, RSTAT, row, lane);
              }
    GRID_BAR();
    for (int l = 0; l < DEPTH; ++l) {
        for (int rep_ = 0; rep_ < 1 + REP_FFN; ++rep_) { GEMM_PHASE(pg8::EpiSwiGLU, XB, DM, Wgu1, 2 * DFF, DM, ACT, DFF, nullptr); }
        GRID_BAR();
        for (int rep_ = 0; rep_ < 1 + REP_FFN; ++rep_) { GEMM_PHASE(pg8::EpiStore, ACT, DFF, Wd1, DM, DFF, Y, DM, nullptr); }
        GRID_BAR();
        if (l == 0) { for (int row = gw; row < MTOK; row += 2 * NGW) resid_row2<true>(Y, g_f1post, 0.5f, INP(0, 0), nullptr, XB, RSTAT, nullptr, row, row + NGW, lane); }
        else { for (int row = gw; row < MTOK; row += 2 * NGW) resid_row2<false>(Y, g_f1post, 0.5f, nullptr, XB, XB, RSTAT, nullptr, row, row + NGW, lane); }
        GRID_BAR();
        for (int rep_ = 0; rep_ < 1 + REP_Z; ++rep_) { GEMM_PHASE(pg8::EpiStore, XB, DM, Wza, 2048, DM, Zb, ZW, nullptr); }
        GRID_BAR();
        for (int rep5_ = 0; rep5_ < 1 + REP_P5; ++rep5_) {
        for (int row = gw; row < MTOK; row += 4 * NGW) mla_prep_rows4(Zb, g_q, g_kv, RC, RS, QN, KVN, KR, row, NGW, lane);
for (int it = (int)blockIdx.x; it < 2 * BATCH * 2 * 8; it += G) { const int which = it >> 7, r = it & 127, b = r >> 4, hkv = (r >> 3) & 1, ct = r & 7;
            compress_wg_unit((LAS unsigned char*)lds, Zb, W1T + (size_t)which * 128 * 2048, W2T + which * 64 * 128, CPE + which * 128, which ? VCb : KCb, b, hkv, (which ? Z_VC : Z_KC) + hkv * 64, ct, wave, lane); }
        }
        GRID_BAR();
        for (int rep_ = 0; rep_ < 1 + REP_G; ++rep_) { GEMM_PHASE(pg8::EpiStore, XB, DM, Wza + (size_t)2048 * DM, 768, DM, Zb + 2048, ZW, nullptr); }
        if ((int)blockIdx.x >= 128) { pg8::Gemm g_; g_.A = QN; g_.Bt = Wqb; g_.M = MTOK; g_.N = 768; g_.K = 384; g_.lda = 384;
            pg8::StaticOrder S_; S_.init(MTOK, 768, 128, (int)blockIdx.x - 128); pg8::EpiStore e_; e_.O = MQ; e_.ldc = 768; e_.rs = nullptr;
            pg8::gemm_phase<pg8::EpiStore, pg8::StaticOrder, true, true>((PG8_LAS unsigned char*)lds, g_, S_, e_, wave); }
        for (int rep_ = 0; rep_ < 1 + REP_G; ++rep_) { GEMM_PHASE(pg8::EpiStore, KVN, 256, Wkvb, 1024, 256, MKV, 1024, nullptr); }
        GRID_BAR();
        __syncthreads();
        if (wave >= 4) __builtin_amdgcn_s_setprio(1);
        int swa_lut_ = -1;
        for (int kind_ = 0; kind_ < 3; ++kind_) {
            gu32_t* qw = (gu32_t*)((unsigned*)(ws_opaque(p) + WS_CTL) + CW_QUEUE + 64 * (3 * l + kind_));
            volatile LAS unsigned* qs = (volatile LAS unsigned*)((LAS unsigned char*)lds + MISC_OFF) + 16;
            for (;;) {
                if (wave == 0 && lane == 0) qs[0] = __hip_atomic_fetch_add(qw, 1u, __ATOMIC_RELAXED, __HIP_MEMORY_SCOPE_AGENT);
                __syncthreads();
                const int u = __builtin_amdgcn_readfirstlane((int)qs[0]);
                __syncthreads();
                if (u >= 1024) break;
                if (kind_ == 0) { const int qc = 15 - (u >> 6), r = u & 63; mla_wg_unit((LAS unsigned char*)lds, MQ, MKV, KR, RC, RS, OC, r >> 3, r & 7, qc, wave, lane); }
                else if (kind_ == 1) { const int ch = 63 - (u >> 4), r = u & 15; nsa_fused_unit((LAS unsigned char*)lds, Zb, L1G, L2G, KCb, VCb, OA, r >> 1, r & 1, ch, wave, lane); }
                else { const int hkv_ = u >> 9, ch = 63 - ((u & 511) >> 3), b_ = u & 7;
                       if (hkv_ != swa_lut_) { fill_lut((LAS unsigned char*)lds, L1G, 8 + hkv_ * 4, wave * 64 + lane); swa_lut_ = hkv_; }
                       swa_wg_unit((LAS unsigned char*)lds, Zb, BD, sinks, OB, b_, hkv_, ch, wave, lane); }
            }
        }
        __builtin_amdgcn_s_setprio(0);
        GRID_BAR();
        for (int rep_ = 0; rep_ < 1 + REP_G; ++rep_) { GEMM_PHASE(pg8::EpiSigmoid, XB, DM, Wg, 3072, DM, YCAT, 3072, nullptr); }
        GRID_BAR();
        { pg8::Gemm g_; g_.A = OA; g_.Bt = Wb; g_.M = 3 * MTOK; g_.N = 3072; g_.K = 512; g_.lda = 512;
          pg8::GateOrder S_; S_.init(MTOK, G, (int)blockIdx.x); pg8::EpiGateChain e_; e_.O = MERGED; e_.ldc = DM; e_.Gp = YCAT; e_.ldg = 3072;
          pg8::gemm_phase<pg8::EpiGateChain, pg8::GateOrder, true, true, true>((PG8_LAS unsigned char*)lds, g_, S_, e_, wave); }
        GRID_BAR();
        for (int rep_ = 0; rep_ < 1 + REP_G; ++rep_) { GEMM_PHASE(pg8::EpiStore, MERGED, DM, Wout, DM, DM, MOUT, DM, nullptr); }
        GRID_BAR();
        for (int row = gw; row < MTOK; row += 2 * NGW) resid_row2<false>(MOUT, g_mpost, 1.0f, nullptr, XB, XB, RSTAT, nullptr, row, row + NGW, lane);
        GRID_BAR();
        for (int rep_ = 0; rep_ < 1 + REP_FFN; ++rep_) { GEMM_PHASE(pg8::EpiSwiGLU, XB, DM, Wgu2, 2 * DFF, DM, ACT, DFF, nullptr); }
        GRID_BAR();
        for (int rep_ = 0; rep_ < 1 + REP_FFN; ++rep_) { GEMM_PHASE(pg8::EpiStore, ACT, DFF, Wd2, DM, DFF, Y, DM, nullptr); }
        GRID_BAR();
        for (int row = gw; row < MTOK; row += 2 * NGW) resid_row2<false>(Y, g_f2post, 0.5f, nullptr, XB, XB, RSTAT, l + 1 < DEPTH ? nullptr : (float*)xo, row, row + NGW, lane);
        if (l + 1 < DEPTH) { const int ln_ = l + 1; { const int l = ln_; PW_BODY(); } }
        GRID_BAR();
    }
}

extern "C" void kernel_launch(void* const* d_in, const int* in_sizes, int n_in, void* d_out, int out_size, void* d_ws, size_t ws_size, hipStream_t stream) {
    static int grid = 0;
    if (grid == 0) {
        if (n_in != 26 || out_size != MTOK * DM || ws_size < WS_END) { fprintf(stderr, "kernel_launch: unexpected shapes (n_in %d out %d ws %zu)\n", n_in, out_size, ws_size); grid = -1; return; }
        int dev = 0, cus = 0, per_cu = 0;
        if (hipGetDevice(&dev) != hipSuccess || hipDeviceGetAttribute(&cus, hipDeviceAttributeMultiprocessorCount, dev) != hipSuccess) { grid = -1; return; }
        if (hipFuncSetAttribute((const void*)mega_fwd, hipFuncAttributeMaxDynamicSharedMemorySize, LDS_BYTES) != hipSuccess) { grid = -1; return; }
        if (hipOccupancyMaxActiveBlocksPerMultiprocessor(&per_cu, (const void*)mega_fwd, NWAVES * 64, LDS_BYTES) != hipSuccess || per_cu < 1) fprintf(stderr, "kernel_launch: occupancy query says %d\n", per_cu);
        (void)hipGetLastError();
        grid = cus;
    }
    if (grid < 0) return;
    if (hipMemsetAsync((char*)d_ws + WS_CTL, 0, CTL_ZERO_BYTES, stream) != hipSuccess) return;
    Params p{};
    for (int i = 0; i < 26; ++i) p.in[i] = (const float*)d_in[i];
    p.out = (float*)d_out; p.ws = (unsigned char*)d_ws;
    hipLaunchKernelGGL(mega_fwd, dim3(grid), dim3(NWAVES * 64), LDS_BYTES, stream, p);
}
```

```cpp
#include <hip/hip_runtime.h>
#include <cstdio>
#include <cstdint>
namespace pg8 {
#define PG8_LAS __attribute__((address_space(3)))
typedef unsigned short bf16_t;
typedef short bf16x8 __attribute__((ext_vector_type(8)));
typedef float f32x4 __attribute__((ext_vector_type(4)));
typedef unsigned u32x4 __attribute__((ext_vector_type(4)));
constexpr int BM = 256, BK = 64, HALF = 128, HTB = HALF * BK * 2  , STAGE_BYTES = 8 * HTB, NXCD = 8, WGM = 8;

__host__ __device__ __forceinline__ int lds_byte(int r, int c) { const int st = (r >> 4) * 2 + (c >> 5), rr = r & 15, cc = c & 31, ob = rr * 64 + cc * 2; return st * 1024 + (ob ^ (((ob >> 9) & 1) << 5)); }
__host__ __device__ __forceinline__ void stage_rc(int b, int& R, int& C) { const int st = b / 1024, sb = b % 1024, swz = sb ^ (((sb >> 9) & 1) << 5); R = (st >> 1) * 16 + swz / 64; C = (st & 1) * 32 + (swz % 64) / 2; }
__host__ __device__ __forceinline__ int perm32(int rho) { const int n = rho >> 4, i = rho & 15; return 8 * (i >> 2) + 4 * n + (i & 3); }

struct Unit { int pm, pn; };
struct Gemm { const bf16_t* A; const bf16_t* Bt; int M, N, K, lda; };

struct StaticOrder {
    int nM, nN, nwg, G, c;
    __host__ __device__ void init(int M, int N, int G_, int c_) { nM = M / BM; nN = N / BM; nwg = nM * nN; G = G_; c = c_; }
    __host__ __device__ bool next(int i, Unit& u) const {
        const long L = (long)i * G + c; if (L >= nwg) return false;
        int wgid = (int)L; { const int q = nwg / NXCD, r = nwg % NXCD, xcd = wgid % NXCD, off = wgid / NXCD; wgid = (xcd < r ? xcd * (q + 1) : r * (q + 1) + (xcd - r) * q) + off; }
        const int nig = WGM * nN, gid = wgid / nig, fm = gid * WGM, gsz = (nM - fm) < WGM ? (nM - fm) : WGM;
        u.pm = fm + ((wgid % nig) % gsz); u.pn = (wgid % nig) / gsz; return true;
    }
    __device__ __forceinline__ void a_ready(const Unit&) const {}
    __device__ __forceinline__ void done(const Unit&) const {}
};

typedef float f32x2c_t __attribute__((ext_vector_type(2))); typedef __bf16 bf16x2c_t __attribute__((ext_vector_type(2)));
__device__ __forceinline__ unsigned cvt_pk_bf16(float lo, float hi) { f32x2c_t v = {lo, hi}; bf16x2c_t b = __builtin_convertvector(v, bf16x2c_t); return __builtin_bit_cast(unsigned, b); }
typedef float f32x2 __attribute__((ext_vector_type(2)));
__device__ __forceinline__ f32x2 gelu_pk(f32x2 v) {
    const f32x2 av = __builtin_elementwise_abs(v), d = av * 0.2316418882f + 1.0f;
    f32x2 t; t.x = __builtin_amdgcn_rcpf(d.x); t.y = __builtin_amdgcn_rcpf(d.y);
    f32x2 q = t * 0.5307027145f + (-0.7265760135f); q = q * t + 0.7107068705f; q = q * t + (-0.142248368f); q = q * t + 0.127414796f; q = q * t;
    const f32x2 s = (v * v) * (-0.72134752044f);
    f32x2 e; e.x = __builtin_amdgcn_exp2f(s.x); e.y = __builtin_amdgcn_exp2f(s.y);
    const f32x2 m = v * (q * e), r = v - m;
    f32x2 o; o.x = v.x < 0.f ? m.x : r.x; o.y = v.y < 0.f ? m.y : r.y; return o;
}

template <int ACT  > struct EpiBf16 {
    static constexpr bool PERM = true, AFTER_DRAIN = false; static_assert(ACT == 0 || ACT == 1, "EpiBf16: ACT is 0 (none) or 1 (gelu_pk)");
    bf16_t* O; int ldc; const float* bias; int split_cols; size_t split_stride; float scale0;
    __device__ __forceinline__ void operator()(const f32x4 (&acc)[2][2][4][2], const Unit& u, int wr, int wc, int fr, int fq) const {
        const int row0 = u.pm * BM + wr * 64 + fr; int colt = u.pn * BM; bf16_t* base = O;
        float sc = 1.f; if (split_cols) { const int t = colt / split_cols; base += (size_t)t * split_stride; colt -= t * split_cols; if (t == 0) sc = scale0; }
        const int col0 = colt + wc * 32 + 8 * fq, bcol0 = u.pn * BM + wc * 32 + 8 * fq;
        f32x4 bv[2][2];
#pragma unroll
        for (int bj = 0; bj < 2; ++bj)
#pragma unroll
            for (int n = 0; n < 2; ++n) bv[bj][n] = bias ? *(const f32x4*)(bias + bcol0 + bj * HALF + 4 * n) : (f32x4){0.f, 0.f, 0.f, 0.f};
#pragma unroll
        for (int ai = 0; ai < 2; ++ai)
#pragma unroll
            for (int m = 0; m < 4; ++m) { bf16_t* rowp = base + (size_t)(row0 + ai * HALF + m * 16) * ldc + col0;
#pragma unroll
                for (int bj = 0; bj < 2; ++bj) { f32x4 v0 = acc[ai][bj][m][0] + bv[bj][0], v1 = acc[ai][bj][m][1] + bv[bj][1];
                    if (ACT == 1) { f32x2 a = gelu_pk((f32x2){v0[0], v0[1]}), b = gelu_pk((f32x2){v0[2], v0[3]}), c = gelu_pk((f32x2){v1[0], v1[1]}), d = gelu_pk((f32x2){v1[2], v1[3]});
                        v0 = (f32x4){a.x, a.y, b.x, b.y}; v1 = (f32x4){c.x, c.y, d.x, d.y}; }
                    v0 = v0 * sc; v1 = v1 * sc; u32x4 w; w.x = cvt_pk_bf16(v0[0], v0[1]); w.y = cvt_pk_bf16(v0[2], v0[3]); w.z = cvt_pk_bf16(v1[0], v1[1]); w.w = cvt_pk_bf16(v1[2], v1[3]);
                    *(u32x4*)(rowp + bj * HALF) = w; } }
    }
};

struct PanelStats {
    unsigned* xbuf;
    unsigned* cnt;
    unsigned* tmo;
    int ntn; float eps;
    unsigned code;
    __device__ __forceinline__ bool run(const f32x4 (&v)[2][2][4][2], const Unit& u, int wr, int wc, int fr, int fq, PG8_LAS unsigned char* lds, int wid, int lane) const {
        typedef float f32x2v __attribute__((ext_vector_type(2)));
        PG8_LAS f32x2v* P = (PG8_LAS f32x2v*)lds;
        PG8_LAS f32x2v* S = (PG8_LAS f32x2v*)(lds + 8192);
        PG8_LAS unsigned* flag = (PG8_LAS unsigned*)(lds + 8192 + 2048);
#pragma unroll
        for (int ai = 0; ai < 2; ++ai)
#pragma unroll
            for (int m = 0; m < 4; ++m) {
                float s = 0.f;
#pragma unroll
                for (int bj = 0; bj < 2; ++bj)
#pragma unroll
                    for (int n = 0; n < 2; ++n) { const f32x4 x = v[ai][bj][m][n]; s += (x[0] + x[1]) + (x[2] + x[3]); }
                s += __shfl_xor(s, 16); s += __shfl_xor(s, 32);
                const float mw = s * (1.0f / 64.0f); float q = 0.f;
#pragma unroll
                for (int bj = 0; bj < 2; ++bj)
#pragma unroll
                    for (int n = 0; n < 2; ++n) { const f32x4 d = v[ai][bj][m][n] - mw; q += (d[0] * d[0] + d[1] * d[1]) + (d[2] * d[2] + d[3] * d[3]); }
                q += __shfl_xor(q, 16); q += __shfl_xor(q, 32);
                if (fq == 0) P[(ai * HALF + wr * 64 + m * 16 + fr) * 4 + wc] = (f32x2v){mw, q};
            }
        asm volatile("s_waitcnt lgkmcnt(0)" ::: "memory"); __builtin_amdgcn_s_barrier(); asm volatile("" ::: "memory");
#if defined(BROKEN_EXCHANGE_NO_WAIT)
#warning BROKEN CONTROL BUILD: the row-statistics exchange does not wait; results are wrong by design
        if (blockIdx.x >= 64) { const long long t0_ = clock64(); while (clock64() - t0_ < 60000) __builtin_amdgcn_s_sleep(8); }
#endif
        const int row = wid * 32 + (lane & 31);
        if (lane < 32) {
            const f32x2v a = P[row * 4 + 0], b = P[row * 4 + 1], c = P[row * 4 + 2], d = P[row * 4 + 3];
            const float mt = (a.x + b.x + c.x + d.x) * 0.25f;
            const float da = a.x - mt, db = b.x - mt, dc = c.x - mt, dd = d.x - mt;
            const float m2 = (a.y + b.y) + (c.y + d.y) + 64.0f * ((da * da + db * db) + (dc * dc + dd * dd));
            unsigned long long* slot = (unsigned long long*)xbuf + ((size_t)(u.pm * BM + row) * 4 + u.pn);
            __hip_atomic_store(slot, ((unsigned long long)__float_as_uint(m2) << 32) | __float_as_uint(mt), __ATOMIC_RELAXED, __HIP_MEMORY_SCOPE_AGENT);
        }
        asm volatile("s_waitcnt vmcnt(0)" ::: "memory");
        if (lane == 0) __hip_atomic_fetch_add(cnt + 64 * u.pm, 1u, __ATOMIC_RELAXED, __HIP_MEMORY_SCOPE_AGENT);
        if (wid == 0) {
            bool dead = false; const unsigned long long t0 = __builtin_amdgcn_s_memrealtime(); const unsigned want = 8u * (unsigned)ntn;
            for (;;) {
#if defined(BROKEN_EXCHANGE_NO_WAIT)
                break;
#endif
                if ((unsigned)__builtin_amdgcn_readfirstlane(__hip_atomic_load(cnt + 64 * u.pm, __ATOMIC_RELAXED, __HIP_MEMORY_SCOPE_AGENT)) >= want) break;
                if (__builtin_amdgcn_s_memrealtime() - t0 > 2000000ull) {
                    if (lane == 0) { unsigned expect = 0u; __hip_atomic_compare_exchange_strong(tmo + 1, &expect, code | (unsigned)(u.pm & 0xff), __ATOMIC_RELAXED, __ATOMIC_RELAXED, __HIP_MEMORY_SCOPE_AGENT);
                                     __hip_atomic_store(tmo, 1u, __ATOMIC_RELAXED, __HIP_MEMORY_SCOPE_AGENT); }
                    dead = true; break; }
                __builtin_amdgcn_s_sleep(2);
            }
            __builtin_amdgcn_fence(__ATOMIC_ACQUIRE, "agent");
            if (lane == 0) flag[0] = dead ? 1u : 0u;
        }
        asm volatile("s_waitcnt vmcnt(0) lgkmcnt(0)" ::: "memory"); __builtin_amdgcn_s_barrier(); asm volatile("" ::: "memory");
        const bool bad = flag[0] != 0u;
        if (lane < 32) {
            const unsigned long long* slot = (const unsigned long long*)xbuf + (size_t)(u.pm * BM + row) * 4; float mt[4], m2[4]; float ms = 0.f;
#pragma unroll
            for (int t = 0; t < 4; ++t) { if (t < ntn) { const unsigned long long w = __hip_atomic_load(slot + t, __ATOMIC_RELAXED, __HIP_MEMORY_SCOPE_AGENT); mt[t] = __uint_as_float((unsigned)w); m2[t] = __uint_as_float((unsigned)(w >> 32)); } else { mt[t] = 0.f; m2[t] = 0.f; } ms += mt[t]; }
            const float mean = ms / (float)ntn; float q = 0.f;
#pragma unroll
            for (int t = 0; t < 4; ++t) if (t < ntn) { const float dm = mt[t] - mean; q += m2[t] + 256.0f * dm * dm; }
            S[row] = (f32x2v){mean, 1.0f / sqrtf(q / (256.0f * (float)ntn) + eps)};
        }
        asm volatile("s_waitcnt lgkmcnt(0)" ::: "memory"); __builtin_amdgcn_s_barrier(); asm volatile("" ::: "memory");
        return bad;
    }
};
struct EpiLnRes {
    static constexpr bool PERM = false, AFTER_DRAIN = true;
    const float* base; float* out; int ldc; const float* bias; PanelStats st; unsigned poison;
    __device__ __forceinline__ void fused(f32x4 (&acc)[2][2][4][2], const Unit& u, int wr, int wc, int fr, int fq, PG8_LAS unsigned char* lds, int wid, int lane) const {
        typedef float f32x2v __attribute__((ext_vector_type(2)));
        const PG8_LAS f32x2v* S = (const PG8_LAS f32x2v*)(lds + 8192);
        const int col0 = u.pn * BM + wc * 32 + 4 * fq;
#pragma unroll
        for (int bj = 0; bj < 2; ++bj)
#pragma unroll
            for (int n = 0; n < 2; ++n) { const f32x4 bv = bias ? *(const f32x4*)(bias + col0 + bj * HALF + n * 16) : (f32x4){0.f, 0.f, 0.f, 0.f};
#pragma unroll
                for (int ai = 0; ai < 2; ++ai)
#pragma unroll
                    for (int m = 0; m < 4; ++m) acc[ai][bj][m][n] += bv; }
        f32x4 pre[4][2][2];
#pragma unroll
        for (int m = 0; m < 4; ++m) { const size_t off = (size_t)(u.pm * BM + wr * 64 + m * 16 + fr) * ldc + col0;
#pragma unroll
            for (int bj = 0; bj < 2; ++bj)
#pragma unroll
                for (int n = 0; n < 2; ++n) pre[m][bj][n] = *(const f32x4*)(base + off + bj * HALF + n * 16); }
        const bool bad = st.run(acc, u, wr, wc, fr, fq, lds, wid, lane) || poison != 0u;
        const float qnan = __builtin_nanf("");
#pragma unroll
        for (int ai = 0; ai < 2; ++ai)
#pragma unroll
            for (int m = 0; m < 4; ++m) { const int r = ai * HALF + wr * 64 + m * 16 + fr; const f32x2v sr = S[r]; const size_t off = (size_t)(u.pm * BM + r) * ldc + col0;
#pragma unroll
                for (int bj = 0; bj < 2; ++bj)
#pragma unroll
                    for (int n = 0; n < 2; ++n) { const f32x4 bs = ai == 0 ? pre[m][bj][n] : *(const f32x4*)(base + off + bj * HALF + n * 16); f32x4 o = bs + (acc[ai][bj][m][n] - sr.x) * sr.y;
                        if (bad) o = (f32x4){qnan, qnan, qnan, qnan}; *(f32x4*)(out + off + bj * HALF + n * 16) = o; }
                if (m & 1) asm volatile("" ::: "memory"); }
    }
};
struct EpiLnResLn {
    static constexpr bool PERM = false, AFTER_DRAIN = true;
    const float* base; float* out; bf16_t* xn; int ldc; const float* bias; PanelStats st1, st2; unsigned poison;
    __device__ __forceinline__ void fused(f32x4 (&acc)[2][2][4][2], const Unit& u, int wr, int wc, int fr, int fq, PG8_LAS unsigned char* lds, int wid, int lane) const {
        typedef float f32x2v __attribute__((ext_vector_type(2))); typedef unsigned u32x2v __attribute__((ext_vector_type(2)));
        const PG8_LAS f32x2v* S = (const PG8_LAS f32x2v*)(lds + 8192);
        const int col0 = u.pn * BM + wc * 32 + 4 * fq;
#pragma unroll
        for (int bj = 0; bj < 2; ++bj)
#pragma unroll
            for (int n = 0; n < 2; ++n) { const f32x4 bv = bias ? *(const f32x4*)(bias + col0 + bj * HALF + n * 16) : (f32x4){0.f, 0.f, 0.f, 0.f};
#pragma unroll
                for (int ai = 0; ai < 2; ++ai)
#pragma unroll
                    for (int m = 0; m < 4; ++m) acc[ai][bj][m][n] += bv; }
        bool bad = st1.run(acc, u, wr, wc, fr, fq, lds, wid, lane) || poison != 0u;
        const float qnan = __builtin_nanf("");
#pragma unroll
        for (int ai = 0; ai < 2; ++ai)
#pragma unroll
            for (int m = 0; m < 4; ++m) { const int r = ai * HALF + wr * 64 + m * 16 + fr; const f32x2v sr = S[r]; const size_t off = (size_t)(u.pm * BM + r) * ldc + col0;
#pragma unroll
                for (int bj = 0; bj < 2; ++bj)
#pragma unroll
                    for (int n = 0; n < 2; ++n) { const f32x4 bs = *(const f32x4*)(base + off + bj * HALF + n * 16); acc[ai][bj][m][n] = bs + (acc[ai][bj][m][n] - sr.x) * sr.y; }
                asm volatile("" : "+v"(acc[ai][0][m][0]), "+v"(acc[ai][0][m][1]), "+v"(acc[ai][1][m][0]), "+v"(acc[ai][1][m][1]));
                if (m & 1) asm volatile("" ::: "memory"); }
        const bool bad1 = bad;
        bad = st2.run(acc, u, wr, wc, fr, fq, lds, wid, lane) || bad;
#pragma unroll
        for (int ai = 0; ai < 2; ++ai)
#pragma unroll
            for (int m = 0; m < 4; ++m) { const int r = ai * HALF + wr * 64 + m * 16 + fr; const f32x2v sr = S[r]; const size_t off = (size_t)(u.pm * BM + r) * ldc + col0;
#pragma unroll
                for (int bj = 0; bj < 2; ++bj)
#pragma unroll
                    for (int n = 0; n < 2; ++n) { const f32x4 x1 = acc[ai][bj][m][n]; *(f32x4*)(out + off + bj * HALF + n * 16) = bad1 ? (f32x4){qnan, qnan, qnan, qnan} : x1;
                        const f32x4 o = (x1 - sr.x) * sr.y; u32x2v w; w.x = cvt_pk_bf16(o[0], o[1]); w.y = cvt_pk_bf16(o[2], o[3]);
                        if (bad) { w.x = 0x7fc07fc0u; w.y = 0x7fc07fc0u; } *(u32x2v*)(xn + off + bj * HALF + n * 16) = w; }
                asm volatile("" ::: "memory"); }
    }
};

template <class Epi, class Sched, bool ALIGN_EPI = false, bool SP2 = false, bool CHAIN = false, bool I8 = false>
__device__ __forceinline__ void gemm_phase(PG8_LAS unsigned char* lds, const Gemm g, const Sched& S, const Epi& E, int wave_id) {
    int lane_o; asm volatile("v_mbcnt_lo_u32_b32 %0, -1, 0\n\tv_mbcnt_hi_u32_b32 %0, -1, %0" : "=v"(lane_o));
    int tid_o = wave_id * 64 + lane_o;
    const int tid = tid_o, wid = __builtin_amdgcn_readfirstlane(tid >> 6), lane = tid & 63, wr = wid >> 2, wc = wid & 3, fr = lane & 15, fq = lane >> 4;
    int K_o = g.K; if constexpr (I8) asm volatile("" : "+s"(K_o));
    const int K = K_o, nt = K / BK;
    unsigned voffA[2], voffB[2];
#pragma unroll
    for (int i = 0; i < 2; ++i) { int R, C; stage_rc(tid * 16 + i * 8192, R, C); const int Rb = Epi::PERM ? ((R & ~31) + perm32(R & 31)) : R;
        voffA[i] = (unsigned)(R * g.lda + C) * 2u; voffB[i] = (unsigned)(Rb * K + C) * 2u; }
    const size_t kstep = (size_t)(BK * 2);
    const size_t hstep = (size_t)HALF * K * 2;
    const size_t tstep = 2 * hstep; const size_t hstepA = (size_t)HALF * g.lda * 2, tstepA = 2 * hstepA;
    const unsigned ldsw = (unsigned)wid * 1024u;
    const int aoff = lds_byte(wr * 64 + fr, fq * 8), boff = lds_byte(wc * 32 + fr, fq * 8);
#define PG8_SA(b, h) (((b) * 2 + (h)) * HTB)
#define PG8_SB(b, h) ((4 + (b) * 2 + (h)) * HTB)
#define PG8_STAGE(bufoff, gbase, voff) do { _Pragma("unroll") for (int _i = 0; _i < 2; ++_i) \
        __builtin_amdgcn_global_load_lds((const unsigned*)((const char*)(gbase) + (voff)[_i]), (PG8_LAS unsigned*)(lds + (bufoff) + ldsw + _i * 8192), 16, 0, 0); } while (0)
#define PG8_LDA(dst, b, h) do { _Pragma("unroll") for (int m = 0; m < 4; ++m) _Pragma("unroll") for (int k = 0; k < 2; ++k) dst[m][k] = *(const PG8_LAS bf16x8*)(lds + PG8_SA(b, h) + aoff + m * 2048 + k * 1024); } while (0)
#define PG8_LDB(dst, b, h) do { _Pragma("unroll") for (int n = 0; n < 2; ++n) _Pragma("unroll") for (int k = 0; k < 2; ++k) dst[n][k] = *(const PG8_LAS bf16x8*)(lds + PG8_SB(b, h) + boff + n * 2048 + k * 1024); } while (0)
#define PG8_MMA(ai, bj, At, Bt) do { __builtin_amdgcn_s_setprio(1); if constexpr (I8) { typedef int v4i_i8 __attribute__((ext_vector_type(4))); \
        _Pragma("unroll") for (int m = 0; m < 4; ++m) _Pragma("unroll") for (int n = 0; n < 2; ++n) _Pragma("unroll") for (int k = 0; k < 2; ++k) \
        acc[ai][bj][m][n] = __builtin_bit_cast(f32x4, __builtin_amdgcn_mfma_i32_16x16x64_i8(__builtin_bit_cast(v4i_i8, Bt[n][k]), __builtin_bit_cast(v4i_i8, At[m][k]), __builtin_bit_cast(v4i_i8, acc[ai][bj][m][n]), 0, 0, 0)); } \
        else { _Pragma("unroll") for (int m = 0; m < 4; ++m) _Pragma("unroll") for (int n = 0; n < 2; ++n) _Pragma("unroll") for (int k = 0; k < 2; ++k) \
        acc[ai][bj][m][n] = __builtin_amdgcn_mfma_f32_16x16x32_bf16(Bt[n][k], At[m][k], acc[ai][bj][m][n], 0, 0, 0); } __builtin_amdgcn_s_setprio(0); } while (0)
#define PG8_WAIT_V(n) asm volatile("s_waitcnt vmcnt(" #n ")" ::: "memory")
#define PG8_WAIT_L(n) asm volatile("s_waitcnt lgkmcnt(" #n ")" ::: "memory")
#define PG8_BAR __builtin_amdgcn_s_barrier()
#define PG8_SCHED __builtin_amdgcn_sched_barrier(0)
    Unit cur, nxt; int ui = 0;
    if (!S.next(0, cur)) return;
    f32x4 acc[2][2][4][2];
#pragma unroll
    for (int a = 0; a < 2; ++a)
#pragma unroll
        for (int b = 0; b < 2; ++b)
#pragma unroll
            for (int m = 0; m < 4; ++m)
#pragma unroll
                for (int n = 0; n < 2; ++n) acc[a][b][m][n] = (f32x4){0.f, 0.f, 0.f, 0.f};
    bf16x8 At[4][2], B0[2][2], B1[2][2];
    const char* cA = (const char*)g.A + (size_t)cur.pm * tstepA; const char* cB = (const char*)g.Bt + (size_t)cur.pn * tstep;
    S.a_ready(cur);
    if constexpr (SP2) {
        PG8_STAGE(PG8_SB(0, 0), cB, voffB); PG8_STAGE(PG8_SB(0, 1), cB + hstep, voffB); PG8_STAGE(PG8_SA(0, 0), cA, voffA); PG8_STAGE(PG8_SA(0, 1), cA + hstepA, voffA);
        if (wr == 1) PG8_BAR;
        PG8_WAIT_V(2); PG8_BAR;
        PG8_STAGE(PG8_SB(1, 0), cB + kstep, voffB); PG8_STAGE(PG8_SA(1, 0), cA + kstep, voffA); PG8_STAGE(PG8_SB(1, 1), cB + hstep + kstep, voffB);
        PG8_WAIT_V(6); PG8_BAR;
    } else {
        PG8_STAGE(PG8_SB(0, 0), cB, voffB); PG8_STAGE(PG8_SA(0, 0), cA, voffA); PG8_STAGE(PG8_SB(0, 1), cB + hstep, voffB); PG8_STAGE(PG8_SA(0, 1), cA + hstepA, voffA);
        if (wr == 1) PG8_BAR;
        PG8_WAIT_V(4); PG8_BAR;
        PG8_STAGE(PG8_SB(1, 0), cB + kstep, voffB); PG8_STAGE(PG8_SA(1, 0), cA + kstep, voffA); PG8_STAGE(PG8_SB(1, 1), cB + hstep + kstep, voffB);
        PG8_WAIT_V(6); PG8_BAR;
    }
    for (;;) {
        const bool has_next = S.next(ui + 1, nxt);
        const char* nA = has_next ? (const char*)g.A + (size_t)nxt.pm * tstepA : cA; const char* nB = has_next ? (const char*)g.Bt + (size_t)nxt.pn * tstep : cB;
        for (int t = 0; t < nt; t += 2) {
            const bool last = (t == nt - 2);
            const char* a1 = cA + (size_t)(t + 1) * kstep;
            const char* a2 = last ? nA : cA + (size_t)(t + 2) * kstep; const char* b2 = last ? nB : cB + (size_t)(t + 2) * kstep;
            const char* a3 = a2 + kstep; const char* b3 = b2 + kstep;
            if (last && has_next) S.a_ready(nxt);
            if constexpr (SP2) {
            PG8_LDB(B0, 0, 0); PG8_LDB(B1, 0, 1); PG8_SCHED; PG8_LDA(At, 0, 0); PG8_STAGE(PG8_SA(1, 1), a1 + hstepA, voffA);
            PG8_WAIT_V(8); PG8_WAIT_L(0); PG8_BAR; PG8_MMA(0, 0, At, B0); PG8_MMA(0, 1, At, B1); PG8_BAR; PG8_SCHED;
            PG8_LDA(At, 0, 1); PG8_STAGE(PG8_SB(0, 0), b2, voffB); PG8_STAGE(PG8_SB(0, 1), b2 + hstep, voffB); PG8_STAGE(PG8_SA(0, 0), a2, voffA);
            PG8_WAIT_V(8); PG8_WAIT_L(0); PG8_BAR; PG8_MMA(1, 0, At, B0); PG8_MMA(1, 1, At, B1); PG8_BAR; PG8_SCHED;
            PG8_LDB(B0, 1, 0); PG8_LDB(B1, 1, 1); PG8_SCHED; PG8_LDA(At, 1, 0); PG8_STAGE(PG8_SA(0, 1), a2 + hstepA, voffA);
            PG8_WAIT_V(8); PG8_WAIT_L(0); PG8_BAR; PG8_MMA(0, 0, At, B0); PG8_MMA(0, 1, At, B1); PG8_BAR; PG8_SCHED;
            PG8_LDA(At, 1, 1); PG8_STAGE(PG8_SB(1, 0), b3, voffB); PG8_STAGE(PG8_SB(1, 1), b3 + hstep, voffB); PG8_STAGE(PG8_SA(1, 0), a3, voffA);
            PG8_WAIT_V(8); PG8_WAIT_L(0); PG8_BAR; PG8_MMA(1, 0, At, B0); PG8_MMA(1, 1, At, B1); PG8_BAR; PG8_SCHED;
            } else {
            PG8_LDB(B0, 0, 0); PG8_SCHED; PG8_LDA(At, 0, 0); PG8_STAGE(PG8_SA(1, 1), a1 + hstepA, voffA);
            PG8_WAIT_L(8); PG8_BAR; PG8_WAIT_L(0); PG8_MMA(0, 0, At, B0); PG8_BAR; PG8_SCHED;
            PG8_LDB(B1, 0, 1); PG8_STAGE(PG8_SB(0, 0), b2, voffB);
            PG8_BAR; PG8_WAIT_L(0); PG8_MMA(0, 1, At, B1); PG8_BAR;
            PG8_LDA(At, 0, 1); PG8_STAGE(PG8_SA(0, 0), a2, voffA);
            PG8_BAR; PG8_WAIT_L(0); PG8_MMA(1, 0, At, B0); PG8_BAR; PG8_SCHED;
            PG8_STAGE(PG8_SB(0, 1), b2 + hstep, voffB);
            PG8_WAIT_V(6); PG8_BAR; PG8_MMA(1, 1, At, B1); PG8_BAR;
            PG8_LDB(B0, 1, 0); PG8_SCHED; PG8_LDA(At, 1, 0); PG8_STAGE(PG8_SA(0, 1), a2 + hstepA, voffA);
            PG8_WAIT_L(8); PG8_BAR; PG8_WAIT_L(0); PG8_MMA(0, 0, At, B0); PG8_BAR; PG8_SCHED;
            PG8_LDB(B1, 1, 1); PG8_STAGE(PG8_SB(1, 0), b3, voffB);
            PG8_BAR; PG8_WAIT_L(0); PG8_MMA(0, 1, At, B1); PG8_BAR;
            PG8_LDA(At, 1, 1); PG8_STAGE(PG8_SA(1, 0), a3, voffA);
            PG8_BAR; PG8_WAIT_L(0); PG8_MMA(1, 0, At, B0); PG8_BAR; PG8_SCHED;
            PG8_STAGE(PG8_SB(1, 1), b3 + hstep, voffB);
            PG8_WAIT_V(6); PG8_BAR; PG8_MMA(1, 1, At, B1); PG8_BAR;
            }
        }
        if constexpr (ALIGN_EPI) { if (wr == 0) PG8_BAR; }
        bool keep_ = false;
        if constexpr (!Epi::AFTER_DRAIN) { if constexpr (CHAIN) keep_ = E.chain(acc, cur, wr, wc, fr, fq); else E(acc, cur, wr, wc, fr, fq); S.done(cur); }
        if (!has_next) break;
        if (!keep_) {
#pragma unroll
        for (int a = 0; a < 2; ++a)
#pragma unroll
            for (int b = 0; b < 2; ++b)
#pragma unroll
                for (int m = 0; m < 4; ++m)
#pragma unroll
                    for (int n = 0; n < 2; ++n) acc[a][b][m][n] = (f32x4){0.f, 0.f, 0.f, 0.f};
        }
        cur = nxt; cA = nA; cB = nB; ++ui;
        if constexpr (ALIGN_EPI) { if (wr == 1) PG8_BAR; }
    }
    PG8_WAIT_V(0);
    if constexpr (!ALIGN_EPI) { if (wr == 0) PG8_BAR; }
    PG8_BAR;
    if constexpr (Epi::AFTER_DRAIN) { E.fused(acc, cur, wr, wc, fr, fq, lds, wid, lane); S.done(cur); }
#undef PG8_SA
#undef PG8_SB
#undef PG8_STAGE
#undef PG8_LDA
#undef PG8_LDB
#undef PG8_MMA
#undef PG8_WAIT_V
#undef PG8_WAIT_L
#undef PG8_BAR
#undef PG8_SCHED
}
}

constexpr int BATCH = 8, SEQ = 4096, DM = 1024, DEPTH = 4, DFF = 2816, MTOK = BATCH * SEQ;
constexpr int ZW = 2816;
constexpr int Z_NQ = 0, Z_KC = 512, Z_VC = 640, Z_KS = 768, Z_VS = 896, Z_KW = 1024, Z_VW = 1152, Z_SQ = 1280, Z_SK = 1792, Z_SV = 1920,
              Z_MQ = 2048, Z_MKV = 2432, Z_MKR = 2688, Z_GATE = 2720;
constexpr int NCMP = 255;
constexpr float NORM_EPS = 1e-6f;
typedef unsigned short bf16_t;
typedef unsigned u32x4_t __attribute__((ext_vector_type(4)));

__device__ __forceinline__ float bf2f(bf16_t v) { return __uint_as_float(((unsigned)v) << 16); }
__device__ __forceinline__ float bflo(unsigned w) { return __uint_as_float(w << 16); }
__device__ __forceinline__ float bfhi(unsigned w) { return __uint_as_float(w & 0xffff0000u); }
__device__ __forceinline__ bf16_t f2bf(float f) { unsigned u = __float_as_uint(f); return (bf16_t)((u + 0x7fffu + ((u >> 16) & 1u)) >> 16); }
__device__ __forceinline__ float wave_sum(float v) {
#pragma unroll
    for (int o = 1; o < 64; o <<= 1) v += __shfl_xor(v, o);
    return v;
}
__device__ __forceinline__ int t5_bucket(int d) {
    if (d < 16) return d < 0 ? 0 : d;
    int b = 16;
    b += (d >= 21); b += (d >= 27); b += (d >= 35); b += (d >= 46); b += (d >= 59); b += (d >= 77); b += (d >= 99); b += (d >= 128);
    b += (d >= 166); b += (d >= 216); b += (d >= 280); b += (d >= 363); b += (d >= 470); b += (d >= 609); b += (d >= 790);
    return b;
}

namespace pg8 {
struct EpiStore {
    static constexpr bool PERM = true, AFTER_DRAIN = false;
    bf16_t* O; long ldc; const float* rs;
    __device__ __forceinline__ void operator()(const f32x4 (&acc)[2][2][4][2], const Unit& u, int wr, int wc, int fr, int fq) const {
        const int row0 = u.pm * BM + wr * 64 + fr, col0 = u.pn * BM + wc * 32 + 8 * fq;
#pragma unroll
        for (int ai = 0; ai < 2; ++ai)
#pragma unroll
            for (int m = 0; m < 4; ++m) { bf16_t* rowp = O + (size_t)(row0 + ai * HALF + m * 16) * ldc + col0; const float sc = rs ? rs[row0 + ai * HALF + m * 16] : 1.0f;
#pragma unroll
                for (int bj = 0; bj < 2; ++bj) { const f32x4 v0 = acc[ai][bj][m][0] * sc, v1 = acc[ai][bj][m][1] * sc;
                    u32x4 w; w.x = cvt_pk_bf16(v0[0], v0[1]); w.y = cvt_pk_bf16(v0[2], v0[3]); w.z = cvt_pk_bf16(v1[0], v1[1]); w.w = cvt_pk_bf16(v1[2], v1[3]);
                    *(u32x4*)(rowp + bj * HALF) = w; } }
    }
};
struct EpiStoreI {
    static constexpr bool PERM = true, AFTER_DRAIN = false;
    bf16_t* O; long ldc; const float* rs; const unsigned* cs;
    __device__ __forceinline__ void operator()(const f32x4 (&acc)[2][2][4][2], const Unit& u, int wr, int wc, int fr, int fq) const {
        typedef int v4i_e __attribute__((ext_vector_type(4))); typedef __attribute__((address_space(1))) const float gfc_e;
        const int row0 = u.pm * BM + wr * 64 + fr, col0 = u.pn * BM + wc * 32 + 8 * fq;
        float scv[2][4];
#pragma unroll
        for (int ai = 0; ai < 2; ++ai)
#pragma unroll
            for (int m = 0; m < 4; ++m) scv[ai][m] = (1.0f / 127.0f) * (rs ? *(gfc_e*)(rs + row0 + ai * HALF + m * 16) : 1.0f);
        typedef __attribute__((address_space(1))) const u32x4 gv4c_e; u32x4 cw[2][2];
#pragma unroll
        for (int bj = 0; bj < 2; ++bj) { cw[bj][0] = *(gv4c_e*)(cs + col0 + bj * HALF); cw[bj][1] = *(gv4c_e*)(cs + col0 + bj * HALF + 4); }
#pragma unroll
        for (int ai = 0; ai < 2; ++ai)
#pragma unroll
            for (int m = 0; m < 4; ++m) { bf16_t* rowp = O + (size_t)(row0 + ai * HALF + m * 16) * ldc + col0; const float ps = scv[ai][m];
#pragma unroll
                for (int bj = 0; bj < 2; ++bj) { const v4i_e i0 = __builtin_bit_cast(v4i_e, acc[ai][bj][m][0]), i1 = __builtin_bit_cast(v4i_e, acc[ai][bj][m][1]);
                    u32x4 w; const u32x4 c0 = cw[bj][0], c1 = cw[bj][1];
#define PG8_CV(I, C) ((float)(I) * ps * __uint_as_float(C))
                    w.x = cvt_pk_bf16(PG8_CV(i0[0], c0.x), PG8_CV(i0[1], c0.y)); w.y = cvt_pk_bf16(PG8_CV(i0[2], c0.z), PG8_CV(i0[3], c0.w)); w.z = cvt_pk_bf16(PG8_CV(i1[0], c1.x), PG8_CV(i1[1], c1.y)); w.w = cvt_pk_bf16(PG8_CV(i1[2], c1.z), PG8_CV(i1[3], c1.w));
#undef PG8_CV
                    *(u32x4*)(rowp + bj * HALF) = w; } }
    }
};
__device__ __forceinline__ float sigm(float x) { return __builtin_amdgcn_rcpf(1.0f + __expf(-x)); }
struct EpiSigmoid {
    static constexpr bool PERM = true, AFTER_DRAIN = false;
    bf16_t* O; long ldc; const float* rs;
    __device__ __forceinline__ void operator()(const f32x4 (&acc)[2][2][4][2], const Unit& u, int wr, int wc, int fr, int fq) const {
        const int row0 = u.pm * BM + wr * 64 + fr, col0 = u.pn * BM + wc * 32 + 8 * fq;
#pragma unroll
        for (int ai = 0; ai < 2; ++ai)
#pragma unroll
            for (int m = 0; m < 4; ++m) { bf16_t* rowp = O + (size_t)(row0 + ai * HALF + m * 16) * ldc + col0; const float sc = rs ? rs[row0 + ai * HALF + m * 16] : 1.0f;
#pragma unroll
                for (int bj = 0; bj < 2; ++bj) { const f32x4 v0 = acc[ai][bj][m][0] * sc, v1 = acc[ai][bj][m][1] * sc;
                    u32x4 w; w.x = cvt_pk_bf16(sigm(v0[0]), sigm(v0[1])); w.y = cvt_pk_bf16(sigm(v0[2]), sigm(v0[3])); w.z = cvt_pk_bf16(sigm(v1[0]), sigm(v1[1])); w.w = cvt_pk_bf16(sigm(v1[2]), sigm(v1[3]));
                    *(u32x4*)(rowp + bj * HALF) = w; } }
    }
};
struct EpiSwiGLU {
    static constexpr bool PERM = true, AFTER_DRAIN = false;
    bf16_t* O; long ldc; const float* rs;
    __device__ __forceinline__ void operator()(const f32x4 (&acc)[2][2][4][2], const Unit& u, int wr, int wc, int fr, int fq) const {
        const int row0 = u.pm * BM + wr * 64 + fr, col0 = u.pn * HALF + wc * 32 + 8 * fq;
#pragma unroll
        for (int ai = 0; ai < 2; ++ai)
#pragma unroll
            for (int m = 0; m < 4; ++m) { bf16_t* rowp = O + (size_t)(row0 + ai * HALF + m * 16) * ldc + col0;
                const float sc = rs ? rs[row0 + ai * HALF + m * 16] : 1.0f;
                const f32x4 g0 = acc[ai][0][m][0] * sc, g1 = acc[ai][0][m][1] * sc, u0 = acc[ai][1][m][0] * sc, u1 = acc[ai][1][m][1] * sc;
                float r[8];
#pragma unroll
                for (int e = 0; e < 4; ++e) { r[e] = g0[e] * sigm(g0[e]) * u0[e]; r[4 + e] = g1[e] * sigm(g1[e]) * u1[e]; }
                u32x4 w; w.x = cvt_pk_bf16(r[0], r[1]); w.y = cvt_pk_bf16(r[2], r[3]); w.z = cvt_pk_bf16(r[4], r[5]); w.w = cvt_pk_bf16(r[6], r[7]);
                *(u32x4*)rowp = w; }
    }
};

struct EpiSwiGLUI {
    static constexpr bool PERM = true, AFTER_DRAIN = false;
    bf16_t* O; long ldc; const float* rs; const unsigned* cs;
    __device__ __forceinline__ void operator()(const f32x4 (&acc)[2][2][4][2], const Unit& u, int wr, int wc, int fr, int fq) const {
        const int row0 = u.pm * BM + wr * 64 + fr, col0 = u.pn * HALF + wc * 32 + 8 * fq;
        typedef __attribute__((address_space(1))) const float gfc_e; float scv[2][4];
#pragma unroll
        for (int ai = 0; ai < 2; ++ai)
#pragma unroll
            for (int m = 0; m < 4; ++m) scv[ai][m] = rs ? *(gfc_e*)(rs + row0 + ai * HALF + m * 16) : 1.0f;
        typedef __attribute__((address_space(1))) const u32x4 gv4c_e; u32x4 cw[2][2]; { const int wrow = u.pn * BM + wc * 32 + 8 * fq;
#pragma unroll
        for (int bj = 0; bj < 2; ++bj) { cw[bj][0] = *(gv4c_e*)(cs + wrow + bj * HALF); cw[bj][1] = *(gv4c_e*)(cs + wrow + bj * HALF + 4); } }
#pragma unroll
        for (int ai = 0; ai < 2; ++ai)
#pragma unroll
            for (int m = 0; m < 4; ++m) { bf16_t* rowp = O + (size_t)(row0 + ai * HALF + m * 16) * ldc + col0;
                const float sc = scv[ai][m];
                typedef int v4i_e __attribute__((ext_vector_type(4))); const float ps = (1.0f / 127.0f) * sc;
                const v4i_e ig0 = __builtin_bit_cast(v4i_e, acc[ai][0][m][0]), ig1 = __builtin_bit_cast(v4i_e, acc[ai][0][m][1]), iu0 = __builtin_bit_cast(v4i_e, acc[ai][1][m][0]), iu1 = __builtin_bit_cast(v4i_e, acc[ai][1][m][1]);
                const f32x4 g0 = {(float)ig0[0] * ps * __uint_as_float(cw[0][0].x), (float)ig0[1] * ps * __uint_as_float(cw[0][0].y), (float)ig0[2] * ps * __uint_as_float(cw[0][0].z), (float)ig0[3] * ps * __uint_as_float(cw[0][0].w)};
                const f32x4 g1 = {(float)ig1[0] * ps * __uint_as_float(cw[0][1].x), (float)ig1[1] * ps * __uint_as_float(cw[0][1].y), (float)ig1[2] * ps * __uint_as_float(cw[0][1].z), (float)ig1[3] * ps * __uint_as_float(cw[0][1].w)};
                const f32x4 u0 = {(float)iu0[0] * ps * __uint_as_float(cw[1][0].x), (float)iu0[1] * ps * __uint_as_float(cw[1][0].y), (float)iu0[2] * ps * __uint_as_float(cw[1][0].z), (float)iu0[3] * ps * __uint_as_float(cw[1][0].w)};
                const f32x4 u1 = {(float)iu1[0] * ps * __uint_as_float(cw[1][1].x), (float)iu1[1] * ps * __uint_as_float(cw[1][1].y), (float)iu1[2] * ps * __uint_as_float(cw[1][1].z), (float)iu1[3] * ps * __uint_as_float(cw[1][1].w)};
                float r[8];
#pragma unroll
                for (int e = 0; e < 4; ++e) { r[e] = g0[e] * sigm(g0[e]) * u0[e]; r[4 + e] = g1[e] * sigm(g1[e]) * u1[e]; }
                u32x4 w; w.x = cvt_pk_bf16(r[0], r[1]); w.y = cvt_pk_bf16(r[2], r[3]); w.z = cvt_pk_bf16(r[4], r[5]); w.w = cvt_pk_bf16(r[6], r[7]);
                *(u32x4*)rowp = w; }
    }
};

struct EpiSigMul {
    static constexpr bool PERM = true, AFTER_DRAIN = false;
    bf16_t* O; long ldc;
    __device__ __forceinline__ void operator()(const f32x4 (&acc)[2][2][4][2], const Unit& u, int wr, int wc, int fr, int fq) const {
        const int row0 = u.pm * BM + wr * 64 + fr, col0 = u.pn * BM + wc * 32 + 8 * fq;
#pragma unroll
        for (int ai = 0; ai < 2; ++ai)
#pragma unroll
            for (int m = 0; m < 4; ++m) { bf16_t* rowp = O + (size_t)(row0 + ai * HALF + m * 16) * ldc + col0;
#pragma unroll
                for (int bj = 0; bj < 2; ++bj) { const f32x4 v0 = acc[ai][bj][m][0], v1 = acc[ai][bj][m][1]; const u32x4 y = *(const u32x4*)(rowp + bj * HALF);
                    u32x4 w;
                    w.x = cvt_pk_bf16(sigm(v0[0]) * __uint_as_float(y.x << 16), sigm(v0[1]) * __uint_as_float(y.x & 0xffff0000u));
                    w.y = cvt_pk_bf16(sigm(v0[2]) * __uint_as_float(y.y << 16), sigm(v0[3]) * __uint_as_float(y.y & 0xffff0000u));
                    w.z = cvt_pk_bf16(sigm(v1[0]) * __uint_as_float(y.z << 16), sigm(v1[1]) * __uint_as_float(y.z & 0xffff0000u));
                    w.w = cvt_pk_bf16(sigm(v1[2]) * __uint_as_float(y.w << 16), sigm(v1[3]) * __uint_as_float(y.w & 0xffff0000u));
                    *(u32x4*)(rowp + bj * HALF) = w; } }
    }
};

template <bool FIRST> struct EpiGate {
    static constexpr bool PERM = true, AFTER_DRAIN = false;
    bf16_t* O; long ldc; const bf16_t* Gp; long ldg;
    __device__ __forceinline__ void operator()(const f32x4 (&acc)[2][2][4][2], const Unit& u, int wr, int wc, int fr, int fq) const {
        typedef __attribute__((address_space(1))) u32x4 gv4;
        const int row0 = u.pm * BM + wr * 64 + fr, col0 = u.pn * BM + wc * 32 + 8 * fq;
#pragma unroll
        for (int ai = 0; ai < 2; ++ai) {
            u32x4 g[4][2], y[4][2];
#pragma unroll
            for (int m = 0; m < 4; ++m) { const size_t row = (size_t)(row0 + ai * HALF + m * 16);
#pragma unroll
                for (int bj = 0; bj < 2; ++bj) { g[m][bj] = *(const gv4*)(Gp + row * ldg + col0 + bj * HALF); if (!FIRST) y[m][bj] = *(const gv4*)(O + row * ldc + col0 + bj * HALF); else y[m][bj] = (u32x4){0u, 0u, 0u, 0u}; } }
#pragma unroll
            for (int m = 0; m < 4; ++m) { const size_t row = (size_t)(row0 + ai * HALF + m * 16);
#pragma unroll
                for (int bj = 0; bj < 2; ++bj) { const f32x4 v0 = acc[ai][bj][m][0], v1 = acc[ai][bj][m][1]; const u32x4 gg = g[m][bj], yy = y[m][bj];
                    u32x4 w;
                    w.x = cvt_pk_bf16(fmaf(v0[0], __uint_as_float(gg.x << 16), __uint_as_float(yy.x << 16)), fmaf(v0[1], __uint_as_float(gg.x & 0xffff0000u), __uint_as_float(yy.x & 0xffff0000u)));
                    w.y = cvt_pk_bf16(fmaf(v0[2], __uint_as_float(gg.y << 16), __uint_as_float(yy.y << 16)), fmaf(v0[3], __uint_as_float(gg.y & 0xffff0000u), __uint_as_float(yy.y & 0xffff0000u)));
                    w.z = cvt_pk_bf16(fmaf(v1[0], __uint_as_float(gg.z << 16), __uint_as_float(yy.z << 16)), fmaf(v1[1], __uint_as_float(gg.z & 0xffff0000u), __uint_as_float(yy.z & 0xffff0000u)));
                    w.w = cvt_pk_bf16(fmaf(v1[2], __uint_as_float(gg.w << 16), __uint_as_float(yy.w << 16)), fmaf(v1[3], __uint_as_float(gg.w & 0xffff0000u), __uint_as_float(yy.w & 0xffff0000u)));
                    *(gv4*)(O + row * ldc + col0 + bj * HALF) = w; } }
        }
    }
};

struct GateOrder {
    StaticOrder so;
    __device__ void init(int M, int G_, int c_) { so.init(M, 1024, G_, c_); }
    __device__ bool next(int i, Unit& u) const { const int t = i / 3, n = i - 3 * t; Unit b; if (!so.next(t, b)) return false; u.pm = 128 * n + b.pm; u.pn = 4 * n + b.pn; return true; }
    __device__ __forceinline__ void a_ready(const Unit&) const {}
    __device__ __forceinline__ void done(const Unit&) const {}
};
struct EpiGateCat {
    static constexpr bool PERM = true, AFTER_DRAIN = false;
    bf16_t* O; long ldc; const bf16_t* Gp; long ldg;
    __device__ __forceinline__ void operator()(const f32x4 (&acc)[2][2][4][2], const Unit& u, int wr, int wc, int fr, int fq) const {
        typedef __attribute__((address_space(1))) u32x4 gv4;
        const int n = u.pm >> 7, pm = u.pm & 127, pn = u.pn & 3;
        const int row0 = pm * BM + wr * 64 + fr, col0 = pn * BM + wc * 32 + 8 * fq;
        const bf16_t* gb = Gp + 1024 * n;
#pragma unroll
        for (int ai = 0; ai < 2; ++ai) {
            u32x4 g[4][2], y[4][2];
#pragma unroll
            for (int m = 0; m < 4; ++m) { const size_t row = (size_t)(row0 + ai * HALF + m * 16);
#pragma unroll
                for (int bj = 0; bj < 2; ++bj) { g[m][bj] = *(const gv4*)(gb + row * ldg + col0 + bj * HALF); y[m][bj] = (u32x4){0u, 0u, 0u, 0u}; } }
            if (n != 0) {
#pragma unroll
                for (int m = 0; m < 4; ++m) { const size_t row = (size_t)(row0 + ai * HALF + m * 16);
#pragma unroll
                    for (int bj = 0; bj < 2; ++bj) y[m][bj] = *(const gv4*)(O + row * ldc + col0 + bj * HALF); } }
#pragma unroll
            for (int m = 0; m < 4; ++m) { const size_t row = (size_t)(row0 + ai * HALF + m * 16);
#pragma unroll
                for (int bj = 0; bj < 2; ++bj) { const f32x4 v0 = acc[ai][bj][m][0], v1 = acc[ai][bj][m][1]; const u32x4 gg = g[m][bj], yy = y[m][bj];
                    u32x4 w;
                    w.x = cvt_pk_bf16(fmaf(v0[0], __uint_as_float(gg.x << 16), __uint_as_float(yy.x << 16)), fmaf(v0[1], __uint_as_float(gg.x & 0xffff0000u), __uint_as_float(yy.x & 0xffff0000u)));
                    w.y = cvt_pk_bf16(fmaf(v0[2], __uint_as_float(gg.y << 16), __uint_as_float(yy.y << 16)), fmaf(v0[3], __uint_as_float(gg.y & 0xffff0000u), __uint_as_float(yy.y & 0xffff0000u)));
                    w.z = cvt_pk_bf16(fmaf(v1[0], __uint_as_float(gg.z << 16), __uint_as_float(yy.z << 16)), fmaf(v1[1], __uint_as_float(gg.z & 0xffff0000u), __uint_as_float(yy.z & 0xffff0000u)));
                    w.w = cvt_pk_bf16(fmaf(v1[2], __uint_as_float(gg.w << 16), __uint_as_float(yy.w << 16)), fmaf(v1[3], __uint_as_float(gg.w & 0xffff0000u), __uint_as_float(yy.w & 0xffff0000u)));
                    *(gv4*)(O + row * ldc + col0 + bj * HALF) = w; } }
        }
    }
};
struct EpiGateChain {
    static constexpr bool PERM = true, AFTER_DRAIN = false;
    bf16_t* O; long ldc; const bf16_t* Gp; long ldg;
    __device__ __forceinline__ bool chain(f32x4 (&acc)[2][2][4][2], const Unit& u, int wr, int wc, int fr, int fq) const {
        typedef __attribute__((address_space(1))) u32x4 gv4;
        const int n = u.pm >> 7, pm = u.pm & 127, pn = u.pn & 3;
        const int row0 = pm * BM + wr * 64 + fr, col0 = pn * BM + wc * 32 + 8 * fq;
        const bf16_t* gb = Gp + 1024 * n;
        const float tiny = 1e-30f;
        if (n < 2) {
#pragma unroll
            for (int ai = 0; ai < 2; ++ai) {
                u32x4 g[4][2], h[4][2];
#pragma unroll
                for (int m = 0; m < 4; ++m) { const size_t row = (size_t)(row0 + ai * HALF + m * 16);
#pragma unroll
                    for (int bj = 0; bj < 2; ++bj) { g[m][bj] = *(const gv4*)(gb + row * ldg + col0 + bj * HALF); h[m][bj] = *(const gv4*)(gb + 1024 + row * ldg + col0 + bj * HALF); } }
#pragma unroll
                for (int m = 0; m < 4; ++m)
#pragma unroll
                    for (int bj = 0; bj < 2; ++bj) { const u32x4 gg = g[m][bj], hh = h[m][bj];
#define PG8_RAT(GW, HW, LO) (fmaxf((LO) ? __uint_as_float((GW) << 16) : __uint_as_float((GW) & 0xffff0000u), tiny) * __builtin_amdgcn_rcpf(fmaxf((LO) ? __uint_as_float((HW) << 16) : __uint_as_float((HW) & 0xffff0000u), tiny)))
                        f32x4 v0 = acc[ai][bj][m][0], v1 = acc[ai][bj][m][1];
                        v0[0] *= PG8_RAT(gg.x, hh.x, true); v0[1] *= PG8_RAT(gg.x, hh.x, false); v0[2] *= PG8_RAT(gg.y, hh.y, true); v0[3] *= PG8_RAT(gg.y, hh.y, false);
                        v1[0] *= PG8_RAT(gg.z, hh.z, true); v1[1] *= PG8_RAT(gg.z, hh.z, false); v1[2] *= PG8_RAT(gg.w, hh.w, true); v1[3] *= PG8_RAT(gg.w, hh.w, false);
#undef PG8_RAT
                        acc[ai][bj][m][0] = v0; acc[ai][bj][m][1] = v1; }
            }
            return true;
        }
#pragma unroll
        for (int ai = 0; ai < 2; ++ai) {
            u32x4 g[4][2];
#pragma unroll
            for (int m = 0; m < 4; ++m) { const size_t row = (size_t)(row0 + ai * HALF + m * 16);
#pragma unroll
                for (int bj = 0; bj < 2; ++bj) g[m][bj] = *(const gv4*)(gb + row * ldg + col0 + bj * HALF); }
#pragma unroll
            for (int m = 0; m < 4; ++m) { const size_t row = (size_t)(row0 + ai * HALF + m * 16);
#pragma unroll
                for (int bj = 0; bj < 2; ++bj) { const f32x4 v0 = acc[ai][bj][m][0], v1 = acc[ai][bj][m][1]; const u32x4 gg = g[m][bj];
#define PG8_GV(GW, LO) fmaxf((LO) ? __uint_as_float((GW) << 16) : __uint_as_float((GW) & 0xffff0000u), tiny)
                    u32x4 w;
                    w.x = cvt_pk_bf16(v0[0] * PG8_GV(gg.x, true), v0[1] * PG8_GV(gg.x, false)); w.y = cvt_pk_bf16(v0[2] * PG8_GV(gg.y, true), v0[3] * PG8_GV(gg.y, false));
                    w.z = cvt_pk_bf16(v1[0] * PG8_GV(gg.z, true), v1[1] * PG8_GV(gg.z, false)); w.w = cvt_pk_bf16(v1[2] * PG8_GV(gg.w, true), v1[3] * PG8_GV(gg.w, false));
#undef PG8_GV
                    *(gv4*)(O + row * ldc + col0 + bj * HALF) = w; } }
        }
        return false;
    }
};
struct EpiSigmoidQ {
    static constexpr bool PERM = true, AFTER_DRAIN = false;
    unsigned char* O; long ldc; const float* rs;
    __device__ __forceinline__ void operator()(const f32x4 (&acc)[2][2][4][2], const Unit& u, int wr, int wc, int fr, int fq) const {
        typedef unsigned u32x2_q __attribute__((ext_vector_type(2)));
        typedef __attribute__((address_space(1))) u32x2_q gv2;
        const int row0 = u.pm * BM + wr * 64 + fr, col0 = u.pn * BM + wc * 32 + 8 * fq;
#pragma unroll
        for (int ai = 0; ai < 2; ++ai)
#pragma unroll
            for (int m = 0; m < 4; ++m) { unsigned char* rowp = O + (size_t)(row0 + ai * HALF + m * 16) * ldc + col0;
#pragma unroll
                for (int bj = 0; bj < 2; ++bj) { const f32x4 v0 = acc[ai][bj][m][0], v1 = acc[ai][bj][m][1];
#define PG8_Q8(X) ((unsigned)(sigm(X) * 255.0f + 0.5f))
                    u32x2_q w; w.x = PG8_Q8(v0[0]) | (PG8_Q8(v0[1]) << 8) | (PG8_Q8(v0[2]) << 16) | (PG8_Q8(v0[3]) << 24); w.y = PG8_Q8(v1[0]) | (PG8_Q8(v1[1]) << 8) | (PG8_Q8(v1[2]) << 16) | (PG8_Q8(v1[3]) << 24);
#undef PG8_Q8
                    *(gv2*)(rowp + bj * HALF) = w; } }
    }
};
struct EpiSigmoidQI {
    static constexpr bool PERM = true, AFTER_DRAIN = false;
    unsigned char* O; long ldc; const float* rs; const unsigned* cs;
    __device__ __forceinline__ void operator()(const f32x4 (&acc)[2][2][4][2], const Unit& u, int wr, int wc, int fr, int fq) const {
        typedef unsigned u32x2_q __attribute__((ext_vector_type(2)));
        typedef __attribute__((address_space(1))) u32x2_q gv2;
        const int row0 = u.pm * BM + wr * 64 + fr, col0 = u.pn * BM + wc * 32 + 8 * fq;
        typedef __attribute__((address_space(1))) const float gfc_e; float scv[2][4];
#pragma unroll
        for (int ai = 0; ai < 2; ++ai)
#pragma unroll
            for (int m = 0; m < 4; ++m) scv[ai][m] = rs ? *(gfc_e*)(rs + row0 + ai * HALF + m * 16) : 1.0f;
        typedef __attribute__((address_space(1))) const u32x4 gv4c_e; u32x4 cw[2][2];
#pragma unroll
        for (int bj = 0; bj < 2; ++bj) { cw[bj][0] = *(gv4c_e*)(cs + col0 + bj * HALF); cw[bj][1] = *(gv4c_e*)(cs + col0 + bj * HALF + 4); }
#pragma unroll
        for (int ai = 0; ai < 2; ++ai)
#pragma unroll
            for (int m = 0; m < 4; ++m) { unsigned char* rowp = O + (size_t)(row0 + ai * HALF + m * 16) * ldc + col0; const float ps = (1.0f / 127.0f) * scv[ai][m];
#pragma unroll
                for (int bj = 0; bj < 2; ++bj) { typedef int v4i_e __attribute__((ext_vector_type(4))); const v4i_e i0 = __builtin_bit_cast(v4i_e, acc[ai][bj][m][0]), i1 = __builtin_bit_cast(v4i_e, acc[ai][bj][m][1]);
                    const u32x4 c0 = cw[bj][0], c1 = cw[bj][1];
                    const f32x4 v0 = {(float)i0[0] * ps * __uint_as_float(c0.x), (float)i0[1] * ps * __uint_as_float(c0.y), (float)i0[2] * ps * __uint_as_float(c0.z), (float)i0[3] * ps * __uint_as_float(c0.w)}, v1 = {(float)i1[0] * ps * __uint_as_float(c1.x), (float)i1[1] * ps * __uint_as_float(c1.y), (float)i1[2] * ps * __uint_as_float(c1.z), (float)i1[3] * ps * __uint_as_float(c1.w)};
#define PG8_Q8(X) ((unsigned)(sigm(X) * 255.0f + 0.5f))
                    u32x2_q w; w.x = PG8_Q8(v0[0]) | (PG8_Q8(v0[1]) << 8) | (PG8_Q8(v0[2]) << 16) | (PG8_Q8(v0[3]) << 24); w.y = PG8_Q8(v1[0]) | (PG8_Q8(v1[1]) << 8) | (PG8_Q8(v1[2]) << 16) | (PG8_Q8(v1[3]) << 24);
#undef PG8_Q8
                    *(gv2*)(rowp + bj * HALF) = w; } }
    }
};
struct EpiGateChainQ {
    static constexpr bool PERM = true, AFTER_DRAIN = false;
    bf16_t* O; long ldc; const unsigned char* Gp; long ldg;
    __device__ __forceinline__ bool chain(f32x4 (&acc)[2][2][4][2], const Unit& u, int wr, int wc, int fr, int fq) const {
        typedef unsigned u32x2_q __attribute__((ext_vector_type(2)));
        typedef __attribute__((address_space(1))) const u32x2_q gv2c;
        typedef __attribute__((address_space(1))) u32x4 gv4;
        const int n = u.pm >> 7, pm = u.pm & 127, pn = u.pn & 3;
        const int row0 = pm * BM + wr * 64 + fr, col0 = pn * BM + wc * 32 + 8 * fq;
        const unsigned char* gb = Gp + 1024 * n;
#define PG8_B(W, K) fmaxf((float)(((W) >> (8 * (K))) & 0xffu), 0.25f)
        if (n < 2) {
            u32x2_q g[2][4][2], h[2][4][2];
#pragma unroll
            for (int ai = 0; ai < 2; ++ai)
#pragma unroll
                for (int m = 0; m < 4; ++m) { const size_t row = (size_t)(row0 + ai * HALF + m * 16);
#pragma unroll
                    for (int bj = 0; bj < 2; ++bj) { g[ai][m][bj] = *(gv2c*)(gb + row * ldg + col0 + bj * HALF); h[ai][m][bj] = *(gv2c*)(gb + 1024 + row * ldg + col0 + bj * HALF); } }
#pragma unroll
            for (int ai = 0; ai < 2; ++ai)
#pragma unroll
                for (int m = 0; m < 4; ++m)
#pragma unroll
                    for (int bj = 0; bj < 2; ++bj) { const u32x2_q gg = g[ai][m][bj], hh = h[ai][m][bj];
                        f32x4 v0 = acc[ai][bj][m][0], v1 = acc[ai][bj][m][1];
#pragma unroll
                        for (int k = 0; k < 4; ++k) { v0[k] *= PG8_B(gg.x, k) * __builtin_amdgcn_rcpf(PG8_B(hh.x, k)); v1[k] *= PG8_B(gg.y, k) * __builtin_amdgcn_rcpf(PG8_B(hh.y, k)); }
                        acc[ai][bj][m][0] = v0; acc[ai][bj][m][1] = v1; }
            return true;
        }
        u32x2_q g[2][4][2];
#pragma unroll
        for (int ai = 0; ai < 2; ++ai)
#pragma unroll
            for (int m = 0; m < 4; ++m) { const size_t row = (size_t)(row0 + ai * HALF + m * 16);
#pragma unroll
                for (int bj = 0; bj < 2; ++bj) g[ai][m][bj] = *(gv2c*)(gb + row * ldg + col0 + bj * HALF); }
#pragma unroll
        for (int ai = 0; ai < 2; ++ai)
#pragma unroll
            for (int m = 0; m < 4; ++m) { const size_t row = (size_t)(row0 + ai * HALF + m * 16);
#pragma unroll
                for (int bj = 0; bj < 2; ++bj) { const f32x4 v0 = acc[ai][bj][m][0], v1 = acc[ai][bj][m][1]; const u32x2_q gg = g[ai][m][bj]; const float s = 1.0f / 255.0f;
                    u32x4 w;
                    w.x = cvt_pk_bf16(v0[0] * (PG8_B(gg.x, 0) * s), v0[1] * (PG8_B(gg.x, 1) * s)); w.y = cvt_pk_bf16(v0[2] * (PG8_B(gg.x, 2) * s), v0[3] * (PG8_B(gg.x, 3) * s));
                    w.z = cvt_pk_bf16(v1[0] * (PG8_B(gg.y, 0) * s), v1[1] * (PG8_B(gg.y, 1) * s)); w.w = cvt_pk_bf16(v1[2] * (PG8_B(gg.y, 2) * s), v1[3] * (PG8_B(gg.y, 3) * s));
                    *(gv4*)(O + row * ldc + col0 + bj * HALF) = w; } }
#undef PG8_B
        return false;
    }
};
}


__device__ __forceinline__ int srccol(int mode, int n, int a, int b) {
    if (mode == 0) return n < b ? a + n : -1;
    if (mode == 1) { const int t = n >> 8, r = n & 255; return r < 128 ? 128 * t + r : DFF + 128 * t + (r - 128); }
    if (n < 1280) return n; if (n < 2720) return n + 24; if (n < 2744) return 1280 + (n - 2720); return -1;
}
__device__ __forceinline__ float gelu_tanh(float x) { const float u = 0.7978845608028654f * (x + 0.044715f * x * x * x); return 0.5f * x * (1.0f + tanhf(u)); }
__device__ __forceinline__ void load_q64(float (&q)[64], const bf16_t* p, float scale) {
    const uint4* p4 = (const uint4*)p;
#pragma unroll
    for (int i = 0; i < 8; ++i) { const uint4 w = p4[i];
        q[8 * i + 0] = bflo(w.x) * scale; q[8 * i + 1] = bfhi(w.x) * scale; q[8 * i + 2] = bflo(w.y) * scale; q[8 * i + 3] = bfhi(w.y) * scale;
        q[8 * i + 4] = bflo(w.z) * scale; q[8 * i + 5] = bfhi(w.z) * scale; q[8 * i + 6] = bflo(w.w) * scale; q[8 * i + 7] = bfhi(w.w) * scale; }
}
__device__ __forceinline__ float dot64_bf(const float (&q)[64], const bf16_t* k) {
    const uint4* k4 = (const uint4*)k; float s = 0.f;
#pragma unroll
    for (int i = 0; i < 8; ++i) { const uint4 w = k4[i];
        s += q[8 * i + 0] * bflo(w.x) + q[8 * i + 1] * bfhi(w.x) + q[8 * i + 2] * bflo(w.y) + q[8 * i + 3] * bfhi(w.y)
           + q[8 * i + 4] * bflo(w.z) + q[8 * i + 5] * bfhi(w.z) + q[8 * i + 6] * bflo(w.w) + q[8 * i + 7] * bfhi(w.w); if ((i & 3) == 3) asm volatile("" ::: "memory"); }
    return s;
}
__device__ __forceinline__ float dot64_f(const float (&q)[64], const float* k) {
    const float4* k4 = (const float4*)k; float s = 0.f;
#pragma unroll
    for (int i = 0; i < 16; ++i) { const float4 w = k4[i]; s += q[4 * i] * w.x + q[4 * i + 1] * w.y + q[4 * i + 2] * w.z + q[4 * i + 3] * w.w; if ((i & 3) == 3) asm volatile("" ::: "memory"); }
    return s;
}
__device__ __forceinline__ void upd_bf(float (&o)[64], float& m, float& l, float s, const bf16_t* v) {
    const float mn = fmaxf(m, s), c = __expf(m - mn), p = __expf(s - mn); l = l * c + p; m = mn;
    const uint4* v4 = (const uint4*)v;
#pragma unroll
    for (int i = 0; i < 8; ++i) { const uint4 w = v4[i];
        o[8 * i + 0] = o[8 * i + 0] * c + p * bflo(w.x); o[8 * i + 1] = o[8 * i + 1] * c + p * bfhi(w.x); o[8 * i + 2] = o[8 * i + 2] * c + p * bflo(w.y); o[8 * i + 3] = o[8 * i + 3] * c + p * bfhi(w.y);
        o[8 * i + 4] = o[8 * i + 4] * c + p * bflo(w.z); o[8 * i + 5] = o[8 * i + 5] * c + p * bfhi(w.z); o[8 * i + 6] = o[8 * i + 6] * c + p * bflo(w.w); o[8 * i + 7] = o[8 * i + 7] * c + p * bfhi(w.w);  if ((i & 3) == 3) asm volatile("" ::: "memory"); }
}
template <bool ACCUM> __device__ __forceinline__ void store_o64(bf16_t* O, const float (&o)[64], float f) {
    uint4* O4 = (uint4*)O;
#pragma unroll
    for (int i = 0; i < 8; ++i) { float r[8];
#pragma unroll
        for (int e = 0; e < 8; ++e) r[e] = o[8 * i + e] * f;
        if (ACCUM) { const uint4 w = O4[i]; r[0] += bflo(w.x); r[1] += bfhi(w.x); r[2] += bflo(w.y); r[3] += bfhi(w.y); r[4] += bflo(w.z); r[5] += bfhi(w.z); r[6] += bflo(w.w); r[7] += bfhi(w.w); }
        uint4 w; w.x = (unsigned)f2bf(r[0]) | ((unsigned)f2bf(r[1]) << 16); w.y = (unsigned)f2bf(r[2]) | ((unsigned)f2bf(r[3]) << 16);
        w.z = (unsigned)f2bf(r[4]) | ((unsigned)f2bf(r[5]) << 16); w.w = (unsigned)f2bf(r[6]) | ((unsigned)f2bf(r[7]) << 16); O4[i] = w; }
}
__device__ __forceinline__ float sigmoidf_(float x) { return 1.0f / (1.0f + __expf(-x)); }


#define LAS __attribute__((address_space(3)))
#define LDS_WAIT() asm volatile("s_waitcnt lgkmcnt(0)" ::: "memory")
#define VM_WAIT() asm volatile("s_waitcnt vmcnt(0)" ::: "memory")
#define XB_TMO      128
#define XB_XCNT(j)  (256  + 64 * (j))
#define XB_XSUB(j)  (1280 + 64 * (j))
#define XB_XGEN(j)  (2304 + 64 * (j))
#define XB_TOP      3328
#define XB_TOPGEN   3392
#define XCD_BAR_WORDS 3456
#define XB_SPIN_CAP (1u << 18)

__device__ __forceinline__ unsigned xb_ld(unsigned* p)              { return __hip_atomic_load(p, __ATOMIC_RELAXED, __HIP_MEMORY_SCOPE_AGENT); }
__device__ __forceinline__ unsigned xb_add(unsigned* p, unsigned v) { return __hip_atomic_fetch_add(p, v, __ATOMIC_RELAXED, __HIP_MEMORY_SCOPE_AGENT); }
__device__ __forceinline__ unsigned xb_xcc_id() { return (unsigned)__builtin_amdgcn_s_getreg((3 << 11) | 20) & 0xFu; }
#define XB_SPIN(cond, bar) do { unsigned _sp = 0; while (cond) { __builtin_amdgcn_s_sleep(1); \
    if ((++_sp & 255u) == 0u) { if (xb_ld(&(bar)[XB_TMO])) break; if (_sp > XB_SPIN_CAP) { atomicAdd(&(bar)[XB_TMO], 1u); break; } } } } while (0)

struct XcdBarrier {
    unsigned* bar; unsigned x;
    volatile LAS unsigned* st;
};

__device__ __forceinline__ XcdBarrier xcd_barrier_post(unsigned* bar, volatile LAS unsigned* st) {
    XcdBarrier b; b.bar = bar; b.x = xb_xcc_id(); b.st = st;
    if (threadIdx.x == 0) (void)xb_add(&bar[XB_XCNT(b.x)], 1u);
    return b;
}
__device__ __forceinline__ void xcd_barrier_complete(unsigned* bar, unsigned x, unsigned& nloc, unsigned& nx) {
    const unsigned G = gridDim.x * gridDim.y * gridDim.z;
    unsigned sum, cnt, mine, sp = 0u;
    for (;;) {
        sum = 0u; cnt = 0u; mine = 0u;
#pragma unroll
        for (unsigned j = 0; j < 16; ++j) { const unsigned c = xb_ld(&bar[XB_XCNT(j)]); sum += c; cnt += (c > 0u) ? 1u : 0u; mine = (j == x) ? c : mine; }
        if (sum == G) break;
        __builtin_amdgcn_s_sleep(1);
        if ((++sp & 255u) == 0u) { if (xb_ld(&bar[XB_TMO])) break; if (sp > XB_SPIN_CAP) { atomicAdd(&bar[XB_TMO], 1u); break; } }
    }
    nloc = mine > 0u ? mine : 1u; nx = cnt > 0u ? cnt : 1u;
}

__device__ __forceinline__ void xcd_barrier(const XcdBarrier& b) {
    asm volatile("s_waitcnt vmcnt(0)" ::: "memory");
    __syncthreads();
    if (threadIdx.x == 0) {
        unsigned* bar = b.bar;
        __builtin_amdgcn_s_waitcnt(0);
        unsigned nloc = b.st[0], nx = b.st[1];
        if (nloc == 0u) { xcd_barrier_complete(bar, b.x, nloc, nx); b.st[0] = nloc; b.st[1] = nx; }
        const unsigned old = xb_add(&bar[XB_XSUB(b.x)], 1u);
        const unsigned gen = old / nloc;
        if (old + 1u == (gen + 1u) * nloc) {
            __builtin_amdgcn_fence(__ATOMIC_RELEASE, "agent");
            asm volatile("s_waitcnt vmcnt(0)" ::: "memory");
            const unsigned og = xb_add(&bar[XB_TOP], 1u);
            const unsigned tg = og / nx;
            if (og + 1u == (tg + 1u) * nx) xb_add(&bar[XB_TOPGEN], 1u);
            else XB_SPIN(xb_ld(&bar[XB_TOPGEN]) == tg, bar);
            __builtin_amdgcn_fence(__ATOMIC_ACQUIRE, "agent");
            xb_add(&bar[XB_XGEN(b.x)], 1u);
            asm volatile("s_waitcnt vmcnt(0)" ::: "memory");
        } else {
            XB_SPIN(xb_ld(&bar[XB_XGEN(b.x)]) == gen, bar);
            __builtin_amdgcn_fence(__ATOMIC_ACQUIRE, "agent");
            asm volatile("s_waitcnt vmcnt(0)" ::: "memory");
        }
    }
    __syncthreads();
}

constexpr int RING_BYTES = 131072, LDSCTL_OFF = RING_BYTES, MISC_OFF = LDSCTL_OFF + 320, LDS_BYTES = 147456;
constexpr int NWAVES = 8;
constexpr size_t MiB = 1ull << 20;
constexpr size_t WS_CTL = 0, CTL_ZERO_BYTES = 1 * MiB; constexpr int CW_BAR = 4096;
constexpr size_t WS_BD = 1 * MiB;
constexpr size_t WS_RC = WS_BD + 256 * 1024;
constexpr size_t WS_RS = WS_RC + 256 * 1024;
constexpr size_t WS_KC = 2 * MiB, WS_VC = 3 * MiB;
constexpr size_t WS_SEL = 4 * MiB;
constexpr size_t WS_KR = 4 * MiB + 512 * 1024;
constexpr size_t WS_WT = 9 * MiB;
constexpr size_t WT_GU1 = 0, WT_D1 = WT_GU1 + 11 * MiB, WT_GU2 = WT_D1 + 5632 * 1024, WT_D2 = WT_GU2 + 11 * MiB, WT_ZA = WT_D2 + 5632 * 1024,
                 WT_G = WT_ZA + 5632 * 1024, WT_B = WT_G + 6 * MiB, WT_OUT = WT_B + 3 * MiB, WT_QB = WT_OUT + 2 * MiB, WT_KVB = WT_QB + 768 * 384 * 2, WT_END = WT_KVB + 1024 * 256 * 2;
static_assert(WT_END <= 51 * MiB, "weights region");
constexpr size_t WS_HN = 60 * MiB;
constexpr size_t WS_RA = 124 * MiB;
constexpr size_t WS_RB = 300 * MiB;
constexpr size_t WS_RCC = 412 * MiB;
constexpr size_t WS_END = 508 * MiB;
constexpr size_t WS_YCAT = WS_RA;

struct Params { const float* in[26]; float* out; unsigned char* ws; };

__device__ __forceinline__ void tr_item2(const float* __restrict__ W, int K, int N, bf16_t* __restrict__ Wt, int Ndst, int mode, int a, int b, const float* __restrict__ gain, int item0, int item1, bool two, LAS float* scr, int lane) {
    const int nblk = Ndst >> 5;
    float v[2][32];
    typedef __attribute__((address_space(1))) const float gfl;
#pragma unroll
    for (int q = 0; q < 2; ++q) { const int item = (q == 0 || two) ? (q ? item1 : item0) : item0; const int kb = item / nblk, nb = item - kb * nblk, k0 = kb << 6, n0 = nb << 5;
        const int sc = srccol(mode, n0 + (lane & 31), a, b); const float keep = sc >= 0 ? 1.0f : 0.0f; const int scc = sc >= 0 ? sc : 0;
        gfl* wp = (gfl*)(W + (size_t)(k0 + (lane >> 5)) * N + scc);
#pragma unroll
        for (int i = 0; i < 32; ++i) v[q][i] = wp[(size_t)(2 * i) * N] * keep; }
    if (gain) {
#pragma unroll
        for (int q = 0; q < 2; ++q) { const int item = (q == 0 || two) ? (q ? item1 : item0) : item0; const int kb = item / nblk, k0 = kb << 6;
            gfl* gp = (gfl*)(gain + k0 + (lane >> 5));
#pragma unroll
            for (int i = 0; i < 32; ++i) v[q][i] *= gp[2 * i]; } }
#pragma unroll
    for (int q = 0; q < 2; ++q) { if (q == 1 && !two) break;
#pragma unroll
        for (int i = 0; i < 32; ++i) scr[(2 * i + (lane >> 5)) * 33 + (lane & 31)] = v[q][i];
        LDS_WAIT();
        const int item = q ? item1 : item0; const int kb = item / nblk, nb = item - kb * nblk, k0 = kb << 6, n0 = nb << 5;
        const int c = lane & 7;
#pragma unroll
        for (int j = 0; j < 4; ++j) { const int n = (lane >> 3) + 8 * j; LAS const float* s = scr + (8 * c) * 33 + n;
            u32x4_t o; o.x = (unsigned)f2bf(s[0]) | ((unsigned)f2bf(s[33]) << 16); o.y = (unsigned)f2bf(s[66]) | ((unsigned)f2bf(s[99]) << 16);
            o.z = (unsigned)f2bf(s[132]) | ((unsigned)f2bf(s[165]) << 16); o.w = (unsigned)f2bf(s[198]) | ((unsigned)f2bf(s[231]) << 16);
            *(u32x4_t*)(Wt + (size_t)(n0 + n) * K + k0 + 8 * c) = o; }
        LDS_WAIT(); }
}
__device__ __forceinline__ void tr_matrix(const float* W, int K, int N, bf16_t* Wt, int Ndst, int mode, int a, int b, const float* gain, LAS float* scr, int lane, int gw, int NGW, int& rot) {
    const int cnt = (K >> 6) * (Ndst >> 5), npair = (cnt + 1) >> 1;
    int first = gw - rot; if (first < 0) first += NGW;
    for (int pr = first; pr < npair; pr += NGW) tr_item2(W, K, N, Wt, Ndst, mode, a, b, gain, 2 * pr, 2 * pr + 1, 2 * pr + 1 < cnt, scr, lane);
    rot = (rot + npair) % NGW;
}
__device__ __forceinline__ void rmsnorm_row(const float* __restrict__ x, const float* __restrict__ g, bf16_t* __restrict__ out, int row, int lane) {
    asm volatile("" : "+v"(lane));
    const float4* xr = (const float4*)(x + (size_t)row * DM); const float4* gr = (const float4*)g;
    float4 v[4]; float s = 0.f;
#pragma unroll
    for (int j = 0; j < 4; ++j) { v[j] = xr[j * 64 + lane]; s += v[j].x * v[j].x + v[j].y * v[j].y + v[j].z * v[j].z + v[j].w * v[j].w; }
    const float inv = rsqrtf(wave_sum(s) * (1.0f / DM) + NORM_EPS);
#pragma unroll
    for (int j = 0; j < 4; ++j) { const float4 gg = gr[j * 64 + lane]; ushort4 o; o.x = f2bf(v[j].x * inv * gg.x); o.y = f2bf(v[j].y * inv * gg.y); o.z = f2bf(v[j].z * inv * gg.z); o.w = f2bf(v[j].w * inv * gg.w);
        ((ushort4*)(out + (size_t)row * DM))[j * 64 + lane] = o; }
}
__device__ __forceinline__ void resnorm_row(const bf16_t* __restrict__ y, const float* __restrict__ gpost, float scale, const float* xin, float* xout, const float* __restrict__ gnext, bf16_t* __restrict__ hn, int row, int lane) {
    asm volatile("" : "+v"(lane));
    const ushort4* yr = (const ushort4*)(y + (size_t)row * DM); const float4* xr = (const float4*)(xin + (size_t)row * DM);
    float4 v[4]; float s = 0.f;
#pragma unroll
    for (int j = 0; j < 4; ++j) { const ushort4 t = yr[j * 64 + lane]; v[j] = make_float4(bf2f(t.x), bf2f(t.y), bf2f(t.z), bf2f(t.w)); s += v[j].x * v[j].x + v[j].y * v[j].y + v[j].z * v[j].z + v[j].w * v[j].w; }
    const float inv = rsqrtf(wave_sum(s) * (1.0f / DM) + NORM_EPS) * scale;
    float s2 = 0.f;
#pragma unroll
    for (int j = 0; j < 4; ++j) { const float4 gg = ((const float4*)gpost)[j * 64 + lane]; const float4 xx = xr[j * 64 + lane];
        v[j].x = xx.x + v[j].x * inv * gg.x; v[j].y = xx.y + v[j].y * inv * gg.y; v[j].z = xx.z + v[j].z * inv * gg.z; v[j].w = xx.w + v[j].w * inv * gg.w;
        s2 += v[j].x * v[j].x + v[j].y * v[j].y + v[j].z * v[j].z + v[j].w * v[j].w; }
#pragma unroll
    for (int j = 0; j < 4; ++j) ((float4*)(xout + (size_t)row * DM))[j * 64 + lane] = v[j];
    if (hn) { const float inv2 = rsqrtf(wave_sum(s2) * (1.0f / DM) + NORM_EPS);
#pragma unroll
        for (int j = 0; j < 4; ++j) { const float4 gg = ((const float4*)gnext)[j * 64 + lane]; ushort4 o; o.x = f2bf(v[j].x * inv2 * gg.x); o.y = f2bf(v[j].y * inv2 * gg.y); o.z = f2bf(v[j].z * inv2 * gg.z); o.w = f2bf(v[j].w * inv2 * gg.w);
            ((ushort4*)(hn + (size_t)row * DM))[j * 64 + lane] = o; } }
}
__device__ __forceinline__ void mla_prep_row(const bf16_t* __restrict__ Z, const float* __restrict__ gq, const float* __restrict__ gkv, const float* __restrict__ RC, const float* __restrict__ RS,
                                             bf16_t* __restrict__ QN, bf16_t* __restrict__ KVN, bf16_t* __restrict__ KR, int row, int lane) {
    asm volatile("" : "+v"(lane));
    const int pos = row & (SEQ - 1);
    const bf16_t* z = Z + (size_t)row * ZW;
    const bool hq = lane < 48, hk = lane < 32;
    uint4 wq = *(const uint4*)(z + Z_MQ + (hq ? lane : 0) * 8), wk = *(const uint4*)(z + Z_MKV + (hk ? lane : 0) * 8);
    const int l16 = lane & 15; const float x1 = bf2f(z[Z_MKR + l16]), x2 = bf2f(z[Z_MKR + 16 + l16]); const float c = RC[pos * 16 + l16], sn = RS[pos * 16 + l16];
    if (!hq) wq = make_uint4(0u, 0u, 0u, 0u);
    if (!hk) wk = make_uint4(0u, 0u, 0u, 0u);
    float q[8] = {bflo(wq.x), bfhi(wq.x), bflo(wq.y), bfhi(wq.y), bflo(wq.z), bfhi(wq.z), bflo(wq.w), bfhi(wq.w)};
    float kv[8] = {bflo(wk.x), bfhi(wk.x), bflo(wk.y), bfhi(wk.y), bflo(wk.z), bfhi(wk.z), bflo(wk.w), bfhi(wk.w)};
    float sq = 0.f, sk = 0.f;
#pragma unroll
    for (int e = 0; e < 8; ++e) { sq += q[e] * q[e]; sk += kv[e] * kv[e]; }
    const float invq = rsqrtf(wave_sum(sq) * (1.0f / 384.0f) + NORM_EPS), invk = rsqrtf(wave_sum(sk) * (1.0f / 256.0f) + NORM_EPS);
    const float4 gq0 = ((const float4*)gq)[(hq ? lane : 0) * 2], gq1 = ((const float4*)gq)[(hq ? lane : 0) * 2 + 1], gk0 = ((const float4*)gkv)[(hk ? lane : 0) * 2], gk1 = ((const float4*)gkv)[(hk ? lane : 0) * 2 + 1];
    if (hq) { const float4 g0 = gq0, g1 = gq1; uint4 w;
        w.x = (unsigned)f2bf(q[0] * invq * g0.x) | ((unsigned)f2bf(q[1] * invq * g0.y) << 16); w.y = (unsigned)f2bf(q[2] * invq * g0.z) | ((unsigned)f2bf(q[3] * invq * g0.w) << 16);
        w.z = (unsigned)f2bf(q[4] * invq * g1.x) | ((unsigned)f2bf(q[5] * invq * g1.y) << 16); w.w = (unsigned)f2bf(q[6] * invq * g1.z) | ((unsigned)f2bf(q[7] * invq * g1.w) << 16);
        *(uint4*)(QN + (size_t)row * 384 + lane * 8) = w; }
    if (hk) { const float4 g0 = gk0, g1 = gk1; uint4 w;
        w.x = (unsigned)f2bf(kv[0] * invk * g0.x) | ((unsigned)f2bf(kv[1] * invk * g0.y) << 16); w.y = (unsigned)f2bf(kv[2] * invk * g0.z) | ((unsigned)f2bf(kv[3] * invk * g0.w) << 16);
        w.z = (unsigned)f2bf(kv[4] * invk * g1.x) | ((unsigned)f2bf(kv[5] * invk * g1.y) << 16); w.w = (unsigned)f2bf(kv[6] * invk * g1.z) | ((unsigned)f2bf(kv[7] * invk * g1.w) << 16);
        *(uint4*)(KVN + (size_t)row * 256 + lane * 8) = w; }
    if (lane < 16) { KR[(size_t)row * 32 + lane] = f2bf(x1 * c - x2 * sn); KR[(size_t)row * 32 + 16 + lane] = f2bf(x1 * sn + x2 * c); }
}
__device__ __forceinline__ void compress_item(const bf16_t* __restrict__ Z, const float* __restrict__ pe, const float* __restrict__ w1, const float* __restrict__ w2, float* __restrict__ out,
                                              int b, int c, int hkv, int col, LAS float* scr, int lane) {
    asm volatile("" : "+v"(lane));
    LAS float* flat = scr; LAS float* hid = scr + 2048;
    for (int i = lane; i < 2048; i += 64) { const int l = i >> 6, d = i & 63; flat[i] = bf2f(Z[(size_t)(b * SEQ + 16 * c + l) * ZW + col + d]) + pe[i]; }
    LDS_WAIT();
    float h0 = 0.f, h1 = 0.f;
    for (int i = 0; i < 2048; ++i) { const float f = flat[i]; h0 += f * w1[i * 128 + lane]; h1 += f * w1[i * 128 + 64 + lane]; }
    hid[lane] = gelu_tanh(h0); hid[64 + lane] = gelu_tanh(h1);
    LDS_WAIT();
    float o = 0.f;
    for (int j = 0; j < 128; ++j) o += hid[j] * w2[j * 64 + lane];
    out[((size_t)(b * NCMP + c) * 2 + hkv) * 64 + lane] = o;
    LDS_WAIT();
}
__device__ __forceinline__ void swa_unit(const bf16_t* __restrict__ Z, const float* __restrict__ BD, const float* __restrict__ sinks, bf16_t* __restrict__ O, int b, int h, int t0, int lane) {
    asm volatile("" : "+v"(lane));
    const int t = t0 + lane, hkv = h >> 2; const size_t rowq = (size_t)(b * SEQ + t);
    const int qcol = Z_SQ + h * 64, kcol = Z_SK + hkv * 64, vcol = Z_SV + hkv * 64;
    const float* bd = BD + (8 + h) * 4096;
    float q[64], o[64]; load_q64(q, Z + rowq * ZW + qcol, 0.125f);
#pragma unroll
    for (int d = 0; d < 64; ++d) o[d] = 0.f;
    float m = -1e30f, l = 0.f;
    const int s_lo = t0 - 127 > 0 ? t0 - 127 : 0, s_hi = t0 + 63;
    for (int s = s_lo; s <= s_hi; ++s) { const bf16_t* kr = Z + (size_t)(b * SEQ + s) * ZW; const int dist = t - s; const bool valid = dist >= 0 && dist < 128;
        const float sc = dot64_bf(q, kr + kcol) + bd[valid ? dist : 0];
        if (valid) upd_bf(o, m, l, sc, kr + vcol); }
    const float sk = sinks[h], mf = fmaxf(m, sk), c = __expf(m - mf); const float den = l * c + __expf(sk - mf);
    store_o64<false>(O + rowq * 512 + h * 64, o, c / den);
}
__device__ __forceinline__ void cmp_unit(const bf16_t* __restrict__ Z, const float* __restrict__ BD, const float* __restrict__ KC, const float* __restrict__ VC, bf16_t* __restrict__ OA, unsigned long long* __restrict__ SEL,
                                         int b, int hkv, int t0, LAS float* imp, int lane) {
    asm volatile("" : "+v"(lane));
    const int t = t0 + lane; const size_t rowq = (size_t)(b * SEQ + t);
#define IMP(j) imp[lane * 64 + ((j) ^ lane)]
#pragma unroll 1
    for (int j = 0; j < 64; ++j) IMP(j) = 0.f;
    const int ncmax = (t0 + 63 >= 31) ? (t0 + 63 - 31) / 16 + 1 : 0;
    const int ncv = (t >= 31) ? (t - 31) / 16 + 1 : 0;
    for (int g = 0; g < 4; ++g) {
        const int h = hkv * 4 + g; const float* bd = BD + h * 4096;
        float q[64], o[64]; load_q64(q, Z + rowq * ZW + Z_NQ + h * 64, 0.125f);
        float m = -1e30f, l = 0.f;
        for (int c = 0; c < ncmax; ++c) { const bool valid = c < ncv; const int dist = t - (16 * c + 31);
            const float sc = dot64_f(q, KC + ((size_t)(b * NCMP + c) * 2 + hkv) * 64) + bd[valid ? dist : 0];
            if (valid) { const float mn = fmaxf(m, sc); l = l * __expf(m - mn) + __expf(sc - mn); m = mn; } }
        const float rl = l > 0.f ? 1.0f / l : 0.f;
#pragma unroll
        for (int d = 0; d < 64; ++d) o[d] = 0.f;
        for (int c = 0; c < ncmax; ++c) { const bool valid = c < ncv; const int dist = t - (16 * c + 31);
            const float* kc = KC + ((size_t)(b * NCMP + c) * 2 + hkv) * 64; const float* vc = VC + ((size_t)(b * NCMP + c) * 2 + hkv) * 64;
            const float sc = dot64_f(q, kc) + bd[valid ? dist : 0];
            const float p = valid ? __expf(sc - m) * rl : 0.f;
            const float4* v4 = (const float4*)vc;
#pragma unroll
            for (int i = 0; i < 16; ++i) { const float4 w = v4[i]; o[4 * i] += p * w.x; o[4 * i + 1] += p * w.y; o[4 * i + 2] += p * w.z; o[4 * i + 3] += p * w.w;  if ((i & 3) == 3) asm volatile("" ::: "memory"); }
            const int j = c >> 2;
            if ((c & 3) < 3) IMP(j) += p; else { IMP(j) += 0.5f * p; if (j + 1 < 64) IMP(j + 1) += 0.5f * p; } }
        const float gt = sigmoidf_(bf2f(Z[rowq * ZW + Z_GATE + h * 3 + 0]));
        store_o64<false>(OA + rowq * 512 + h * 64, o, gt);
    }
    const int cur = t >> 6;
    unsigned long long mask = 1ull | (1ull << cur); if (cur >= 1) mask |= 1ull << (cur - 1);
    const int need = 16 - __popcll(mask);
    for (int it = 0; it < 13; ++it) { if (it >= need) break;
        float best = -1.f; int bj = -1;
#pragma unroll 1
        for (int j = 1; j <= cur - 2; ++j) { const float v = IMP(j); if (!((mask >> j) & 1ull) && v > best) { best = v; bj = j; } }
        if (bj < 0) break; mask |= 1ull << bj; }
    SEL[(size_t)(b * 2 + hkv) * SEQ + t] = mask;
    LDS_WAIT();
#undef IMP
}
__device__ __forceinline__ void winsel_unit(const bf16_t* __restrict__ Z, const float* __restrict__ BD, const unsigned long long* __restrict__ SEL, bf16_t* __restrict__ OA, int b, int h, int t0, int lane) {
    asm volatile("" : "+v"(lane));
    const int t = t0 + lane, hkv = h >> 2, cur = t0 >> 6; const size_t rowq = (size_t)(b * SEQ + t);
    const float* bd = BD + h * 4096;
    float q[64], o[64]; load_q64(q, Z + rowq * ZW + Z_NQ + h * 64, 0.125f);
#pragma unroll
    for (int d = 0; d < 64; ++d) o[d] = 0.f;
    float m = -1e30f, l = 0.f;
    { const int s_lo = t0 - 511 > 0 ? t0 - 511 : 0, s_hi = t0 + 63;
      for (int s = s_lo; s <= s_hi; ++s) { const bf16_t* kr = Z + (size_t)(b * SEQ + s) * ZW; const int dist = t - s; const bool valid = dist >= 0 && dist < 512;
          const float sc = dot64_bf(q, kr + Z_KW + hkv * 64) + bd[valid ? dist : 0];
          if (valid) upd_bf(o, m, l, sc, kr + Z_VW + hkv * 64); } }
    store_o64<true>(OA + rowq * 512 + h * 64, o, sigmoidf_(bf2f(Z[rowq * ZW + Z_GATE + h * 3 + 2])) / l);
    const unsigned long long mask = SEL[(size_t)(b * 2 + hkv) * SEQ + t];
#pragma unroll
    for (int d = 0; d < 64; ++d) o[d] = 0.f;
    m = -1e30f; l = 0.f;
    for (int j = 0; j <= cur; ++j) { const bool need = (mask >> j) & 1ull; if (!__any(need)) continue;
        for (int p = 0; p < 64; ++p) { const int s = 64 * j + p; const int dist = t - s; const bool valid = need && dist >= 0;
            const bf16_t* kr = Z + (size_t)(b * SEQ + s) * ZW;
            const float sc = dot64_bf(q, kr + Z_KS + hkv * 64) + bd[valid ? dist : 0];
            if (valid) upd_bf(o, m, l, sc, kr + Z_VS + hkv * 64); } }
    store_o64<true>(OA + rowq * 512 + h * 64, o, sigmoidf_(bf2f(Z[rowq * ZW + Z_GATE + h * 3 + 1])) / l);
}
__device__ __forceinline__ void mla_unit(const bf16_t* __restrict__ MQ, const bf16_t* __restrict__ MKV, const float* __restrict__ KR, const float* __restrict__ RC, const float* __restrict__ RS, bf16_t* __restrict__ OC, int b, int h, int t0, int lane) {
    asm volatile("" : "+v"(lane));
    const int t = t0 + lane; const size_t rowq = (size_t)(b * SEQ + t);
    const float scale = 0.10206207261596577f;
    float q[64], qr[32], o[64]; load_q64(q, MQ + rowq * 768 + h * 96, scale);
    { const bf16_t* p = MQ + rowq * 768 + h * 96 + 64;
#pragma unroll
      for (int i = 0; i < 16; ++i) { const float x1 = bf2f(p[i]), x2 = bf2f(p[16 + i]); const float c = RC[t * 16 + i], sn = RS[t * 16 + i]; qr[i] = (x1 * c - x2 * sn) * scale; qr[16 + i] = (x1 * sn + x2 * c) * scale; } }
#pragma unroll
    for (int d = 0; d < 64; ++d) o[d] = 0.f;
    float m = -1e30f, l = 0.f;
    for (int s = 0; s <= t0 + 63; ++s) { const size_t rk = (size_t)(b * SEQ + s); const bf16_t* kv = MKV + rk * 1024 + h * 128; const float4* kr4 = (const float4*)(KR + rk * 32);
        float sc = dot64_bf(q, kv);
#pragma unroll
        for (int i = 0; i < 8; ++i) { const float4 w = kr4[i]; sc += qr[4 * i] * w.x + qr[4 * i + 1] * w.y + qr[4 * i + 2] * w.z + qr[4 * i + 3] * w.w; }
        if (s <= t) upd_bf(o, m, l, sc, kv + 64); }
    store_o64<false>(OC + rowq * 512 + h * 64, o, 1.0f / l);
}
__device__ __forceinline__ void merge_row(const bf16_t* __restrict__ GY, bf16_t* __restrict__ out, int row, int lane) {
    asm volatile("" : "+v"(lane));
#pragma unroll
    for (int j = 0; j < 2; ++j) { const int c = j * 512 + lane * 8; float r[8];
#pragma unroll
        for (int e = 0; e < 8; ++e) r[e] = 0.f;
#pragma unroll
        for (int n = 0; n < 3; ++n) { const uint4 g = *(const uint4*)(GY + (size_t)row * 3072 + n * 1024 + c);
            r[0] += bflo(g.x); r[1] += bfhi(g.x); r[2] += bflo(g.y); r[3] += bfhi(g.y); r[4] += bflo(g.z); r[5] += bfhi(g.z); r[6] += bflo(g.w); r[7] += bfhi(g.w); }
        uint4 w; w.x = (unsigned)f2bf(r[0]) | ((unsigned)f2bf(r[1]) << 16); w.y = (unsigned)f2bf(r[2]) | ((unsigned)f2bf(r[3]) << 16);
        w.z = (unsigned)f2bf(r[4]) | ((unsigned)f2bf(r[5]) << 16); w.w = (unsigned)f2bf(r[6]) | ((unsigned)f2bf(r[7]) << 16);
        *(uint4*)(out + (size_t)row * 1024 + c) = w; }
}

template <bool XIN32> __device__ __forceinline__ void resid_row2(const bf16_t* __restrict__ y, const float* __restrict__ gpost, float scale, const float* __restrict__ xin32, const bf16_t* xinb, bf16_t* xb, float* rs,
                                                                float* __restrict__ out32, int row0, int row1, int lane) {
    float4 v[2][4], xx[2][4]; float s[2] = {0.f, 0.f};
    const float ri0 = XIN32 ? 1.0f : 1.0f / rs[row0], ri1 = XIN32 ? 1.0f : 1.0f / rs[row1];
#pragma unroll
    for (int q = 0; q < 2; ++q) { const int row = q ? row1 : row0; const ushort4* yr = (const ushort4*)(y + (size_t)row * DM);
#pragma unroll
        for (int j = 0; j < 4; ++j) { const ushort4 t = yr[j * 64 + lane]; v[q][j] = make_float4(bf2f(t.x), bf2f(t.y), bf2f(t.z), bf2f(t.w));
            if (XIN32) xx[q][j] = ((const float4*)(xin32 + (size_t)row * DM))[j * 64 + lane];
            else { const ushort4 u = ((const ushort4*)(xinb + (size_t)row * DM))[j * 64 + lane]; xx[q][j] = make_float4(bf2f(u.x), bf2f(u.y), bf2f(u.z), bf2f(u.w)); } } }
#pragma unroll
    for (int q = 0; q < 2; ++q)
#pragma unroll
        for (int j = 0; j < 4; ++j) s[q] += v[q][j].x * v[q][j].x + v[q][j].y * v[q][j].y + v[q][j].z * v[q][j].z + v[q][j].w * v[q][j].w;
    const float inv0 = rsqrtf(wave_sum(s[0]) * (1.0f / DM) + NORM_EPS) * scale, inv1 = rsqrtf(wave_sum(s[1]) * (1.0f / DM) + NORM_EPS) * scale;
    float s2[2] = {0.f, 0.f};
#pragma unroll
    for (int j = 0; j < 4; ++j) { const float4 gg = ((const float4*)gpost)[j * 64 + lane];
#pragma unroll
        for (int q = 0; q < 2; ++q) { const float inv = q ? inv1 : inv0, ri = q ? ri1 : ri0;
            v[q][j].x = xx[q][j].x * ri + v[q][j].x * inv * gg.x; v[q][j].y = xx[q][j].y * ri + v[q][j].y * inv * gg.y; v[q][j].z = xx[q][j].z * ri + v[q][j].z * inv * gg.z; v[q][j].w = xx[q][j].w * ri + v[q][j].w * inv * gg.w;
            s2[q] += v[q][j].x * v[q][j].x + v[q][j].y * v[q][j].y + v[q][j].z * v[q][j].z + v[q][j].w * v[q][j].w; } }
    if (out32) {
#pragma unroll
        for (int q = 0; q < 2; ++q) { const int row = q ? row1 : row0;
#pragma unroll
            for (int j = 0; j < 4; ++j) ((float4*)(out32 + (size_t)row * DM))[j * 64 + lane] = v[q][j]; }
    } else {
        const float r0 = rsqrtf(wave_sum(s2[0]) * (1.0f / DM) + NORM_EPS), r1 = rsqrtf(wave_sum(s2[1]) * (1.0f / DM) + NORM_EPS);
#pragma unroll
        for (int q = 0; q < 2; ++q) { const int row = q ? row1 : row0; const float r = q ? r1 : r0;
#pragma unroll
            for (int j = 0; j < 4; ++j) { ushort4 o; o.x = f2bf(v[q][j].x * r); o.y = f2bf(v[q][j].y * r); o.z = f2bf(v[q][j].z * r); o.w = f2bf(v[q][j].w * r); ((ushort4*)(xb + (size_t)row * DM))[j * 64 + lane] = o; } }
        if (lane == 0) { rs[row0] = r0; rs[row1] = r1; }
    }
}
__device__ __forceinline__ void xinit_row(const float* __restrict__ x, bf16_t* __restrict__ xb, float* __restrict__ rs, int row, int lane) {
    const float4* xr = (const float4*)(x + (size_t)row * DM); float4 v[4]; float s = 0.f;
#pragma unroll
    for (int j = 0; j < 4; ++j) { v[j] = xr[j * 64 + lane]; s += v[j].x * v[j].x + v[j].y * v[j].y + v[j].z * v[j].z + v[j].w * v[j].w; }
    const float r = rsqrtf(wave_sum(s) * (1.0f / DM) + NORM_EPS);
#pragma unroll
    for (int j = 0; j < 4; ++j) { ushort4 o; o.x = f2bf(v[j].x * r); o.y = f2bf(v[j].y * r); o.z = f2bf(v[j].z * r); o.w = f2bf(v[j].w * r); ((ushort4*)(xb + (size_t)row * DM))[j * 64 + lane] = o; }
    if (lane == 0) rs[row] = r;
}

__device__ __forceinline__ void mla_prep_rows4(const bf16_t* __restrict__ Z, const float* __restrict__ gq, const float* __restrict__ gkv, const float* __restrict__ RC, const float* __restrict__ RS,
                                               bf16_t* __restrict__ QN, bf16_t* __restrict__ KVN, bf16_t* __restrict__ KR, int row0, int rstep, int lane) {
    asm volatile("" : "+v"(lane));
    const bool hq = lane < 48, hk = lane < 32; const int lq = hq ? lane : 0, lk = hk ? lane : 0, l16 = lane & 15;
    uint4 wq[4], wk[4]; float x1[4], x2[4], cs[4], sn[4];
#pragma unroll
    for (int r = 0; r < 4; ++r) { const int row = row0 + r * rstep; const bf16_t* z = Z + (size_t)row * ZW; const int pos = row & (SEQ - 1);
        wq[r] = *(const uint4*)(z + Z_MQ + lq * 8); wk[r] = *(const uint4*)(z + Z_MKV + lk * 8);
        x1[r] = bf2f(z[Z_MKR + l16]); x2[r] = bf2f(z[Z_MKR + 16 + l16]); cs[r] = RC[pos * 16 + l16]; sn[r] = RS[pos * 16 + l16]; }
    const float4 gq0 = ((const float4*)gq)[lq * 2], gq1 = ((const float4*)gq)[lq * 2 + 1], gk0 = ((const float4*)gkv)[lk * 2], gk1 = ((const float4*)gkv)[lk * 2 + 1];
#pragma unroll
    for (int r = 0; r < 4; ++r) { const int row = row0 + r * rstep;
        if (!hq) wq[r] = make_uint4(0u, 0u, 0u, 0u);
        if (!hk) wk[r] = make_uint4(0u, 0u, 0u, 0u);
        float q[8] = {bflo(wq[r].x), bfhi(wq[r].x), bflo(wq[r].y), bfhi(wq[r].y), bflo(wq[r].z), bfhi(wq[r].z), bflo(wq[r].w), bfhi(wq[r].w)};
        float kv[8] = {bflo(wk[r].x), bfhi(wk[r].x), bflo(wk[r].y), bfhi(wk[r].y), bflo(wk[r].z), bfhi(wk[r].z), bflo(wk[r].w), bfhi(wk[r].w)};
        float sq = 0.f, sk = 0.f;
#pragma unroll
        for (int e = 0; e < 8; ++e) { sq += q[e] * q[e]; sk += kv[e] * kv[e]; }
        const float invq = rsqrtf(wave_sum(sq) * (1.0f / 384.0f) + NORM_EPS), invk = rsqrtf(wave_sum(sk) * (1.0f / 256.0f) + NORM_EPS);
        if (hq) { uint4 w;
            w.x = (unsigned)f2bf(q[0] * invq * gq0.x) | ((unsigned)f2bf(q[1] * invq * gq0.y) << 16); w.y = (unsigned)f2bf(q[2] * invq * gq0.z) | ((unsigned)f2bf(q[3] * invq * gq0.w) << 16);
            w.z = (unsigned)f2bf(q[4] * invq * gq1.x) | ((unsigned)f2bf(q[5] * invq * gq1.y) << 16); w.w = (unsigned)f2bf(q[6] * invq * gq1.z) | ((unsigned)f2bf(q[7] * invq * gq1.w) << 16);
            *(uint4*)(QN + (size_t)row * 384 + lane * 8) = w; }
        if (hk) { uint4 w;
            w.x = (unsigned)f2bf(kv[0] * invk * gk0.x) | ((unsigned)f2bf(kv[1] * invk * gk0.y) << 16); w.y = (unsigned)f2bf(kv[2] * invk * gk0.z) | ((unsigned)f2bf(kv[3] * invk * gk0.w) << 16);
            w.z = (unsigned)f2bf(kv[4] * invk * gk1.x) | ((unsigned)f2bf(kv[5] * invk * gk1.y) << 16); w.w = (unsigned)f2bf(kv[6] * invk * gk1.z) | ((unsigned)f2bf(kv[7] * invk * gk1.w) << 16);
            *(uint4*)(KVN + (size_t)row * 256 + lane * 8) = w; }
        if (lane < 16) { KR[(size_t)row * 32 + lane] = f2bf(x1[r] * cs[r] - x2[r] * sn[r]); KR[(size_t)row * 32 + 16 + lane] = f2bf(x1[r] * sn[r] + x2[r] * cs[r]); } }
}
__device__ __forceinline__ void tr_item2_i8(const float* __restrict__ W, int K, int N, unsigned char* __restrict__ Wt, int Ndst, int mode, int a, int b, const float* __restrict__ gain, int item0, int item1, bool two, LAS float* scr, int lane, const unsigned* __restrict__ cmax) {
    const int nblk = Ndst >> 5;
    float v[2][32];
    typedef __attribute__((address_space(1))) const float gfl;
#pragma unroll
    for (int q = 0; q < 2; ++q) { const int item = (q == 0 || two) ? (q ? item1 : item0) : item0; const int kb = item / nblk, nb = item - kb * nblk, k0 = kb << 6, n0 = nb << 5;
        const int sc = srccol(mode, n0 + (lane & 31), a, b); const float keep = sc >= 0 ? 1.0f : 0.0f; const int scc = sc >= 0 ? sc : 0;
        gfl* wp = (gfl*)(W + (size_t)(k0 + (lane >> 5)) * N + scc);
#pragma unroll
        for (int i = 0; i < 32; ++i) v[q][i] = wp[(size_t)(2 * i) * N] * keep; }
    if (gain) {
#pragma unroll
        for (int q = 0; q < 2; ++q) { const int item = (q == 0 || two) ? (q ? item1 : item0) : item0; const int kb = item / nblk, k0 = kb << 6;
            gfl* gp = (gfl*)(gain + k0 + (lane >> 5));
#pragma unroll
            for (int i = 0; i < 32; ++i) v[q][i] *= gp[2 * i]; } }
#pragma unroll
    for (int q = 0; q < 2; ++q) { if (q == 1 && !two) break;
#pragma unroll
        for (int i = 0; i < 32; ++i) scr[(2 * i + (lane >> 5)) * 33 + (lane & 31)] = v[q][i];
        LDS_WAIT();
        const int item = q ? item1 : item0; const int kb = item / nblk, nb = item - kb * nblk, k0 = kb << 6, n0 = nb << 5;
        const int c = lane & 7;
#pragma unroll
        for (int j = 0; j < 4; ++j) { const int n = (lane >> 3) + 8 * j; LAS const float* s = scr + (8 * c) * 33 + n;
            typedef unsigned u32x2_w __attribute__((ext_vector_type(2))); u32x2_w o;
            const float qs = 127.0f / fmaxf(__uint_as_float(cmax[n0 + n]), 1e-30f);
#define TR_Q8(X) ((unsigned)min(max(__float2int_rn((X) * qs), -127), 127) & 0xffu)
            o.x = TR_Q8(s[0]) | (TR_Q8(s[33]) << 8) | (TR_Q8(s[66]) << 16) | (TR_Q8(s[99]) << 24); o.y = TR_Q8(s[132]) | (TR_Q8(s[165]) << 8) | (TR_Q8(s[198]) << 16) | (TR_Q8(s[231]) << 24);
#undef TR_Q8
            *(u32x2_w*)(Wt + (size_t)(n0 + n) * K + k0 + 8 * c) = o; }
        LDS_WAIT(); }
}
__device__ __forceinline__ void tr_matrix_i8(const float* W, int K, int N, unsigned char* Wt, int Ndst, int mode, int a, int b, const float* gain, LAS float* scr, int lane, int gw, int NGW, int& rot, const unsigned* __restrict__ cmax) {
    asm volatile("" : "+s"(gw));
    const int cnt = (K >> 6) * (Ndst >> 5), npair = (cnt + 1) >> 1;
    int first = gw - rot; if (first < 0) first += NGW;
    for (int pr = first; pr < npair; pr += NGW) tr_item2_i8(W, K, N, Wt, Ndst, mode, a, b, gain, 2 * pr, 2 * pr + 1, 2 * pr + 1 < cnt, scr, lane, cmax);
    rot = (rot + npair) % NGW;
}
__device__ __forceinline__ void wg_absmax(const float* __restrict__ w_in, const float* __restrict__ gain, unsigned* word, int gw, int NGW, int lane) {
    typedef __attribute__((address_space(1))) const float gfl;
    for (int k = gw; k < DM; k += NGW) { gfl* wp = (gfl*)(w_in + (size_t)k * 5816 + 2744); float mx = 0.f;
#pragma unroll 8
        for (int i = 0; i < 48; ++i) mx = fmaxf(mx, fabsf(wp[i * 64 + lane]));
        mx *= fabsf(gain[k]);
#pragma unroll
        for (int s_ = 1; s_ < 64; s_ <<= 1) mx = fmaxf(mx, __shfl_xor(mx, s_));
        if (lane == 0) atomicMax(word, __float_as_uint(mx)); }
}
__device__ __forceinline__ void mat_absmax(const float* __restrict__ W, int ld, int c0, int nc, const float* __restrict__ gain, unsigned* word, int gw, int NGW, int lane) {
    typedef __attribute__((address_space(1))) const float gfl;
    for (int k = gw; k < DM; k += NGW) { gfl* wp = (gfl*)(W + (size_t)k * ld + c0); float mx = 0.f;
#pragma unroll 8
        for (int i = 0; i < nc / 64; ++i) mx = fmaxf(mx, fabsf(wp[i * 64 + lane]));
        mx *= fabsf(gain[k]);
#pragma unroll
        for (int s_ = 1; s_ < 64; s_ <<= 1) mx = fmaxf(mx, __shfl_xor(mx, s_));
        if (lane == 0) atomicMax(word, __float_as_uint(mx)); }
}
__device__ __forceinline__ void col_absmax(const float* __restrict__ W, int N, int Ndst, int mode, int a, int b, const float* __restrict__ gain, unsigned* cmax, int gw, int NGW, int lane) {
    asm volatile("" : "+s"(gw));
    typedef __attribute__((address_space(1))) const float gfl;
    const int ntask = (Ndst >> 6) * 8;
    for (int t = gw; t < ntask; t += NGW) { const int n = (t >> 3) * 64 + lane, k0 = (t & 7) * 128; const int sc = srccol(mode, n, a, b); const int scc = sc >= 0 ? sc : 0;
        gfl* wp = (gfl*)(W + (size_t)k0 * N + scc); gfl* gp = (gfl*)(gain + k0); float mx = 0.f;
#pragma unroll 16
        for (int k = 0; k < 128; ++k) mx = fmaxf(mx, fabsf(wp[(size_t)k * N] * gp[k]));
        if (sc >= 0) atomicMax(cmax + n, __float_as_uint(mx)); }
}
__device__ __forceinline__ void strip_absmax_wg(const float* __restrict__ W, int N, int mode, int a, int b, const float* __restrict__ gain, unsigned* cmax, int strip, LAS float* red, int wave, int lane) {
    typedef __attribute__((address_space(1))) const float gfl;
    const int n = strip * 64 + lane, k0 = wave * 128; const int sc = srccol(mode, n, a, b); const int scc = sc >= 0 ? sc : 0;
    gfl* wp = (gfl*)(W + (size_t)k0 * N + scc); gfl* gp = (gfl*)(gain + k0); float mx = 0.f;
#pragma unroll 8
    for (int k = 0; k < 128; ++k) mx = fmaxf(mx, fabsf(wp[(size_t)k * N] * gp[k]));
    red[wave * 64 + lane] = mx;
    __syncthreads();
    if (wave == 0) { float m_ = red[lane];
#pragma unroll
        for (int w = 1; w < 8; ++w) m_ = fmaxf(m_, red[w * 64 + lane]);
        if (sc >= 0) cmax[n] = __float_as_uint(m_); }
    __syncthreads();
}
template <bool XIN32>
__device__ __forceinline__ void resid_stream(const bf16_t* __restrict__ y, const float* __restrict__ gpost, float scale, const float* __restrict__ xin32, bf16_t* xb, float* rs, float* __restrict__ out32, int gw, int NGW, int lane, unsigned char* __restrict__ x8 = nullptr) {
    typedef __attribute__((address_space(1))) const u32x4_t gv4c;
    typedef __attribute__((address_space(1))) u32x4_t gv4;
    typedef float f32x4_r __attribute__((ext_vector_type(4)));
    typedef __attribute__((address_space(1))) const f32x4_r gf4c;
    typedef __attribute__((address_space(1))) f32x4_r gf4;
    typedef __attribute__((address_space(1))) const float gfc;
    f32x4_r g[2][2];
#pragma unroll
    for (int j = 0; j < 2; ++j) { g[j][0] = *(gf4c*)(gpost + (j * 64 + lane) * 8); g[j][1] = *(gf4c*)(gpost + (j * 64 + lane) * 8 + 4); }
    u32x4_t yn[2][2], xn[2][2]; f32x4_r x32n[2][2][2]; float rsn[2] = {1.f, 1.f};
#define RS_LOAD(ROW0) do { _Pragma("unroll") for (int q = 0; q < 2; ++q) { const size_t ro_ = (size_t)((ROW0) + q * NGW) * DM; \
        _Pragma("unroll") for (int j = 0; j < 2; ++j) { const size_t o_ = ro_ + (size_t)(j * 64 + lane) * 8; yn[q][j] = *(gv4c*)(y + o_); \
            if (XIN32) { x32n[q][j][0] = *(gf4c*)(xin32 + o_); x32n[q][j][1] = *(gf4c*)(xin32 + o_ + 4); } else xn[q][j] = *(gv4c*)(xb + o_); } \
        if (!XIN32) rsn[q] = *(gfc*)(rs + (ROW0) + q * NGW); } } while (0)
    RS_LOAD(gw);
    for (int row = gw; row < MTOK; row += 2 * NGW) {
        u32x4_t yc[2][2], xc[2][2]; f32x4_r x32c[2][2][2]; float rsc[2];
#pragma unroll
        for (int q = 0; q < 2; ++q) { rsc[q] = rsn[q];
#pragma unroll
            for (int j = 0; j < 2; ++j) { yc[q][j] = yn[q][j]; if (XIN32) { x32c[q][j][0] = x32n[q][j][0]; x32c[q][j][1] = x32n[q][j][1]; } else xc[q][j] = xn[q][j]; } }
        if (row + 2 * NGW < MTOK) RS_LOAD(row + 2 * NGW);
#pragma unroll
        for (int q = 0; q < 2; ++q) { const int rw = row + q * NGW;
            float v[2][8], xx[2][8]; float s = 0.f;
#pragma unroll
            for (int j = 0; j < 2; ++j) { const u32x4_t t = yc[q][j];
                v[j][0] = __uint_as_float(t.x << 16); v[j][1] = __uint_as_float(t.x & 0xffff0000u); v[j][2] = __uint_as_float(t.y << 16); v[j][3] = __uint_as_float(t.y & 0xffff0000u);
                v[j][4] = __uint_as_float(t.z << 16); v[j][5] = __uint_as_float(t.z & 0xffff0000u); v[j][6] = __uint_as_float(t.w << 16); v[j][7] = __uint_as_float(t.w & 0xffff0000u);
#pragma unroll
                for (int e = 0; e < 8; ++e) s += v[j][e] * v[j][e];
                if (XIN32) {
#pragma unroll
                    for (int e = 0; e < 4; ++e) { xx[j][e] = x32c[q][j][0][e]; xx[j][4 + e] = x32c[q][j][1][e]; }
                } else { const u32x4_t u = xc[q][j]; const float ri = 1.0f / rsc[q];
                    xx[j][0] = __uint_as_float(u.x << 16) * ri; xx[j][1] = __uint_as_float(u.x & 0xffff0000u) * ri; xx[j][2] = __uint_as_float(u.y << 16) * ri; xx[j][3] = __uint_as_float(u.y & 0xffff0000u) * ri;
                    xx[j][4] = __uint_as_float(u.z << 16) * ri; xx[j][5] = __uint_as_float(u.z & 0xffff0000u) * ri; xx[j][6] = __uint_as_float(u.w << 16) * ri; xx[j][7] = __uint_as_float(u.w & 0xffff0000u) * ri; } }
            const float inv = rsqrtf(wave_sum(s) * (1.0f / DM) + NORM_EPS) * scale;
            float s2 = 0.f;
#pragma unroll
            for (int j = 0; j < 2; ++j)
#pragma unroll
                for (int e = 0; e < 8; ++e) { const float gg = g[j][e >> 2][e & 3]; v[j][e] = xx[j][e] + v[j][e] * inv * gg; s2 += v[j][e] * v[j][e]; }
            if (out32) {
#pragma unroll
                for (int j = 0; j < 2; ++j) { const size_t o_ = (size_t)rw * DM + (size_t)(j * 64 + lane) * 8;
                    *(gf4*)(out32 + o_) = (f32x4_r){v[j][0], v[j][1], v[j][2], v[j][3]}; *(gf4*)(out32 + o_ + 4) = (f32x4_r){v[j][4], v[j][5], v[j][6], v[j][7]}; }
            } else {
                const float r = rsqrtf(wave_sum(s2) * (1.0f / DM) + NORM_EPS);
                float amx = 1e-30f;
                if (x8) {
#pragma unroll
                    for (int j = 0; j < 2; ++j)
#pragma unroll
                        for (int e = 0; e < 8; ++e) amx = fmaxf(amx, fabsf(v[j][e]));
#pragma unroll
                    for (int s_ = 1; s_ < 64; s_ <<= 1) amx = fmaxf(amx, __shfl_xor(amx, s_));
                    if (lane == 0) ((float*)(x8 + (size_t)MTOK * DM))[rw] = amx * r * (1.0f / 127.0f); }
#pragma unroll
                for (int j = 0; j < 2; ++j) { u32x4_t o; o.x = pg8::cvt_pk_bf16(v[j][0] * r, v[j][1] * r); o.y = pg8::cvt_pk_bf16(v[j][2] * r, v[j][3] * r); o.z = pg8::cvt_pk_bf16(v[j][4] * r, v[j][5] * r); o.w = pg8::cvt_pk_bf16(v[j][6] * r, v[j][7] * r);
                    *(gv4*)(xb + (size_t)rw * DM + (size_t)(j * 64 + lane) * 8) = o;
                    if (x8) { typedef unsigned u32x2_w __attribute__((ext_vector_type(2))); typedef __attribute__((address_space(1))) u32x2_w gv2w; u32x2_w q8; const float r8 = 127.0f / amx;
#define RS_Q8(X) ((unsigned)min(max(__float2int_rn((X) * r8), -127), 127) & 0xffu)
                        q8.x = RS_Q8(v[j][0]) | (RS_Q8(v[j][1]) << 8) | (RS_Q8(v[j][2]) << 16) | (RS_Q8(v[j][3]) << 24); q8.y = RS_Q8(v[j][4]) | (RS_Q8(v[j][5]) << 8) | (RS_Q8(v[j][6]) << 16) | (RS_Q8(v[j][7]) << 24);
#undef RS_Q8
                        *(gv2w*)(x8 + (size_t)rw * DM + (size_t)(j * 64 + lane) * 8) = q8; } }
                if (lane == 0) rs[rw] = r;
            }
        }
    }
#undef RS_LOAD
}
__device__ __forceinline__ void xinit_stream(const float* __restrict__ x, bf16_t* __restrict__ xb, float* __restrict__ rs, int gw, int NGW, int lane, unsigned char* __restrict__ x8 = nullptr) {
    typedef __attribute__((address_space(1))) u32x4_t gv4;
    typedef float f32x4_r __attribute__((ext_vector_type(4)));
    typedef __attribute__((address_space(1))) const f32x4_r gf4c;
    f32x4_r xn[2][2][2];
#define XI_LOAD(ROW0) do { _Pragma("unroll") for (int q = 0; q < 2; ++q) { const size_t ro_ = (size_t)((ROW0) + q * NGW) * DM; \
        _Pragma("unroll") for (int j = 0; j < 2; ++j) { const size_t o_ = ro_ + (size_t)(j * 64 + lane) * 8; xn[q][j][0] = *(gf4c*)(x + o_); xn[q][j][1] = *(gf4c*)(x + o_ + 4); } } } while (0)
    XI_LOAD(gw);
    for (int row = gw; row < MTOK; row += 2 * NGW) {
        f32x4_r xc[2][2][2];
#pragma unroll
        for (int q = 0; q < 2; ++q)
#pragma unroll
            for (int j = 0; j < 2; ++j) { xc[q][j][0] = xn[q][j][0]; xc[q][j][1] = xn[q][j][1]; }
        if (row + 2 * NGW < MTOK) XI_LOAD(row + 2 * NGW);
#pragma unroll
        for (int q = 0; q < 2; ++q) { const int rw = row + q * NGW; float s = 0.f;
#pragma unroll
            for (int j = 0; j < 2; ++j)
#pragma unroll
                for (int e = 0; e < 4; ++e) s += xc[q][j][0][e] * xc[q][j][0][e] + xc[q][j][1][e] * xc[q][j][1][e];
            const float r = rsqrtf(wave_sum(s) * (1.0f / DM) + NORM_EPS);
            float amx = 1e-30f;
            if (x8) {
#pragma unroll
                for (int j = 0; j < 2; ++j)
#pragma unroll
                    for (int e = 0; e < 4; ++e) amx = fmaxf(amx, fmaxf(fabsf(xc[q][j][0][e]), fabsf(xc[q][j][1][e])));
#pragma unroll
                for (int s_ = 1; s_ < 64; s_ <<= 1) amx = fmaxf(amx, __shfl_xor(amx, s_));
                if (lane == 0) ((float*)(x8 + (size_t)MTOK * DM))[rw] = amx * r * (1.0f / 127.0f); }
#pragma unroll
            for (int j = 0; j < 2; ++j) { u32x4_t o; o.x = pg8::cvt_pk_bf16(xc[q][j][0][0] * r, xc[q][j][0][1] * r); o.y = pg8::cvt_pk_bf16(xc[q][j][0][2] * r, xc[q][j][0][3] * r);
                o.z = pg8::cvt_pk_bf16(xc[q][j][1][0] * r, xc[q][j][1][1] * r); o.w = pg8::cvt_pk_bf16(xc[q][j][1][2] * r, xc[q][j][1][3] * r);
                *(gv4*)(xb + (size_t)rw * DM + (size_t)(j * 64 + lane) * 8) = o;
                if (x8) { typedef unsigned u32x2_w __attribute__((ext_vector_type(2))); typedef __attribute__((address_space(1))) u32x2_w gv2w; u32x2_w q8; const float r8 = 127.0f / amx;
#define XI_Q8(X) ((unsigned)min(max(__float2int_rn((X) * r8), -127), 127) & 0xffu)
                    q8.x = XI_Q8(xc[q][j][0][0]) | (XI_Q8(xc[q][j][0][1]) << 8) | (XI_Q8(xc[q][j][0][2]) << 16) | (XI_Q8(xc[q][j][0][3]) << 24);
                    q8.y = XI_Q8(xc[q][j][1][0]) | (XI_Q8(xc[q][j][1][1]) << 8) | (XI_Q8(xc[q][j][1][2]) << 16) | (XI_Q8(xc[q][j][1][3]) << 24);
#undef XI_Q8
                    *(gv2w*)(x8 + (size_t)rw * DM + (size_t)(j * 64 + lane) * 8) = q8; } }
            if (lane == 0) rs[rw] = r; }
    }
#undef XI_LOAD
}
__device__ __forceinline__ void mla_prep_stream(const bf16_t* __restrict__ Z, const float* __restrict__ gq, const float* __restrict__ gkv, const float* __restrict__ RC, const float* __restrict__ RS,
                                                bf16_t* __restrict__ QN, bf16_t* __restrict__ KVN, bf16_t* __restrict__ KR, int gw, int NGW, int lane) {
    asm volatile("" : "+v"(lane));
    typedef __attribute__((address_space(1))) const u32x4_t gv4c;
    typedef __attribute__((address_space(1))) u32x4_t gv4;
    typedef __attribute__((address_space(1))) const unsigned short gu16c;
    typedef __attribute__((address_space(1))) const float gfc;
    const bool hq = lane < 48, hk = lane < 32; const int lq = hq ? lane : 0, lk = hk ? lane : 0, l16 = lane & 15;
    const float4 gq0 = ((const float4*)gq)[lq * 2], gq1 = ((const float4*)gq)[lq * 2 + 1], gk0 = ((const float4*)gkv)[lk * 2], gk1 = ((const float4*)gkv)[lk * 2 + 1];
    u32x4_t wqn[4], wkn[4]; unsigned short x1n[4], x2n[4]; float csn[4], snn[4];
#define MP_LOAD(ROW0) do { _Pragma("unroll") for (int r = 0; r < 4; ++r) { const int row_ = (ROW0) + r * NGW; const bf16_t* z = Z + (size_t)row_ * ZW; const int pos = row_ & (SEQ - 1); \
        wqn[r] = *(gv4c*)(z + Z_MQ + lq * 8); wkn[r] = *(gv4c*)(z + Z_MKV + lk * 8); x1n[r] = *(gu16c*)(z + Z_MKR + l16); x2n[r] = *(gu16c*)(z + Z_MKR + 16 + l16); \
        csn[r] = *(gfc*)(RC + pos * 16 + l16); snn[r] = *(gfc*)(RS + pos * 16 + l16); } } while (0)
    MP_LOAD(gw);
    for (int row0 = gw; row0 < MTOK; row0 += 4 * NGW) {
        u32x4_t wq[4], wk[4]; float x1[4], x2[4], cs[4], sn[4];
#pragma unroll
        for (int r = 0; r < 4; ++r) { wq[r] = wqn[r]; wk[r] = wkn[r]; x1[r] = bf2f((bf16_t)x1n[r]); x2[r] = bf2f((bf16_t)x2n[r]); cs[r] = csn[r]; sn[r] = snn[r]; }
        if (row0 + 4 * NGW < MTOK) MP_LOAD(row0 + 4 * NGW);
#pragma unroll
        for (int r = 0; r < 4; ++r) { const int row = row0 + r * NGW;
            if (!hq) wq[r] = (u32x4_t){0u, 0u, 0u, 0u};
            if (!hk) wk[r] = (u32x4_t){0u, 0u, 0u, 0u};
            float q[8] = {bflo(wq[r].x), bfhi(wq[r].x), bflo(wq[r].y), bfhi(wq[r].y), bflo(wq[r].z), bfhi(wq[r].z), bflo(wq[r].w), bfhi(wq[r].w)};
            float kv[8] = {bflo(wk[r].x), bfhi(wk[r].x), bflo(wk[r].y), bfhi(wk[r].y), bflo(wk[r].z), bfhi(wk[r].z), bflo(wk[r].w), bfhi(wk[r].w)};
            float sq = 0.f, sk = 0.f;
#pragma unroll
            for (int e = 0; e < 8; ++e) { sq += q[e] * q[e]; sk += kv[e] * kv[e]; }
            const float invq = rsqrtf(wave_sum(sq) * (1.0f / 384.0f) + NORM_EPS), invk = rsqrtf(wave_sum(sk) * (1.0f / 256.0f) + NORM_EPS);
            if (hq) { u32x4_t w;
                w.x = pg8::cvt_pk_bf16(q[0] * invq * gq0.x, q[1] * invq * gq0.y); w.y = pg8::cvt_pk_bf16(q[2] * invq * gq0.z, q[3] * invq * gq0.w);
                w.z = pg8::cvt_pk_bf16(q[4] * invq * gq1.x, q[5] * invq * gq1.y); w.w = pg8::cvt_pk_bf16(q[6] * invq * gq1.z, q[7] * invq * gq1.w);
                *(gv4*)(QN + (size_t)row * 384 + lane * 8) = w; }
            if (hk) { u32x4_t w;
                w.x = pg8::cvt_pk_bf16(kv[0] * invk * gk0.x, kv[1] * invk * gk0.y); w.y = pg8::cvt_pk_bf16(kv[2] * invk * gk0.z, kv[3] * invk * gk0.w);
                w.z = pg8::cvt_pk_bf16(kv[4] * invk * gk1.x, kv[5] * invk * gk1.y); w.w = pg8::cvt_pk_bf16(kv[6] * invk * gk1.z, kv[7] * invk * gk1.w);
                *(gv4*)(KVN + (size_t)row * 256 + lane * 8) = w; }
            if (lane < 16) { KR[(size_t)row * 32 + lane] = f2bf(x1[r] * cs[r] - x2[r] * sn[r]); KR[(size_t)row * 32 + 16 + lane] = f2bf(x1[r] * sn[r] + x2[r] * cs[r]); } }
    }
#undef MP_LOAD
}

typedef short bf16x8_t __attribute__((ext_vector_type(8)));
typedef float f32x16_t __attribute__((ext_vector_type(16)));
typedef short v4i16_t __attribute__((ext_vector_type(4)));
constexpr int AT_LUT = 0, AT_K0 = 16384, AT_KB = 64 * 104 * 2, AT_V0 = AT_K0 + 2 * AT_KB, AT_VP = 96, AT_VB = 64 * AT_VP * 2, AT_MISC = AT_V0 + 2 * AT_VB;
static_assert(AT_MISC + 64 <= RING_BYTES, "attention LDS map");
constexpr float LOG2E = 1.4426950408889634f;
#define MAX_DEFER 6.0f
#define MFMA32(a, b, c) __builtin_amdgcn_mfma_f32_32x32x16_bf16((a), (b), (c), 0, 0, 0)
__device__ __forceinline__ float swap_max(float x) { auto rr = __builtin_amdgcn_permlane32_swap(__float_as_uint(x), __float_as_uint(x), false, false); return fmaxf(__uint_as_float(rr[0]), __uint_as_float(rr[1])); }
__device__ __forceinline__ float swap_sum(float x) { auto rr = __builtin_amdgcn_permlane32_swap(__float_as_uint(x), __float_as_uint(x), false, false); return __uint_as_float(rr[0]) + __uint_as_float(rr[1]); }
__device__ __forceinline__ bf16x8_t pack8(const f32x16_t& p, int base) {
    u32x4_t w; w.x = pg8::cvt_pk_bf16(p[base + 0], p[base + 1]); w.y = pg8::cvt_pk_bf16(p[base + 2], p[base + 3]); w.z = pg8::cvt_pk_bf16(p[base + 4], p[base + 5]); w.w = pg8::cvt_pk_bf16(p[base + 6], p[base + 7]);
    return __builtin_bit_cast(bf16x8_t, w);
}
__device__ __forceinline__ v4i16_t tr_read(LAS const unsigned char* p) { return __builtin_amdgcn_ds_read_tr16_b64_v4i16((LAS v4i16_t*)p); }

#define GAS __attribute__((address_space(1)))
#define WG_BAR_LDS() asm volatile("s_waitcnt lgkmcnt(0)\n\ts_barrier" ::: "memory")
__device__ __forceinline__ u32x4_t gload16(const void* p) { return *(const GAS u32x4_t*)p; }
template <int DQK, int MODE>
__device__ __forceinline__ void attn_s1(LAS const unsigned char* Kl, LAS const float* lut, const bf16x8_t (&qf)[DQK / 16], f32x16_t (&o)[2], float& m, f32x16_t& lacc,
                                        int qpos, int kbase, bool flag, int kind, float c2, float cb, int lane, bf16x8_t (&pf)[4]) {
    constexpr int KP = DQK + 8, ND = DQK / 16;
    const int r32 = lane & 31, hi = lane >> 5;
    f32x16_t p0, p1;
#pragma unroll
    for (int r = 0; r < 16; ++r) { p0[r] = 0.f; p1[r] = 0.f; }
    { LAS const unsigned char* kp = Kl + (r32 * KP + 8 * hi) * 2;
      bf16x8_t kf[2 * ND];
#pragma unroll
      for (int d0 = 0; d0 < ND; ++d0) kf[d0] = *(LAS const bf16x8_t*)(kp + d0 * 32);
#pragma unroll
      for (int d0 = 0; d0 < ND; ++d0) kf[ND + d0] = *(LAS const bf16x8_t*)(kp + d0 * 32 + 32 * KP * 2);
      __builtin_amdgcn_sched_barrier(0);
#pragma unroll
      for (int d0 = 0; d0 < ND; ++d0) p0 = MFMA32(kf[d0], qf[d0], p0);
#pragma unroll
      for (int d0 = 0; d0 < ND; ++d0) p1 = MFMA32(kf[ND + d0], qf[d0], p1);
    }
    constexpr int KS = (MODE == 4) ? 16 : 1;
    const int d00 = qpos - (MODE == 4 ? 31 : 0) - KS * (kbase + 4 * hi);
    float alpha;
    if (MODE != 3 && (kind & 2)) {
        if (MODE == 1 || MODE == 2) {
            typedef float f32x2_l __attribute__((ext_vector_type(2)));
            LAS const float* lp = lut + kbase;
#pragma unroll
            for (int g4 = 0; g4 < 4; ++g4) {
                const f32x2_l a0 = *(LAS const f32x2_l*)(lp + 8 * g4), b0 = *(LAS const f32x2_l*)(lp + 8 * g4 + 2), a1 = *(LAS const f32x2_l*)(lp + 32 + 8 * g4), b1 = *(LAS const f32x2_l*)(lp + 32 + 8 * g4 + 2);
                p0[4 * g4] = fmaf(p0[4 * g4], c2, a0.x); p0[4 * g4 + 1] = fmaf(p0[4 * g4 + 1], c2, a0.y); p0[4 * g4 + 2] = fmaf(p0[4 * g4 + 2], c2, b0.x); p0[4 * g4 + 3] = fmaf(p0[4 * g4 + 3], c2, b0.y);
                p1[4 * g4] = fmaf(p1[4 * g4], c2, a1.x); p1[4 * g4 + 1] = fmaf(p1[4 * g4 + 1], c2, a1.y); p1[4 * g4 + 2] = fmaf(p1[4 * g4 + 2], c2, b1.x); p1[4 * g4 + 3] = fmaf(p1[4 * g4 + 3], c2, b1.y); }
        } else {
#pragma unroll
        for (int r = 0; r < 16; ++r) { const int dist0 = d00 - KS * ((r & 3) + 8 * (r >> 2)), dist1 = dist0 - 32 * KS;
            p0[r] = fmaf(p0[r], c2, lut[min(max(dist0, 0), 1023)]); p1[r] = fmaf(p1[r], c2, lut[min(max(dist1, 0), 1023)]); }
        }
        if (kind & 1) {
#pragma unroll
            for (int r = 0; r < 16; ++r) { const int dist0 = d00 - KS * ((r & 3) + 8 * (r >> 2)), dist1 = dist0 - 32 * KS;
                bool k0, k1;
                if (MODE == 0) { k0 = (unsigned)dist0 < 128u; k1 = (unsigned)dist1 < 128u; }
                else if (MODE == 1) { k0 = (unsigned)dist0 < 512u; k1 = (unsigned)dist1 < 512u; }
                else { k0 = dist0 >= 0; k1 = dist1 >= 0; }
                p0[r] = k0 ? p0[r] : -INFINITY; p1[r] = k1 ? p1[r] : -INFINITY; }
        }
        float mx = -INFINITY;
#pragma unroll
        for (int r = 0; r < 16; ++r) mx = fmaxf(mx, fmaxf(p0[r], p1[r]));
        if (MODE == 2) mx = flag ? mx : -INFINITY;
        mx = swap_max(mx);
        const float mn = (mx > m + MAX_DEFER) ? mx : m, mne = (MODE == 2) ? (flag ? mn : INFINITY) : mn;
        alpha = __builtin_amdgcn_exp2f(m - mn); m = mn;
#pragma unroll
        for (int r = 0; r < 16; ++r) { p0[r] = __builtin_amdgcn_exp2f(p0[r] - mne); p1[r] = __builtin_amdgcn_exp2f(p1[r] - mne); }
    } else {
        if (kind & 1) {
#pragma unroll
            for (int r = 0; r < 16; ++r) { const int dist0 = d00 - KS * ((r & 3) + 8 * (r >> 2)), dist1 = dist0 - 32 * KS;
                p0[r] = dist0 >= 0 ? p0[r] : -INFINITY; p1[r] = dist1 >= 0 ? p1[r] : -INFINITY; }
        }
        float mx;
        { float pinf = INFINITY; asm volatile("" : "+s"(pinf));
          float q0 = __builtin_amdgcn_fmed3f(p0[0], p1[0], pinf), q1 = __builtin_amdgcn_fmed3f(p0[1], p1[1], pinf), q2 = __builtin_amdgcn_fmed3f(p0[2], p1[2], pinf), q3 = __builtin_amdgcn_fmed3f(p0[3], p1[3], pinf);
#pragma unroll
          for (int r = 4; r < 16; r += 4) { q0 = __builtin_amdgcn_fmed3f(q0, __builtin_amdgcn_fmed3f(p0[r], p1[r], pinf), pinf); q1 = __builtin_amdgcn_fmed3f(q1, __builtin_amdgcn_fmed3f(p0[r + 1], p1[r + 1], pinf), pinf);
              q2 = __builtin_amdgcn_fmed3f(q2, __builtin_amdgcn_fmed3f(p0[r + 2], p1[r + 2], pinf), pinf); q3 = __builtin_amdgcn_fmed3f(q3, __builtin_amdgcn_fmed3f(p0[r + 3], p1[r + 3], pinf), pinf); }
          mx = __builtin_amdgcn_fmed3f(__builtin_amdgcn_fmed3f(q0, q1, pinf), __builtin_amdgcn_fmed3f(q2, q3, pinf), pinf); }
        mx = fmaf(mx, c2, cb);
        if (MODE == 2) mx = flag ? mx : -INFINITY;
        mx = swap_max(mx);
        const float mn = (mx > m + MAX_DEFER) ? mx : m, sub = (MODE == 2) ? (flag ? cb - mn : -INFINITY) : cb - mn;
        alpha = __builtin_amdgcn_exp2f(m - mn); m = mn;
#pragma unroll
        for (int r = 0; r < 16; ++r) { p0[r] = __builtin_amdgcn_exp2f(fmaf(p0[r], c2, sub)); p1[r] = __builtin_amdgcn_exp2f(fmaf(p1[r], c2, sub)); }
    }
    if (__any(alpha != 1.0f)) {
#pragma unroll
        for (int r = 0; r < 16; ++r) { o[0][r] *= alpha; o[1][r] *= alpha; }
        lacc[0] *= alpha;
    }
    pf[0] = pack8(p0, 0); pf[1] = pack8(p0, 8); pf[2] = pack8(p1, 0); pf[3] = pack8(p1, 8);
}
__device__ __forceinline__ void attn_s2(LAS const unsigned char* Vl, const bf16x8_t (&pf)[4], f32x16_t (&o)[2], f32x16_t& lacc, int lane) {
    const int hi = lane >> 5, i16 = lane & 15, blk = (lane >> 4) & 1;
    LAS const unsigned char* vp = Vl + ((4 * hi + (i16 >> 2)) * AT_VP + 16 * blk) * 2 + 8 * (i16 & 3);
    bf16x8_t vf[4], vg2[4];
#pragma unroll
    for (int s = 0; s < 2; ++s)
#pragma unroll
        for (int db = 0; db < 2; ++db) { const v4i16_t lo = tr_read(vp + (16 * s) * AT_VP * 2 + db * 64), hh = tr_read(vp + (16 * s + 8) * AT_VP * 2 + db * 64);
            vf[2 * s + db] = __builtin_shufflevector(lo, hh, 0, 1, 2, 3, 4, 5, 6, 7); }
#pragma unroll
    for (int s = 2; s < 4; ++s)
#pragma unroll
        for (int db = 0; db < 2; ++db) { const v4i16_t lo = tr_read(vp + (16 * s) * AT_VP * 2 + db * 64), hh = tr_read(vp + (16 * s + 8) * AT_VP * 2 + db * 64);
            vg2[2 * (s - 2) + db] = __builtin_shufflevector(lo, hh, 0, 1, 2, 3, 4, 5, 6, 7); }
    __builtin_amdgcn_sched_barrier(0);
#pragma unroll
    for (int s = 0; s < 2; ++s)
#pragma unroll
        for (int db = 0; db < 2; ++db) o[db] = MFMA32(vf[2 * s + db], pf[s], o[db]);
#pragma unroll
    for (int s = 2; s < 4; ++s)
#pragma unroll
        for (int db = 0; db < 2; ++db) o[db] = MFMA32(vg2[2 * (s - 2) + db], pf[s], o[db]);
    { const bf16x8_t ones = {0x3f80, 0x3f80, 0x3f80, 0x3f80, 0x3f80, 0x3f80, 0x3f80, 0x3f80};
#pragma unroll
      for (int s = 0; s < 4; ++s) lacc = MFMA32(ones, pf[s], lacc); }
}
template <int DQK, int MODE>
__device__ __forceinline__ void attn_tile(LAS const unsigned char* Kl, LAS const unsigned char* Vl, LAS const float* lut, const bf16x8_t (&qf)[DQK / 16], f32x16_t (&o)[2], float& m, f32x16_t& lacc,
                                          int qpos, int kbase, bool flag, int kind, float c2, float cb, int lane) {
    bf16x8_t pf[4];
    attn_s1<DQK, MODE>(Kl, lut, qf, o, m, lacc, qpos, kbase, flag, kind, c2, cb, lane, pf);
    attn_s2(Vl, pf, o, lacc, lane);
}

template <int MODE>
__device__ __forceinline__ void gqa_pass(LAS unsigned char* lds, const bf16_t* __restrict__ Zb_, int kcol, int vcol, unsigned long long tmask, const bf16x8_t (&qf)[4], int qpos, unsigned long long selmask,
                                         LAS const float* lut, float c31, f32x16_t (&o)[2], float& m, f32x16_t& lacc, int tid, int lane) {
    constexpr int KP = 72;
    const int srow = tid >> 3, sch = tid & 7, q0w = __builtin_amdgcn_readfirstlane(qpos - (lane & 31));
    const bf16_t* kg = Zb_ + (size_t)srow * ZW + kcol + sch * 8; const bf16_t* vg = Zb_ + (size_t)srow * ZW + vcol + sch * 8;
    LAS unsigned char* kdst = lds + AT_K0 + (srow * KP + sch * 8) * 2; LAS unsigned char* vdst = lds + AT_V0 + (srow * AT_VP + sch * 8) * 2;
    int j = __builtin_ctzll(tmask);
    { const u32x4_t k0 = gload16(kg + (size_t)j * 64 * ZW), v0 = gload16(vg + (size_t)j * 64 * ZW); *(LAS u32x4_t*)kdst = k0; *(LAS u32x4_t*)vdst = v0; }
    WG_BAR_LDS();
    int buf = 0;
    for (;;) {
        tmask &= tmask - 1; const bool has_next = tmask != 0ull; const int jn = has_next ? __builtin_ctzll(tmask) : 0;
        u32x4_t kr, vr;
        if (has_next) { kr = gload16(kg + (size_t)jn * 64 * ZW); vr = gload16(vg + (size_t)jn * 64 * ZW); }
        { const int dmin = q0w - 64 * j - 63, dmax = q0w + 31 - 64 * j;
          int kind; bool fl = true;
          if (MODE == 2) { fl = (selmask >> j) & 1ull; kind = (dmin >= 790 ? 0 : 2) | (dmin >= 0 ? 0 : 1); }
          else { constexpr int W = MODE == 0 ? 128 : 512; kind = 2 | ((dmin >= 0 && dmax < W) ? 0 : 1); }
          attn_tile<64, MODE>(lds + AT_K0 + buf * AT_KB, lds + AT_V0 + buf * AT_VB, lut, qf, o, m, lacc, qpos, j * 64, fl, kind, 0.125f * LOG2E, c31, lane); }
        if (!has_next) break;
        *(LAS u32x4_t*)(kdst + (buf ^ 1) * AT_KB) = kr; *(LAS u32x4_t*)(vdst + (buf ^ 1) * AT_VB) = vr;
        WG_BAR_LDS();
        buf ^= 1; j = jn;
    }
    __syncthreads();
}
__device__ __forceinline__ void fill_lut(LAS unsigned char* lds, const float* __restrict__ L1G, int head0, int tid) {
    typedef __attribute__((address_space(1))) const u32x4_t gv4c;
    gv4c* src = (gv4c*)(L1G + (head0 >> 2) * 4096);
    const u32x4_t a0 = src[tid], a1 = src[512 + tid];
    ((LAS u32x4_t*)(lds + AT_LUT))[tid] = a0; ((LAS u32x4_t*)(lds + AT_LUT))[512 + tid] = a1;
}
__device__ __forceinline__ void swa_wg_unit(LAS unsigned char* lds, const bf16_t* __restrict__ Z, const float* __restrict__ BD, const float* __restrict__ sinks, bf16_t* __restrict__ OB, int b, int hkv, int ch, int wave, int lane) {
    asm volatile("" : "+v"(lane));
    const int tid = wave * 64 + lane, r32 = lane & 31, hi = lane >> 5, g = wave >> 1, h = hkv * 4 + g, t0 = ch * 64, qpos = t0 + (wave & 1) * 32 + r32;
    const bf16_t* Zb_ = Z + (size_t)b * SEQ * ZW;
    bf16x8_t qf[4];
#pragma unroll
    for (int d0 = 0; d0 < 4; ++d0) qf[d0] = *(const bf16x8_t*)(Zb_ + (size_t)qpos * ZW + Z_SQ + h * 64 + 16 * d0 + 8 * hi);
    f32x16_t o[2];
#pragma unroll
    for (int r = 0; r < 16; ++r) { o[0][r] = 0.f; o[1][r] = 0.f; }
    float m = -1e30f; f32x16_t lacc;
#pragma unroll
    for (int r = 0; r < 16; ++r) lacc[r] = 0.f;
    const int jlo = ch - 2 > 0 ? ch - 2 : 0;
    const unsigned long long tmask = ((ch == 63 ? ~0ull : ((1ull << (ch + 1)) - 1ull))) & ~((1ull << jlo) - 1ull);
    __syncthreads();
    gqa_pass<0>(lds, Zb_, Z_SK + hkv * 64, Z_SV + hkv * 64, tmask, qf, qpos, 0ull, (LAS const float*)(lds + AT_LUT) + g * 1024, 0.f, o, m, lacc, tid, lane);
    const float lt = lacc[0], sk = sinks[h] * LOG2E, mf = fmaxf(m, sk), c = __builtin_amdgcn_exp2f(m - mf), f = c / (lt * c + __builtin_amdgcn_exp2f(sk - mf));
    bf16_t* orow = OB + (size_t)(b * SEQ + qpos) * 512 + h * 64;
#pragma unroll
    for (int db = 0; db < 2; ++db)
#pragma unroll
        for (int g4 = 0; g4 < 4; ++g4) { uint2 w; w.x = pg8::cvt_pk_bf16(o[db][4 * g4] * f, o[db][4 * g4 + 1] * f); w.y = pg8::cvt_pk_bf16(o[db][4 * g4 + 2] * f, o[db][4 * g4 + 3] * f);
            *(uint2*)(orow + 32 * db + 8 * g4 + 4 * hi) = w; }
}
__device__ __forceinline__ void mla_wg_unit(LAS unsigned char* lds, const bf16_t* __restrict__ MQ, const bf16_t* __restrict__ MKV, const bf16_t* __restrict__ KRb, const float* __restrict__ RC, const float* __restrict__ RS,
                                            bf16_t* __restrict__ OC, int b, int h, int qc, int wave, int lane) {
    asm volatile("" : "+v"(lane));
    constexpr int KP = 104;
    const int tid = wave * 64 + lane, r32 = lane & 31, hi = lane >> 5, t0 = qc * 256, qpos = t0 + wave * 32 + r32;
    const size_t rowq = (size_t)(b * SEQ + qpos);
    bf16x8_t qf[6];
#pragma unroll
    for (int d0 = 0; d0 < 4; ++d0) qf[d0] = *(const bf16x8_t*)(MQ + rowq * 768 + h * 96 + 16 * d0 + 8 * hi);
    { const bf16x8_t x1 = *(const bf16x8_t*)(MQ + rowq * 768 + h * 96 + 64 + 8 * hi), x2 = *(const bf16x8_t*)(MQ + rowq * 768 + h * 96 + 80 + 8 * hi);
      float a[8], c[8];
#pragma unroll
      for (int e = 0; e < 8; ++e) { const float v1 = bf2f((bf16_t)x1[e]), v2 = bf2f((bf16_t)x2[e]); const float cs = RC[qpos * 16 + 8 * hi + e], sn = RS[qpos * 16 + 8 * hi + e]; a[e] = v1 * cs - v2 * sn; c[e] = v1 * sn + v2 * cs; }
      u32x4_t w; w.x = pg8::cvt_pk_bf16(a[0], a[1]); w.y = pg8::cvt_pk_bf16(a[2], a[3]); w.z = pg8::cvt_pk_bf16(a[4], a[5]); w.w = pg8::cvt_pk_bf16(a[6], a[7]); qf[4] = __builtin_bit_cast(bf16x8_t, w);
      w.x = pg8::cvt_pk_bf16(c[0], c[1]); w.y = pg8::cvt_pk_bf16(c[2], c[3]); w.z = pg8::cvt_pk_bf16(c[4], c[5]); w.w = pg8::cvt_pk_bf16(c[6], c[7]); qf[5] = __builtin_bit_cast(bf16x8_t, w); }
    f32x16_t o[2];
#pragma unroll
    for (int r = 0; r < 16; ++r) { o[0][r] = 0.f; o[1][r] = 0.f; }
    float m = -1e30f; f32x16_t lacc;
#pragma unroll
    for (int r = 0; r < 16; ++r) lacc[r] = 0.f;
    const int srow = tid >> 3, sch = tid & 7, rrow = (tid & 255) >> 2, rch = tid & 3;
    const bf16_t* kg = MKV + (size_t)(b * SEQ + srow) * 1024 + h * 128 + sch * 8; const bf16_t* rg = KRb + (size_t)(b * SEQ + rrow) * 32 + rch * 8;
    LAS unsigned char* kdst = lds + AT_K0 + (srow * KP + sch * 8) * 2; LAS unsigned char* vdst = lds + AT_V0 + (srow * AT_VP + sch * 8) * 2; LAS unsigned char* rdst = lds + AT_K0 + (rrow * KP + 64 + rch * 8) * 2;
    const int nt = 4 * qc + 4, jmine = 4 * qc + (wave >> 1);
    { const u32x4_t k0 = gload16(kg), v0 = gload16(kg + 64), r0 = gload16(rg); *(LAS u32x4_t*)kdst = k0; *(LAS u32x4_t*)vdst = v0; if (tid < 256) *(LAS u32x4_t*)rdst = r0; }
    WG_BAR_LDS();
    const float c2 = 0.10206207261596577f * LOG2E;
    for (int j = 0; j < nt; ++j) { const int buf = j & 1; const bool has_next = j + 1 < nt;
        u32x4_t kr, vr, rr;
        if (has_next) { kr = gload16(kg + (size_t)(j + 1) * 64 * 1024); vr = gload16(kg + (size_t)(j + 1) * 64 * 1024 + 64); rr = gload16(rg + (size_t)(j + 1) * 64 * 32); }
        if (j <= jmine) attn_tile<96, 3>(lds + AT_K0 + buf * AT_KB, lds + AT_V0 + buf * AT_VB, nullptr, qf, o, m, lacc, qpos, j * 64, true, j == jmine ? 1 : 0, c2, 0.f, lane);
        if (has_next) { *(LAS u32x4_t*)(kdst + (buf ^ 1) * AT_KB) = kr; *(LAS u32x4_t*)(vdst + (buf ^ 1) * AT_VB) = vr; if (tid < 256) *(LAS u32x4_t*)(rdst + (buf ^ 1) * AT_KB) = rr; }
        WG_BAR_LDS();
    }
    const float f = 1.0f / lacc[0];
    bf16_t* orow = OC + rowq * 512 + h * 64;
#pragma unroll
    for (int db = 0; db < 2; ++db)
#pragma unroll
        for (int g4 = 0; g4 < 4; ++g4) { uint2 w; w.x = pg8::cvt_pk_bf16(o[db][4 * g4] * f, o[db][4 * g4 + 1] * f); w.y = pg8::cvt_pk_bf16(o[db][4 * g4 + 2] * f, o[db][4 * g4 + 3] * f);
            *(uint2*)(orow + 32 * db + 8 * g4 + 4 * hi) = w; }
}

typedef float f32x4_t __attribute__((ext_vector_type(4)));
__device__ __forceinline__ float gelu_tanh_fast(float x) { const float u = 1.5957691216057308f * (x + 0.044715f * x * x * x); return x * __builtin_amdgcn_rcpf(1.0f + __expf(-u)); }
constexpr int CP_HID = 0, CP_Z = 16384, CP_ZG = 33 * 144;
__device__ __forceinline__ void compress_wg_unit(LAS unsigned char* lds, const bf16_t* __restrict__ Z, const bf16_t* __restrict__ W1F, const bf16_t* __restrict__ W2t, const float* __restrict__ cpe, bf16_t* __restrict__ out,
                                                 int b, int hkv, int col, int ct, int wave, int lane) {
    asm volatile("" : "+v"(lane));
    const int r32 = lane & 31, hi = lane >> 5, c = 32 * ct + r32, tid = wave * 64 + lane;
    LAS int* hidT = (LAS int*)(lds + CP_HID);
    for (int i = tid; i < 128 * 32; i += 512) hidT[i] = 0;
    {
      const bf16_t* zsrc = Z + (size_t)(b * SEQ) * ZW + col; u32x4_t zz[9];
#pragma unroll
      for (int it = 0; it < 9; ++it) { const int i = it * 512 + tid, row = (i < 528 * 8 ? i : 0) >> 3, c8 = i & 7; int tok = 512 * ct + row; tok = tok < SEQ ? tok : SEQ - 1; zz[it] = gload16(zsrc + (size_t)tok * ZW + c8 * 8); }
#pragma unroll
      for (int it = 0; it < 9; ++it) { const int i = it * 512 + tid, row = i >> 3, c8 = i & 7; if (i < 528 * 8) *(LAS u32x4_t*)(lds + CP_Z + (row & 15) * CP_ZG + (row >> 4) * 144 + c8 * 16) = zz[it]; } }
    f32x16_t acc[4];
#pragma unroll
    for (int nt = 0; nt < 4; ++nt)
#pragma unroll
        for (int r = 0; r < 16; ++r) acc[nt][r] = 0.f;
    __syncthreads();
    typedef __attribute__((address_space(1))) const bf16x8_t gb8;
    gb8* wf = (gb8*)W1F + lane;
#pragma unroll 4
    for (int k_ = 0; k_ < 16; ++k_) { const int ks = wave * 16 + k_, lrow = ks >> 2;
        const int row = 16 * r32 + lrow;
        const bf16x8_t fb = *(LAS const bf16x8_t*)(lds + CP_Z + (row & 15) * CP_ZG + (row >> 4) * 144 + (16 * (ks & 3) + 8 * hi) * 2);
#pragma unroll
        for (int nt = 0; nt < 4; ++nt) { const bf16x8_t wa = wf[(ks * 4 + nt) * 64]; acc[nt] = MFMA32(wa, fb, acc[nt]); }
    }
#pragma unroll
    for (int nt = 0; nt < 4; ++nt)
#pragma unroll
        for (int r = 0; r < 16; ++r) (void)__hip_atomic_fetch_add(hidT + (32 * nt + (r & 3) + 8 * (r >> 2) + 4 * hi) * 32 + r32, __float2int_rn(acc[nt][r] * 1048576.0f), __ATOMIC_RELAXED, __HIP_MEMORY_SCOPE_WORKGROUP);
    __syncthreads();
    if (wave == 0) {
        typedef __attribute__((address_space(1))) const f32x4_t gf4; typedef __attribute__((address_space(1))) const v4i16_t gv4s;
        f32x4_t cb[4][4]; v4i16_t w2l[4][2][2], w2h[4][2][2];
#pragma unroll
        for (int nt = 0; nt < 4; ++nt) {
#pragma unroll
            for (int g4 = 0; g4 < 4; ++g4) cb[nt][g4] = *(gf4*)(cpe + 32 * nt + 8 * g4 + 4 * hi);
#pragma unroll
            for (int s = 0; s < 2; ++s)
#pragma unroll
                for (int et = 0; et < 2; ++et) { const bf16_t* w2p = W2t + (size_t)(32 * et + r32) * 128 + 32 * nt + 16 * s + 4 * hi; w2l[nt][s][et] = *(gv4s*)w2p; w2h[nt][s][et] = *(gv4s*)(w2p + 8); } }
        f32x16_t o2[2];
#pragma unroll
        for (int r = 0; r < 16; ++r) { o2[0][r] = 0.f; o2[1][r] = 0.f; }
#pragma unroll
        for (int nt = 0; nt < 4; ++nt) {
#pragma unroll
            for (int r = 0; r < 16; ++r) { const int n = 32 * nt + (r & 3) + 8 * (r >> 2) + 4 * hi; acc[nt][r] = gelu_tanh_fast((float)hidT[n * 32 + r32] * (1.0f / 1048576.0f) + cb[nt][r >> 2][r & 3]); }
#pragma unroll
            for (int s = 0; s < 2; ++s) { const bf16x8_t pf = pack8(acc[nt], 8 * s);
#pragma unroll
                for (int et = 0; et < 2; ++et) { const bf16x8_t wa = __builtin_shufflevector(w2l[nt][s][et], w2h[nt][s][et], 0, 1, 2, 3, 4, 5, 6, 7);
                    o2[et] = MFMA32(wa, pf, o2[et]); } }
        }
        bf16_t* orow = out + ((size_t)(b * 2 + hkv) * 256 + c) * 64;
        const bool pad = c >= NCMP;
#pragma unroll
        for (int et = 0; et < 2; ++et)
#pragma unroll
            for (int g4 = 0; g4 < 4; ++g4) { uint2 w; w.x = pg8::cvt_pk_bf16(o2[et][4 * g4], o2[et][4 * g4 + 1]); w.y = pg8::cvt_pk_bf16(o2[et][4 * g4 + 2], o2[et][4 * g4 + 3]);
                if (pad) { w.x = 0u; w.y = 0u; } *(uint2*)(orow + 32 * et + 8 * g4 + 4 * hi) = w; }
    }
    __syncthreads();
}
__device__ __forceinline__ void cpe_item(const float* __restrict__ pe, const float* __restrict__ w1, float* __restrict__ cpe, int n, int lane) {
    float s = 0.f;
#pragma unroll 8
    for (int i = lane; i < 2048; i += 64) s += pe[i] * w1[i * 128 + n];
    s = wave_sum(s);
    if (lane == 0) cpe[n] = s;
}

constexpr int NS_CK = 16384, NS_CV = NS_CK + 256 * 72 * 2, NS_IMP = NS_CV + 256 * AT_VP * 2, NS_MASK = NS_IMP + 64 * 65 * 4, NS_END = NS_MASK + 64 * 8;
constexpr int NS_L2 = AT_MISC + 64, NS_L2N = 1028;
static_assert(NS_CV == 53248 && NS_IMP == 102400 && NS_END <= RING_BYTES && NS_L2 % 8 == 0 && NS_L2 + 4 * 2 * NS_L2N * 4 <= NS_IMP, "NSA LDS map");

__device__ __forceinline__ void cmp_imp_tile(LAS const unsigned char* Kl, LAS const float* lut, const bf16x8_t (&qf)[4], float m, float rl, int qpos, int T, LAS unsigned* imp_row, int lane) {
    constexpr int KP = 72;
    const int r32 = lane & 31, hi = lane >> 5;
    f32x16_t p0, p1;
#pragma unroll
    for (int r = 0; r < 16; ++r) { p0[r] = 0.f; p1[r] = 0.f; }
    LAS const unsigned char* kp = Kl + (r32 * KP + 8 * hi) * 2;
#pragma unroll
    for (int d0 = 0; d0 < 4; ++d0) { const bf16x8_t k0 = *(LAS const bf16x8_t*)(kp + d0 * 32), k1 = *(LAS const bf16x8_t*)(kp + d0 * 32 + 32 * KP * 2); p0 = MFMA32(k0, qf[d0], p0); p1 = MFMA32(k1, qf[d0], p1); }
    const int d00 = qpos - 31 - 16 * (64 * T + 4 * hi);
#pragma unroll
    for (int r = 0; r < 16; ++r) { const int dist0 = d00 - 16 * ((r & 3) + 8 * (r >> 2)), dist1 = dist0 - 512;
        const float s0 = p0[r] * (0.125f * LOG2E) + lut[min(max(dist0, 0), 1023)], s1 = p1[r] * (0.125f * LOG2E) + lut[min(max(dist1, 0), 1023)];
        p0[r] = dist0 >= 0 ? __builtin_amdgcn_exp2f(s0 - m) * rl : 0.f; p1[r] = dist1 >= 0 ? __builtin_amdgcn_exp2f(s1 - m) * rl : 0.f; }
#pragma unroll
    for (int g4 = 0; g4 < 4; ++g4) {
        { const int j = 16 * T + 2 * g4 + hi; const float hb = 0.5f * p0[4 * g4 + 3]; (void)__hip_atomic_fetch_add(imp_row + j, (unsigned)__float2int_rn((p0[4 * g4] + p0[4 * g4 + 1] + p0[4 * g4 + 2] + hb) * 67108864.0f), __ATOMIC_RELAXED, __HIP_MEMORY_SCOPE_WORKGROUP); if (j + 1 < 64) (void)__hip_atomic_fetch_add(imp_row + j + 1, (unsigned)__float2int_rn(hb * 67108864.0f), __ATOMIC_RELAXED, __HIP_MEMORY_SCOPE_WORKGROUP); }
        { const int j = 16 * T + 8 + 2 * g4 + hi; const float hb = 0.5f * p1[4 * g4 + 3]; (void)__hip_atomic_fetch_add(imp_row + j, (unsigned)__float2int_rn((p1[4 * g4] + p1[4 * g4 + 1] + p1[4 * g4 + 2] + hb) * 67108864.0f), __ATOMIC_RELAXED, __HIP_MEMORY_SCOPE_WORKGROUP); if (j + 1 < 64) (void)__hip_atomic_fetch_add(imp_row + j + 1, (unsigned)__float2int_rn(hb * 67108864.0f), __ATOMIC_RELAXED, __HIP_MEMORY_SCOPE_WORKGROUP); }
    }
}

__device__ __forceinline__ void nsa_fused_unit(LAS unsigned char* lds, const bf16_t* __restrict__ Z, const float* __restrict__ L1G, const float* __restrict__ L2G, const bf16_t* __restrict__ KCb, const bf16_t* __restrict__ VCb, bf16_t* __restrict__ OA,
                                               int b, int hkv, int ch, int wave, int lane) {
    asm volatile("" : "+v"(lane));
    const int tid = wave * 64 + lane, r32 = lane & 31, hi = lane >> 5, g = wave >> 1, h = hkv * 4 + g, t0 = ch * 64, tok = (wave & 1) * 32 + r32, qpos = t0 + tok;
    fill_lut(lds, L1G, hkv * 4, tid);
    for (int i = tid; i < 64 * 65; i += 512) ((LAS unsigned*)(lds + NS_IMP))[i] = 0u;
    const int cmax = 4 * ch + 2;
    const int ntc = ch == 0 ? 1 : (cmax >> 6) + 1;
    {
      const bf16_t* kc = KCb + (size_t)(b * 2 + hkv) * 256 * 64; const bf16_t* vc = VCb + (size_t)(b * 2 + hkv) * 256 * 64;
      u32x4_t kk_[4], vv_[4];
#pragma unroll
      for (int T = 0; T < 4; ++T) { const int i = (T < ntc ? T : 0) * 512 + tid, row = i >> 3, c8 = i & 7; kk_[T] = gload16(kc + row * 64 + c8 * 8); vv_[T] = gload16(vc + row * 64 + c8 * 8); }
#pragma unroll
      for (int T = 0; T < 4; ++T) if (T < ntc) { const int i = T * 512 + tid, row = i >> 3, c8 = i & 7;
          *(LAS u32x4_t*)(lds + NS_CK + (row * 72 + c8 * 8) * 2) = kk_[T]; *(LAS u32x4_t*)(lds + NS_CV + (row * AT_VP + c8 * 8) * 2) = vv_[T]; } }
    const bf16_t* Zb_ = Z + (size_t)b * SEQ * ZW; const size_t rowq = (size_t)(b * SEQ + qpos);
    bf16x8_t qf[4];
#pragma unroll
    for (int d0 = 0; d0 < 4; ++d0) qf[d0] = *(const bf16x8_t*)(Zb_ + (size_t)qpos * ZW + Z_NQ + h * 64 + 16 * d0 + 8 * hi);
    LAS const float* lut = (LAS const float*)(lds + AT_LUT) + g * 1024;
    __syncthreads();
    f32x16_t o[2], lacc; unsigned accp[2][8];
    float m;
#pragma unroll
    for (int r = 0; r < 16; ++r) { o[0][r] = 0.f; o[1][r] = 0.f; }
    m = -1e30f;
#pragma unroll
    for (int r = 0; r < 16; ++r) lacc[r] = 0.f;
    for (int T = 0; T < ntc; ++T) attn_tile<64, 4>(lds + NS_CK + T * 64 * 72 * 2, lds + NS_CV + T * 64 * AT_VP * 2, lut, qf, o, m, lacc, qpos, 64 * T, true, 3, 0.125f * LOG2E, 0.f, lane);
    { const float lt = lacc[0], rl = lt > 0.f ? 1.0f / lt : 0.f;
      const float f = sigmoidf_(bf2f(Z[rowq * ZW + Z_GATE + h * 3 + 0])) * rl;
#pragma unroll
      for (int r = 0; r < 8; ++r) { accp[0][r] = pg8::cvt_pk_bf16(o[0][2 * r] * f, o[0][2 * r + 1] * f); accp[1][r] = pg8::cvt_pk_bf16(o[1][2 * r] * f, o[1][2 * r + 1] * f); }
      LAS unsigned* imp_row = (LAS unsigned*)(lds + NS_IMP) + tok * 65;
      for (int T = 0; T < ntc; ++T) cmp_imp_tile(lds + NS_CK + T * 64 * 72 * 2, lut, qf, m, rl, qpos, T, imp_row, lane); }
    __syncthreads();
    {
      typedef __attribute__((address_space(1))) const u32x4_t gv4c;
      gv4c* src = (gv4c*)(L2G + hkv * (4 * 2 * NS_L2N));
      u32x4_t lv[5];
#pragma unroll
      for (int it = 0; it < 5; ++it) { const int i = it * 512 + tid; lv[it] = src[i < 2 * NS_L2N ? i : 0]; }
#pragma unroll
      for (int it = 0; it < 5; ++it) { const int i = it * 512 + tid; if (i < 2 * NS_L2N) ((LAS u32x4_t*)(lds + NS_L2))[i] = lv[it]; } }
    { const int cur = ch; unsigned long long forced = 1ull | (1ull << cur); if (cur >= 1) forced |= 1ull << (cur - 1);
      const int need = 16 - __popcll(forced);
      for (int tt = 0; tt < 8; ++tt) { const int token = wave * 8 + tt;
          const unsigned v = ((LAS const unsigned*)(lds + NS_IMP))[token * 65 + lane];
          const bool cand = lane >= 1 && lane <= cur - 2;
          const unsigned long long cm = __ballot(cand);
          unsigned long long selb = cm;
          if (__popcll(cm) > need) {
              unsigned T = 0u;
              for (int bit = 28; bit >= 0; --bit) { const unsigned t = T | (1u << bit); if (__popcll(__ballot(cand && v >= t)) >= need) T = t; }
              const unsigned long long gt = __ballot(cand && v > T), eq = __ballot(cand && v == T);
              const int rem = need - __popcll(gt);
              const int below = (int)__builtin_amdgcn_mbcnt_hi((unsigned)(eq >> 32), __builtin_amdgcn_mbcnt_lo((unsigned)eq, 0u));
              selb = gt | __ballot(cand && v == T && below < rem);
          }
          if (lane == 0) ((LAS unsigned long long*)(lds + NS_MASK))[token] = selb | forced; } }
    __syncthreads();
    const unsigned long long selmask = ((LAS const unsigned long long*)(lds + NS_MASK))[tok];
    unsigned long long umask;
    { const unsigned long long u = ((LAS const unsigned long long*)(lds + NS_MASK))[lane]; unsigned lo = (unsigned)u, hh = (unsigned)(u >> 32);
#pragma unroll
      for (int s = 1; s < 64; s <<= 1) { lo |= __shfl_xor(lo, s); hh |= __shfl_xor(hh, s); }
      umask = ((unsigned long long)__builtin_amdgcn_readfirstlane(hh) << 32) | (unsigned long long)__builtin_amdgcn_readfirstlane(lo); }
    const float c31 = lut[1023];
    LAS const float* lutv;
    { const int xl = 959 - qpos + 4 * hi, k = xl & 1; lutv = (LAS const float*)(lds + NS_L2) + (g * 2 + k) * NS_L2N + (xl - k); }
#pragma unroll
    for (int r = 0; r < 16; ++r) { o[0][r] = 0.f; o[1][r] = 0.f; }
    m = -1e30f;
#pragma unroll
    for (int r = 0; r < 16; ++r) lacc[r] = 0.f;
    { const int jlo = ch - 8 > 0 ? ch - 8 : 0; const unsigned long long tmask = ((ch == 63 ? ~0ull : ((1ull << (ch + 1)) - 1ull))) & ~((1ull << jlo) - 1ull);
      gqa_pass<1>(lds, Zb_, Z_KW + hkv * 64, Z_VW + hkv * 64, tmask, qf, qpos, 0ull, lutv, c31, o, m, lacc, tid, lane); }
    { const float f = sigmoidf_(bf2f(Z[rowq * ZW + Z_GATE + h * 3 + 2])) / lacc[0];
#pragma unroll
      for (int r = 0; r < 8; ++r) { accp[0][r] = pg8::cvt_pk_bf16(fmaf(o[0][2 * r], f, bflo(accp[0][r])), fmaf(o[0][2 * r + 1], f, bfhi(accp[0][r]))); accp[1][r] = pg8::cvt_pk_bf16(fmaf(o[1][2 * r], f, bflo(accp[1][r])), fmaf(o[1][2 * r + 1], f, bfhi(accp[1][r]))); } }
#pragma unroll
    for (int r = 0; r < 16; ++r) { o[0][r] = 0.f; o[1][r] = 0.f; }
    m = -1e30f;
#pragma unroll
    for (int r = 0; r < 16; ++r) lacc[r] = 0.f;
    gqa_pass<2>(lds, Zb_, Z_KS + hkv * 64, Z_VS + hkv * 64, umask, qf, qpos, selmask, lutv, c31, o, m, lacc, tid, lane);
    { const float f = sigmoidf_(bf2f(Z[rowq * ZW + Z_GATE + h * 3 + 1])) / lacc[0];
#pragma unroll
      for (int r = 0; r < 8; ++r) { accp[0][r] = pg8::cvt_pk_bf16(fmaf(o[0][2 * r], f, bflo(accp[0][r])), fmaf(o[0][2 * r + 1], f, bfhi(accp[0][r]))); accp[1][r] = pg8::cvt_pk_bf16(fmaf(o[1][2 * r], f, bflo(accp[1][r])), fmaf(o[1][2 * r + 1], f, bfhi(accp[1][r]))); } }
    int b_o = b; asm volatile("" : "+s"(b_o));
    bf16_t* orow = OA + (size_t)(b_o * SEQ + qpos) * 512 + h * 64;
#pragma unroll
    for (int db = 0; db < 2; ++db)
#pragma unroll
        for (int g4 = 0; g4 < 4; ++g4) { uint2 w; w.x = accp[db][2 * g4]; w.y = accp[db][2 * g4 + 1]; *(uint2*)(orow + 32 * db + 8 * g4 + 4 * hi) = w; }
}

#ifdef NO_MLA_UNIT
#define U_MLA_UNIT(x) ((void)0)
#else
#define U_MLA_UNIT(x) x
#endif
#ifdef NO_WINSEL_UNIT
#define U_WINSEL_UNIT(x) ((void)0)
#else
#define U_WINSEL_UNIT(x) x
#endif
#ifdef NO_CMP_UNIT
#define U_CMP_UNIT(x) ((void)0)
#else
#define U_CMP_UNIT(x) x
#endif
#ifdef NO_SWA_UNIT
#define U_SWA_UNIT(x) ((void)0)
#else
#define U_SWA_UNIT(x) x
#endif
#ifdef NO_COMPRESS_ITEM
#define U_COMPRESS_ITEM(x) ((void)0)
#else
#define U_COMPRESS_ITEM(x) x
#endif
#ifdef NO_MLA_PREP_ROW
#define U_MLA_PREP_ROW(x) ((void)0)
#else
#define U_MLA_PREP_ROW(x) x
#endif
#ifdef NO_RESNORM_ROW
#define U_RESNORM_ROW(x) ((void)0)
#else
#define U_RESNORM_ROW(x) x
#endif
#ifdef NO_RMSNORM_ROW
#define U_RMSNORM_ROW(x) ((void)0)
#else
#define U_RMSNORM_ROW(x) x
#endif
#ifdef NO_MERGE_ROW
#define U_MERGE_ROW(x) ((void)0)
#else
#define U_MERGE_ROW(x) x
#endif
#ifdef NO_TR
#define U_TR(x) ((void)0)
#else
#define U_TR(x) x
#endif
#ifndef REP_FFN
#define REP_FFN 0
#endif
#ifndef REP_Z
#define REP_Z 0
#endif
#ifndef REP_CMP
#define REP_CMP 0
#endif
#ifndef REP_CPR
#define REP_CPR 0
#endif
#ifndef REP_G
#define REP_G 0
#endif
#ifndef REP_P5
#define REP_P5 0
#endif
#ifndef REP_BAR
#define REP_BAR 0
#endif
#ifndef REP_RN
#define REP_RN 0
#endif
#ifndef REP_MLA
#define REP_MLA 0
#endif
#ifndef REP_NSA
#define REP_NSA 0
#endif
#ifndef REP_SWA
#define REP_SWA 0
#endif
__device__ __forceinline__ int lane_id_opaque() { int l_; asm volatile("v_mbcnt_lo_u32_b32 %0, -1, 0\n\tv_mbcnt_hi_u32_b32 %0, -1, %0" : "=v"(l_)); return l_; }
__device__ __forceinline__ unsigned char* ws_opaque(const Params& p) { unsigned char* w = p.ws; asm volatile("" : "+s"(w)); return w; }
__device__ __forceinline__ const float* in_opaque(const Params& p, int i) { const float* w = p.in[i]; asm volatile("" : "+s"(w)); return w; }
__device__ __forceinline__ float* out_opaque(const Params& p) { float* w = p.out; asm volatile("" : "+s"(w)); return w; }
#define GEMM_PHASE(EPI, Aptr, LDA, BT, NN, KK, OUT, LDC, RSP) do { pg8::Gemm g_; g_.A = (Aptr); g_.Bt = (BT); g_.M = MTOK; g_.N = (NN); g_.K = (KK); g_.lda = (LDA); \
        pg8::StaticOrder S_; S_.init(MTOK, (NN), G, (int)blockIdx.x); EPI e_; e_.O = (OUT); e_.ldc = (LDC); e_.rs = (RSP); \
        pg8::gemm_phase<EPI, pg8::StaticOrder, true, true>((PG8_LAS unsigned char*)lds, g_, S_, e_, wave); } while (0)

typedef __attribute__((address_space(1))) unsigned gu32_t;
constexpr int CW_QUEUE = 16384;
#define GEMM_GATE(FIRST, Aptr, BT, GP) do { pg8::Gemm g_; g_.A = (Aptr); g_.Bt = (BT); g_.M = MTOK; g_.N = DM; g_.K = 512; g_.lda = 512; \
        pg8::StaticOrder S_; S_.init(MTOK, DM, G, (int)blockIdx.x); pg8::EpiGate<FIRST> e_; e_.O = MERGED; e_.ldc = DM; e_.Gp = (GP); e_.ldg = 3072; \
        pg8::gemm_phase<pg8::EpiGate<FIRST>, pg8::StaticOrder, true, true>((PG8_LAS unsigned char*)lds, g_, S_, e_, wave); } while (0)

__global__ void __launch_bounds__(512, 2) mega_fwd(Params p) {
    extern __shared__ __attribute__((aligned(16))) unsigned char lds[];
    const int tid = threadIdx.x, wave = __builtin_amdgcn_readfirstlane(tid >> 6);
#define lane (lane_id_opaque())
#define G ((int)gridDim.x)
#define gw ((int)blockIdx.x * NWAVES + wave)
#define NGW ((int)gridDim.x * NWAVES)
    for (int u = tid; u < (LDS_BYTES - LDSCTL_OFF) / 4; u += NWAVES * 64) ((LAS unsigned*)((LAS unsigned char*)lds + LDSCTL_OFF))[u] = 0u;
    __syncthreads();
    (void)xcd_barrier_post((unsigned*)(p.ws + WS_CTL) + CW_BAR, (volatile LAS unsigned*)((LAS unsigned char*)lds + MISC_OFF) + 8);
#define GRID_BAR() do { XcdBarrier b_; b_.bar = (unsigned*)(ws_opaque(p) + WS_CTL) + CW_BAR; b_.x = xb_xcc_id(); b_.st = (volatile LAS unsigned*)((LAS unsigned char*)lds + MISC_OFF) + 8; xcd_barrier(b_); if (REP_BAR) xcd_barrier(b_); } while (0)
#define scr ((LAS float*)((LAS unsigned char*)lds + wave * 16384))
#define WSP(T, off) ((T*)(ws_opaque(p) + (off)))
#define INP(i, off) (in_opaque(p, (i)) + (size_t)(off))
#define xo (out_opaque(p))
#define BD WSP(float, WS_BD)
#define RC WSP(float, WS_RC)
#define RS WSP(float, WS_RS)
#define KCb WSP(bf16_t, WS_KC)
#define VCb WSP(bf16_t, WS_KC + 512 * 1024)
#define W1T WSP(bf16_t, WS_VC)
#define W2T WSP(bf16_t, WS_RS + 256 * 1024)
#define CPE WSP(float, WS_RS + 256 * 1024 + 64 * 1024)
#define KR WSP(bf16_t, WS_KR)
#define SEL WSP(unsigned long long, WS_SEL)
#define Wgu1 WSP(bf16_t, WS_WT + WT_GU1)
#define Wd1 WSP(bf16_t, WS_WT + WT_D1)
#define Wgu2 WSP(bf16_t, WS_WT + WT_GU2)
#define Wd2 WSP(bf16_t, WS_WT + WT_D2)
#define Wza WSP(bf16_t, WS_WT + WT_ZA)
#define Wg WSP(bf16_t, WS_WT + WT_G)
#define Wb WSP(bf16_t, WS_WT + WT_B)
#define Wout WSP(bf16_t, WS_WT + WT_OUT)
#define Wqb WSP(bf16_t, WS_WT + WT_QB)
#define Wkvb WSP(bf16_t, WS_WT + WT_KVB)
#define XB WSP(bf16_t, WS_HN)
#define RSTAT WSP(float, WS_SEL)
#define L1G WSP(float, WS_SEL + 128 * 1024)
#define L2G WSP(float, WS_SEL + 192 * 1024)
#define ACT WSP(bf16_t, WS_RA)
#define Zb WSP(bf16_t, WS_RA)
#define Y WSP(bf16_t, WS_RB)
#define MQ WSP(bf16_t, WS_RB)
#define MKV WSP(bf16_t, WS_RB + 48 * MiB)
#define QN WSP(bf16_t, WS_RCC)
#define KVN WSP(bf16_t, WS_RCC + 24 * MiB)
#define OA WSP(bf16_t, WS_RCC)
#define OB WSP(bf16_t, WS_RCC + 32 * MiB)
#define OC WSP(bf16_t, WS_RCC + 64 * MiB)
#define YCAT WSP(bf16_t, WS_YCAT)
#define MERGED WSP(bf16_t, WS_RB + 20 * MiB)
#define MOUT WSP(bf16_t, WS_RCC)
#define g_f1pre INP(2, l * DM)
#define w_gu1 INP(3, (size_t)l * DM * 2 * DFF)
#define w_d1 INP(4, (size_t)l * DFF * DM)
#define g_f1post INP(5, l * DM)
#define g_mpre INP(6, l * DM)
#define w_in INP(7, (size_t)l * DM * 5816)
#define pe_k INP(8, l * 2048)
#define w1_k INP(9, (size_t)l * 2048 * 128)
#define w2_k INP(10, l * 128 * 64)
#define pe_v INP(11, l * 2048)
#define w1_v INP(12, (size_t)l * 2048 * 128)
#define w2_v INP(13, l * 128 * 64)
#define sinks INP(14, l * 8)
#define g_q INP(15, l * 384)
#define w_qb INP(16, (size_t)l * 384 * 768)
#define g_kv INP(17, l * 256)
#define w_kvb INP(18, (size_t)l * 256 * 1024)
#define w_br INP(19, (size_t)l * 3 * 512 * 1024)
#define w_out INP(20, (size_t)l * DM * DM)
#define g_mpost INP(21, l * DM)
#define g_f2pre INP(22, l * DM)
#define w_gu2 INP(23, (size_t)l * DM * 2 * DFF)
#define w_d2 INP(24, (size_t)l * DFF * DM)
#define g_f2post INP(25, l * DM)
#define PW_BODY() do { int rot = 0; const unsigned* cm_ = CMAXW(l, 0); \
          U_TR(tr_matrix_i8(w_gu1, DM, 2 * DFF, (unsigned char*)Wgu1, 2 * DFF, 1, 0, 0, g_f1pre, scr, lane, gw, NGW, rot, cm_)); \
          U_TR(tr_matrix(w_d1, DFF, DM, Wd1, DM, 0, 0, DM, nullptr, scr, lane, gw, NGW, rot)); \
          U_TR(tr_matrix_i8(w_gu2, DM, 2 * DFF, (unsigned char*)Wgu2, 2 * DFF, 1, 0, 0, g_f2pre, scr, lane, gw, NGW, rot, cm_ + 5632)); \
          U_TR(tr_matrix(w_d2, DFF, DM, Wd2, DM, 0, 0, DM, nullptr, scr, lane, gw, NGW, rot)); \
          U_TR(tr_matrix_i8(w_in, DM, 5816, (unsigned char*)Wza, ZW, 2, 0, 0, g_mpre, scr, lane, gw, NGW, rot, cm_ + 14336)); \
          U_TR(tr_matrix_i8(w_in, DM, 5816, (unsigned char*)Wg, 3072, 0, 2744, 3072, g_mpre, scr, lane, gw, NGW, rot, cm_ + 11264)); \
          for (int n = 0; n < 3; ++n) U_TR(tr_matrix(w_br + (size_t)n * 512 * 1024, 512, 1024, Wb + (size_t)n * 1024 * 512, 1024, 0, 0, 1024, nullptr, scr, lane, gw, NGW, rot)); \
          U_TR(tr_matrix(w_out, DM, DM, Wout, DM, 0, 0, DM, nullptr, scr, lane, gw, NGW, rot)); \
          U_TR(tr_matrix(w_qb, 384, 768, Wqb, 768, 0, 0, 768, nullptr, scr, lane, gw, NGW, rot)); \
          U_TR(tr_matrix(w_kvb, 256, 1024, Wkvb, 1024, 0, 0, 1024, nullptr, scr, lane, gw, NGW, rot)); \
          for (int i = gw * 64 + lane; i < 2 * 128 * 4 * 64; i += NGW * 64) { const int which_ = i >> 15, r_ = i & 32767, ks_ = r_ >> 8, nt_ = (r_ >> 6) & 3, ln_ = r_ & 63; \
              const float* w1_ = which_ ? w1_v : w1_k; const int n_ = 32 * nt_ + (ln_ & 31), kb_ = 16 * ks_ + 8 * (ln_ >> 5); u32x4_t o_; \
              o_.x = (unsigned)f2bf(w1_[(kb_ + 0) * 128 + n_]) | ((unsigned)f2bf(w1_[(kb_ + 1) * 128 + n_]) << 16); o_.y = (unsigned)f2bf(w1_[(kb_ + 2) * 128 + n_]) | ((unsigned)f2bf(w1_[(kb_ + 3) * 128 + n_]) << 16); \
              o_.z = (unsigned)f2bf(w1_[(kb_ + 4) * 128 + n_]) | ((unsigned)f2bf(w1_[(kb_ + 5) * 128 + n_]) << 16); o_.w = (unsigned)f2bf(w1_[(kb_ + 6) * 128 + n_]) | ((unsigned)f2bf(w1_[(kb_ + 7) * 128 + n_]) << 16); \
              ((u32x4_t*)W1T)[i] = o_; } \
          U_TR(tr_matrix(w2_k, 128, 64, W2T, 64, 0, 0, 64, nullptr, scr, lane, gw, NGW, rot)); \
          U_TR(tr_matrix(w2_v, 128, 64, W2T + 64 * 128, 64, 0, 0, 64, nullptr, scr, lane, gw, NGW, rot)); \
          for (int it = wave * G + (int)blockIdx.x; it < 256; it += NGW) cpe_item((it >> 7) ? pe_v : pe_k, (it >> 7) ? w1_v : w1_k, CPE + (it >> 7) * 128, it & 127, lane); } while (0)
#define CW_AMAX 121000
#define WG_AMAX(L) fmaxf(__uint_as_float(__hip_atomic_load((unsigned*)(ws_opaque(p) + WS_CTL) + CW_AMAX + (L), __ATOMIC_RELAXED, __HIP_MEMORY_SCOPE_AGENT)), 1e-30f)
#define CMAXW(L, OFF) ((unsigned*)(ws_opaque(p) + WS_CTL) + 140000 + (L) * 17408 + (OFF))
    for (int s_ = (int)blockIdx.x; s_ < DEPTH * 268; s_ += G) { int l = s_ / 268; asm volatile("" : "+s"(l)); const int r_ = s_ - l * 268;
        LAS float* red_ = (LAS float*)((LAS unsigned char*)lds);
        if (r_ < 88) strip_absmax_wg(w_gu1, 2 * DFF, 1, 0, 0, g_f1pre, CMAXW(l, 0), r_, red_, wave, lane);
        else if (r_ < 176) strip_absmax_wg(w_gu2, 2 * DFF, 1, 0, 0, g_f2pre, CMAXW(l, 5632), r_ - 88, red_, wave, lane);
        else if (r_ < 224) strip_absmax_wg(w_in, 5816, 0, 2744, 3072, g_mpre, CMAXW(l, 11264), r_ - 176, red_, wave, lane);
        else strip_absmax_wg(w_in, 5816, 2, 0, 0, g_mpre, CMAXW(l, 14336), r_ - 224, red_, wave, lane); }
    GRID_BAR();
    { const int l = 0; PW_BODY();

              for (int i = gw * 64 + lane; i < 16 * 4096; i += NGW * 64) { const int h = i >> 12, d = i & 4095; BD[i] = INP(1, 0)[t5_bucket(d) * 16 + h];
                  const int pos = i >> 4, j = i & 15; const float inv_freq = powf(10000.0f, -(float)j / 16.0f); const float ang = (float)pos * inv_freq; RC[i] = cosf(ang); RS[i] = sinf(ang); }
              for (int i = gw * 64 + lane; i < 4 * 4096; i += NGW * 64) { const int h = i >> 10, d = i & 1023; L1G[i] = INP(1, 0)[t5_bucket(d) * 16 + h] * 1.4426950408889634f; }
              for (int i = gw * 64 + lane; i < 2 * 8 * 1028; i += NGW * 64) { const int hk = i / (8 * 1028), r1 = i - hk * (8 * 1028), hg = r1 / (2 * 1028), r2 = r1 - hg * (2 * 1028), k = r2 >= 1028 ? 1 : 0, idx = r2 - k * 1028, dist = 959 - (idx + k);
                  L2G[i] = dist >= 0 ? INP(1, 0)[t5_bucket(dist) * 16 + hk * 4 + hg] * 1.4426950408889634f : 0.f; }
              xinit_stream(INP(0, 0), XB, RSTAT, gw, NGW, lane, (unsigned char*)xo);
              }
    GRID_BAR();
    for (int l = 0; l < DEPTH; ++l) {
        { pg8::Gemm g_; g_.A = (const bf16_t*)xo; g_.Bt = Wgu1; g_.M = MTOK; g_.N = 2 * DFF; g_.K = DM / 2; g_.lda = DM / 2;
          pg8::StaticOrder S_; S_.init(MTOK, 2 * DFF, G, (int)blockIdx.x); pg8::EpiSwiGLUI e_; e_.O = ACT; e_.ldc = DFF; e_.rs = (const float*)((const unsigned char*)xo + (size_t)MTOK * DM); e_.cs = CMAXW(l, 0);
          pg8::gemm_phase<pg8::EpiSwiGLUI, pg8::StaticOrder, true, true, false, true>((PG8_LAS unsigned char*)lds, g_, S_, e_, wave); }
        GRID_BAR();
        for (int rep_ = 0; rep_ < 1 + REP_FFN; ++rep_) { GEMM_PHASE(pg8::EpiStore, ACT, DFF, Wd1, DM, DFF, Y, DM, nullptr); }
        GRID_BAR();
        if (l == 0) resid_stream<true>(Y, g_f1post, 0.5f, INP(0, 0), XB, RSTAT, nullptr, gw, NGW, lane, (unsigned char*)xo);
        else resid_stream<false>(Y, g_f1post, 0.5f, nullptr, XB, RSTAT, nullptr, gw, NGW, lane, (unsigned char*)xo);
        GRID_BAR();
        { pg8::Gemm g_; g_.A = (const bf16_t*)xo; g_.Bt = Wza; g_.M = MTOK; g_.N = ZW; g_.K = DM / 2; g_.lda = DM / 2;
          pg8::StaticOrder S_; S_.init(MTOK, ZW, G, (int)blockIdx.x); pg8::EpiStoreI e_; e_.O = Zb; e_.ldc = ZW; e_.rs = (const float*)((const unsigned char*)xo + (size_t)MTOK * DM); e_.cs = CMAXW(l, 14336);
          pg8::gemm_phase<pg8::EpiStoreI, pg8::StaticOrder, true, true, false, true>((PG8_LAS unsigned char*)lds, g_, S_, e_, wave); }
        GRID_BAR();
        for (int rep5_ = 0; rep5_ < 1 + REP_P5; ++rep5_) {
        for (int row = gw; row < MTOK; row += 4 * NGW) mla_prep_rows4(Zb, g_q, g_kv, RC, RS, QN, KVN, KR, row, NGW, lane);
for (int it = (int)blockIdx.x; it < 2 * BATCH * 2 * 8; it += G) { const int which = it >> 7, r = it & 127, b = r >> 4, hkv = (r >> 3) & 1, ct = r & 7;
            compress_wg_unit((LAS unsigned char*)lds, Zb, W1T + (size_t)which * 128 * 2048, W2T + which * 64 * 128, CPE + which * 128, which ? VCb : KCb, b, hkv, (which ? Z_VC : Z_KC) + hkv * 64, ct, wave, lane); }
        }
        GRID_BAR();
        for (int rep_ = 0; rep_ < 1 + REP_G; ++rep_) { GEMM_PHASE(pg8::EpiStore, QN, 384, Wqb, 768, 384, MQ, 768, nullptr); }
        for (int rep_ = 0; rep_ < 1 + REP_G; ++rep_) { GEMM_PHASE(pg8::EpiStore, KVN, 256, Wkvb, 1024, 256, MKV, 1024, nullptr); }
        GRID_BAR();
        __syncthreads();
        if (wave >= 4) __builtin_amdgcn_s_setprio(1);
        int swa_lut_ = -1;
        for (int kind_ = 0; kind_ < 3; ++kind_) {
            gu32_t* qw = (gu32_t*)((unsigned*)(ws_opaque(p) + WS_CTL) + CW_QUEUE + 64 * (3 * l + kind_));
            volatile LAS unsigned* qs = (volatile LAS unsigned*)((LAS unsigned char*)lds + MISC_OFF) + 16;
            for (;;) {
                if (wave == 0 && lane == 0) qs[0] = __hip_atomic_fetch_add(qw, 1u, __ATOMIC_RELAXED, __HIP_MEMORY_SCOPE_AGENT);
                __syncthreads();
                const int u = __builtin_amdgcn_readfirstlane((int)qs[0]);
                __syncthreads();
                if (u >= 1024) break;
                if (kind_ == 0) { const int qc = 15 - (u >> 6), r = u & 63; mla_wg_unit((LAS unsigned char*)lds, MQ, MKV, KR, RC, RS, OC, r >> 3, r & 7, qc, wave, lane); }
                else if (kind_ == 1) { const int ch = 63 - (u >> 4), r = u & 15; nsa_fused_unit((LAS unsigned char*)lds, Zb, L1G, L2G, KCb, VCb, OA, r >> 1, r & 1, ch, wave, lane); }
                else { const int hkv_ = u >> 9, ch = 63 - ((u & 511) >> 3), b_ = u & 7;
                       if (hkv_ != swa_lut_) { fill_lut((LAS unsigned char*)lds, L1G, 8 + hkv_ * 4, wave * 64 + lane); swa_lut_ = hkv_; }
                       swa_wg_unit((LAS unsigned char*)lds, Zb, BD, sinks, OB, b_, hkv_, ch, wave, lane); }
            }
        }
        __builtin_amdgcn_s_setprio(0);
        GRID_BAR();
        { pg8::Gemm g_; g_.A = (const bf16_t*)xo; g_.Bt = Wg; g_.M = MTOK; g_.N = 3072; g_.K = DM / 2; g_.lda = DM / 2;
          pg8::StaticOrder S_; S_.init(MTOK, 3072, G, (int)blockIdx.x); pg8::EpiSigmoidQI e_; e_.O = (unsigned char*)YCAT; e_.ldc = 3072; e_.rs = (const float*)((const unsigned char*)xo + (size_t)MTOK * DM); e_.cs = CMAXW(l, 11264);
          pg8::gemm_phase<pg8::EpiSigmoidQI, pg8::StaticOrder, true, true, false, true>((PG8_LAS unsigned char*)lds, g_, S_, e_, wave); }
        GRID_BAR();
        { pg8::Gemm g_; g_.A = OA; g_.Bt = Wb; g_.M = 3 * MTOK; g_.N = 3072; g_.K = 512; g_.lda = 512;
          pg8::GateOrder S_; S_.init(MTOK, G, (int)blockIdx.x); pg8::EpiGateChainQ e_; e_.O = MERGED; e_.ldc = DM; e_.Gp = (const unsigned char*)YCAT; e_.ldg = 3072;
          pg8::gemm_phase<pg8::EpiGateChainQ, pg8::GateOrder, true, true, true>((PG8_LAS unsigned char*)lds, g_, S_, e_, wave); }
        GRID_BAR();
        for (int rep_ = 0; rep_ < 1 + REP_G; ++rep_) { GEMM_PHASE(pg8::EpiStore, MERGED, DM, Wout, DM, DM, MOUT, DM, nullptr); }
        GRID_BAR();
        resid_stream<false>(MOUT, g_mpost, 1.0f, nullptr, XB, RSTAT, nullptr, gw, NGW, lane, (unsigned char*)xo);
        GRID_BAR();
        { pg8::Gemm g_; g_.A = (const bf16_t*)xo; g_.Bt = Wgu2; g_.M = MTOK; g_.N = 2 * DFF; g_.K = DM / 2; g_.lda = DM / 2;
          pg8::StaticOrder S_; S_.init(MTOK, 2 * DFF, G, (int)blockIdx.x); pg8::EpiSwiGLUI e_; e_.O = ACT; e_.ldc = DFF; e_.rs = (const float*)((const unsigned char*)xo + (size_t)MTOK * DM); e_.cs = CMAXW(l, 5632);
          pg8::gemm_phase<pg8::EpiSwiGLUI, pg8::StaticOrder, true, true, false, true>((PG8_LAS unsigned char*)lds, g_, S_, e_, wave); }
        GRID_BAR();
        for (int rep_ = 0; rep_ < 1 + REP_FFN; ++rep_) { GEMM_PHASE(pg8::EpiStore, ACT, DFF, Wd2, DM, DFF, Y, DM, nullptr); }
        GRID_BAR();
        resid_stream<false>(Y, g_f2post, 0.5f, nullptr, XB, RSTAT, l + 1 < DEPTH ? nullptr : (float*)xo, gw, NGW, lane, l + 1 < DEPTH ? (unsigned char*)xo : nullptr);
        if (l + 1 < DEPTH) { const int ln_ = l + 1; { const int l = ln_; PW_BODY(); } }
        GRID_BAR();
    }
}

extern "C" void kernel_launch(void* const* d_in, const int* in_sizes, int n_in, void* d_out, int out_size, void* d_ws, size_t ws_size, hipStream_t stream) {
    static int grid = 0;
    if (grid == 0) {
        if (n_in != 26 || out_size != MTOK * DM || ws_size < WS_END) { fprintf(stderr, "kernel_launch: unexpected shapes (n_in %d out %d ws %zu)\n", n_in, out_size, ws_size); grid = -1; return; }
        int dev = 0, cus = 0, per_cu = 0;
        if (hipGetDevice(&dev) != hipSuccess || hipDeviceGetAttribute(&cus, hipDeviceAttributeMultiprocessorCount, dev) != hipSuccess) { grid = -1; return; }
        if (hipFuncSetAttribute((const void*)mega_fwd, hipFuncAttributeMaxDynamicSharedMemorySize, LDS_BYTES) != hipSuccess) { grid = -1; return; }
        if (hipOccupancyMaxActiveBlocksPerMultiprocessor(&per_cu, (const void*)mega_fwd, NWAVES * 64, LDS_BYTES) != hipSuccess || per_cu < 1) fprintf(stderr, "kernel_launch: occupancy query says %d\n", per_cu);
        (void)hipGetLastError();
        grid = cus;
    }
    if (grid < 0) return;
    if (hipMemsetAsync((char*)d_ws + WS_CTL, 0, CTL_ZERO_BYTES, stream) != hipSuccess) return;
    Params p{};
    for (int i = 0; i < 26; ++i) p.in[i] = (const float*)d_in[i];
    p.out = (float*)d_out; p.ws = (unsigned char*)d_ws;
    hipLaunchKernelGGL(mega_fwd, dim3(grid), dim3(NWAVES * 64), LDS_BYTES, stream, p);
}
```
